# Optimizing an MI355X kernel written in HIP

```python
import math
import jax, jax.numpy as jnp
from jax import lax
import numpy as np

D_MODEL = 1024
BATCH = 2
SEQ = 8192
DEPTH = 4
DEC_BATCH = 128
DEC_SEQ = 4
PAST_LEN = 8192
PAGE_SIZE = 128

H_A = 4
DK_A = 32
DV_A = 64
RET_CHUNK = 128
RET_THETA = 10000.0
H_B = 8
KV_B = 2
G_B = H_B // KV_B
HD_B = 64
WINDOW = 128
ROPE_THETA = 500000.0
ROT_B = HD_B // 4
W_C = 256
POOL_WINDOWS = (2, 4, 8, 16)
N_POOL = 4
GC = W_C // N_POOL
POOL_HIST = 15
H_D = 4
DK_D = 64
DV_D = 64
HGRN_CHUNK = 16

W_A = H_A * DV_A
W_B = H_B * HD_B
W_D = H_D * DV_D
N_BRANCH = 4
BRANCH_WIDTHS = (W_A, W_B, W_C, W_D)
W_MIX = W_A + W_B + W_C + W_D
IN_WIDTHS = (
    H_A * DK_A, H_A * DK_A, W_A, W_A,
    H_B * HD_B, KV_B * HD_B, KV_B * HD_B, W_B,
    W_C, W_C,
    H_D * DK_D, H_D * DK_D, W_D, W_D,
    N_BRANCH * D_MODEL,
)
D_IN = sum(IN_WIDTHS)
EPS = 1e-6

kernel_name = "hybrid_gated_parallel_decoder_step"


def rms_norm(x, g=None):
    xf = x.astype(jnp.float32)
    y = xf * lax.rsqrt(jnp.mean(xf * xf, axis=-1, keepdims=True) + EPS)
    if g is not None:
        y = y * g.astype(jnp.float32)
    return y.astype(x.dtype)


def rope(x, pos, rot_dim, theta):
    half = rot_dim // 2
    inv = jnp.power(theta, -jnp.arange(half, dtype=jnp.float32) / half)
    ang = pos.astype(jnp.float32)[:, None] * inv[None, :]
    cos = jnp.cos(ang)[None, :, None, :]
    sin = jnp.sin(ang)[None, :, None, :]
    xf = x.astype(jnp.float32)
    x1 = xf[..., :half]
    x2 = xf[..., half:rot_dim]
    out = jnp.concatenate([x1 * cos - x2 * sin, x2 * cos + x1 * sin, xf[..., rot_dim:]], axis=-1)
    return out.astype(x.dtype)


def retention(q, k, v, s0):
    B, T, H, DK = q.shape
    DV = v.shape[-1]
    C = math.gcd(T, RET_CHUNK)
    n = T // C
    f32 = jnp.float32
    q = q.astype(f32).reshape(B, n, C, H, DK)
    k = k.astype(f32).reshape(B, n, C, H, DK)
    v = v.astype(f32).reshape(B, n, C, H, DV)
    lg = jnp.log1p(-jnp.power(2.0, -5.0 - jnp.arange(H, dtype=f32)))
    idx = jnp.arange(C, dtype=f32)
    rel = idx[:, None] - idx[None, :]
    dmask = jnp.where(rel[None] >= 0, jnp.exp(jnp.maximum(rel, 0.0)[None] * lg[:, None, None]), 0.0)
    scores = jnp.einsum('bnthd,bnshd->bnhts', q, k) * dmask[None, None]
    o = jnp.einsum('bnhts,bnshe->bnthe', scores, v)
    q_dec = q * jnp.exp((idx[:, None] + 1.0) * lg[None, :])[:, :, None]
    k_dec = k * jnp.exp((C - 1.0 - idx)[:, None] * lg[None, :])[:, :, None]
    kv = jnp.einsum('bnshd,bnshe->nbhde', k_dec, v)
    cdec = jnp.exp(C * lg)[None, :, None, None]

    def step(s, kv_n):
        return cdec * s + kv_n, s

    s_fin, s_starts = lax.scan(step, s0.astype(f32), kv)
    o = o + jnp.einsum('bnthd,nbhde->bnthe', q_dec, s_starts)
    return o.reshape(B, T, H, DV), s_fin


def hgrn2_scan(q, k, v, log_f, s0):
    B, T, H, DK = q.shape
    DV = v.shape[-1]
    C = math.gcd(T, HGRN_CHUNK)
    n = T // C
    f32 = jnp.float32
    q = q.astype(f32).reshape(B, n, C, H, DK)
    k = k.astype(f32).reshape(B, n, C, H, DK)
    v = v.astype(f32).reshape(B, n, C, H, DV)
    b = jnp.cumsum(log_f.astype(f32).reshape(B, n, C, H, DK), axis=2)
    causal = jnp.tril(jnp.ones((C, C), dtype=bool))
    diff = b[:, :, :, None] - b[:, :, None, :]
    w = jnp.exp(jnp.where(causal[None, None, :, :, None, None], diff, -jnp.inf))
    scores = jnp.einsum('bnthd,bntshd,bnshd->bnhts', q, w, k)
    o = jnp.einsum('bnhts,bnshe->bnthe', scores, v)
    b_last = b[:, :, -1]
    q_dec = q * jnp.exp(b)
    k_dec = k * jnp.exp(b_last[:, :, None] - b)
    kv = jnp.einsum('bnshd,bnshe->nbhde', k_dec, v)
    cdec = jnp.moveaxis(jnp.exp(b_last), 1, 0)[..., None]

    def step(s, xs):
        dec, kv_n = xs
        return dec * s + kv_n, s

    s_fin, s_starts = lax.scan(step, s0.astype(f32), (cdec, kv))
    o = o + jnp.einsum('bnthd,nbhde->bnthe', q_dec, s_starts)
    return o.reshape(B, T, H, DV), s_fin


def swa_sink_attention(q, k, v, k_buf, v_buf, sink, start):
    B, T = q.shape[:2]
    Bq = WINDOW if T % WINDOW == 0 else T
    nb = T // Bq
    L = WINDOW + Bq
    k_ext = jnp.concatenate([k_buf.astype(k.dtype), k], axis=1)
    v_ext = jnp.concatenate([v_buf.astype(v.dtype), v], axis=1)
    ctx = jnp.arange(nb)[:, None] * Bq + jnp.arange(L)[None, :]
    kb = k_ext[:, ctx].astype(jnp.float32)
    vb = v_ext[:, ctx].astype(jnp.float32)
    qb = q.astype(jnp.float32).reshape(B, nb, Bq, KV_B, G_B, HD_B)
    q_pos = start + jnp.arange(T).reshape(nb, Bq)
    k_pos = start - WINDOW + ctx
    dist = q_pos[:, :, None] - k_pos[:, None, :]
    mask = (dist >= 0) & (dist <= WINDOW) & (k_pos[:, None, :] >= 0)
    s = jnp.einsum('bnqkgd,bnlkd->bnkgql', qb, kb) * (HD_B ** -0.5)
    s = jnp.where(mask[None, :, None, None], s, -jnp.inf)
    sink_col = jnp.broadcast_to(sink.astype(jnp.float32).reshape(KV_B, G_B)[None, None, :, :, None, None],
                                s.shape[:-1] + (1,))
    p = jax.nn.softmax(jnp.concatenate([s, sink_col], axis=-1), axis=-1)[..., :-1]
    o = jnp.einsum('bnkgql,bnlkd->bnqkgd', p, vb)
    return o.reshape(B, T, H_B * HD_B), k_ext[:, -WINDOW:], v_ext[:, -WINDOW:]


def pool_mix(u, hist, w_pool, pool_scale, start):
    B, T, _ = u.shape
    ext_raw = jnp.concatenate([hist.astype(u.dtype), u], axis=1)
    ext = ext_raw.astype(jnp.float32)
    cs = jnp.concatenate([jnp.zeros((B, 1, W_C), jnp.float32), jnp.cumsum(ext, axis=1)], axis=1)
    end = cs[:, POOL_HIST + 1:]
    pos = start + jnp.arange(T)
    outs = []
    for g, w in enumerate(POOL_WINDOWS):
        sl = slice(g * GC, (g + 1) * GC)
        win = end[..., sl] - cs[:, POOL_HIST + 1 - w: POOL_HIST + 1 - w + T, sl]
        cnt = jnp.minimum(pos + 1, w).astype(jnp.float32)[None, :, None]
        outs.append(win / cnt)
    pooled = jnp.concatenate(outs, axis=-1) - u.astype(jnp.float32)
    mixed = jnp.einsum('btgc,gcd->btgd', pooled.reshape(B, T, N_POOL, GC),
                       w_pool.astype(jnp.float32)).reshape(B, T, W_C)
    return mixed * pool_scale.astype(jnp.float32), ext_raw[:, -POOL_HIST:]


def mixer_layer(x, start, s_ret, k_buf, v_buf, p_hist, s_hgrn, lb,
                w_in, w_branch, w_out, g_pre, g_post, sink, w_pool, pool_scale, g_hgrn):
    B, T, _ = x.shape
    dt = x.dtype
    h = rms_norm(x, g_pre)
    proj = h @ w_in
    split_idx = [int(i) for i in np.cumsum(IN_WIDTHS)[:-1]]
    (q_a, k_a, v_a, z_a, q_b, k_b, v_b, z_b, u_c, z_c,
     q_d, f_d, i_d, z_d, gl) = jnp.split(proj, split_idx, axis=-1)
    pos = start + jnp.arange(T)

    qa = rope(q_a.reshape(B, T, H_A, DK_A), pos, DK_A, RET_THETA)
    ka = rope(k_a.reshape(B, T, H_A, DK_A), pos, DK_A, RET_THETA) * (DK_A ** -0.5)
    o_a, s_ret_new = retention(qa, ka, v_a.reshape(B, T, H_A, DV_A), s_ret)
    y_a = (rms_norm(o_a).reshape(B, T, W_A) * jax.nn.silu(z_a.astype(jnp.float32))).astype(dt)

    qb = rope(q_b.reshape(B, T, H_B, HD_B), pos, ROT_B, ROPE_THETA)
    kb = rope(k_b.reshape(B, T, KV_B, HD_B), pos, ROT_B, ROPE_THETA)
    o_b, k_new, v_new = swa_sink_attention(qb, kb, v_b.reshape(B, T, KV_B, HD_B), k_buf, v_buf, sink, start)
    y_b = (o_b * jax.nn.silu(z_b.astype(jnp.float32))).astype(dt)

    o_c, p_new = pool_mix(u_c, p_hist, w_pool, pool_scale, start)
    y_c = (o_c * jax.nn.silu(z_c.astype(jnp.float32))).astype(dt)

    f = lb + (1.0 - lb) * jax.nn.sigmoid(f_d.astype(jnp.float32))
    o_d, s_hgrn_new = hgrn2_scan(jax.nn.silu(q_d.astype(jnp.float32)).reshape(B, T, H_D, DK_D),
                                 (1.0 - f).reshape(B, T, H_D, DK_D),
                                 i_d.reshape(B, T, H_D, DV_D),
                                 jnp.log(f).reshape(B, T, H_D, DK_D), s_hgrn)
    y_d = (rms_norm(o_d, g_hgrn.reshape(H_D, DV_D)).reshape(B, T, W_D)
           * jax.nn.silu(z_d.astype(jnp.float32))).astype(dt)

    gates = jax.nn.sigmoid(gl.reshape(B, T, N_BRANCH, D_MODEL))
    ys = (y_a, y_b, y_c, y_d)
    off = 0
    merged = None
    for i in range(N_BRANCH):
        wd = BRANCH_WIDTHS[i]
        term = gates[:, :, i] * (ys[i] @ w_branch[off:off + wd])
        merged = term if merged is None else merged + term
        off += wd
    out = merged @ w_out
    x_new = x + rms_norm(out, g_post)
    return (x_new, s_ret_new.astype(dt), k_new.astype(dt), v_new.astype(dt),
            p_new.astype(dt), s_hgrn_new.astype(dt))


def trunk(x, start, s_ret, k_buf, v_buf, p_hist, s_hgrn, lb,
          w_in, w_branch, w_out, g_pre, g_post, attn_sink, w_pool, pool_scale, g_hgrn):
    acc = ([], [], [], [], [])
    for l in range(DEPTH):
        x, *st = mixer_layer(x, start, s_ret[l], k_buf[l], v_buf[l], p_hist[l], s_hgrn[l], lb[l],
                             w_in[l], w_branch[l], w_out[l], g_pre[l], g_post[l], attn_sink[l],
                             w_pool[l], pool_scale[l], g_hgrn[l])
        for a, s in zip(acc, st):
            a.append(s)
    return (x, jnp.stack(acc[0]), jnp.stack(acc[1]), jnp.stack(acc[2]),
            jnp.stack(acc[3]), jnp.stack(acc[4]))


def setup_inputs(seed: int = 0) -> dict:
    key = jax.random.key(seed)
    ks = jax.random.split(key, 17)

    def nrm(k, shape, s):
        return jax.random.normal(k, shape, jnp.float32) * s

    return {
        "x_prompt": nrm(ks[0], (BATCH, SEQ, D_MODEL), 1.0),
        "x_sample": nrm(ks[1], (DEC_BATCH, DEC_SEQ, D_MODEL), 1.0),
        "state_ret": nrm(ks[2], (DEPTH, DEC_BATCH, H_A, DK_A, DV_A), 0.5),
        "cache_swa_k": nrm(ks[3], (DEPTH, DEC_BATCH, WINDOW, KV_B, HD_B), 1.0),
        "cache_swa_v": nrm(ks[4], (DEPTH, DEC_BATCH, WINDOW, KV_B, HD_B), 1.0),
        "state_pool": nrm(ks[5], (DEPTH, DEC_BATCH, POOL_HIST, W_C), 1.0),
        "state_hgrn": nrm(ks[6], (DEPTH, DEC_BATCH, H_D, DK_D, DV_D), 0.5),
        "w_in": nrm(ks[7], (DEPTH, D_MODEL, D_IN), D_MODEL ** -0.5),
        "w_branch": nrm(ks[8], (DEPTH, W_MIX, D_MODEL), (W_MIX // N_BRANCH) ** -0.5),
        "w_out": nrm(ks[9], (DEPTH, D_MODEL, D_MODEL), D_MODEL ** -0.5),
        "g_pre": 1.0 + nrm(ks[10], (DEPTH, D_MODEL), 0.1),
        "g_post": 1.0 + nrm(ks[11], (DEPTH, D_MODEL), 0.1),
        "attn_sink": nrm(ks[12], (DEPTH, H_B), 0.5),
        "w_pool": nrm(ks[13], (DEPTH, N_POOL, GC, GC), GC ** -0.5),
        "pool_scale": 1.0 + nrm(ks[14], (DEPTH, W_C), 0.1),
        "g_hgrn": 1.0 + nrm(ks[15], (DEPTH, W_D), 0.1),
        "lower_bounds": nrm(ks[16], (DEPTH, H_D * DK_D), 0.1),
    }


def reference(x_prompt, x_sample, state_ret, cache_swa_k, cache_swa_v, state_pool, state_hgrn,
              w_in, w_branch, w_out, g_pre, g_post, attn_sink, w_pool, pool_scale, g_hgrn,
              lower_bounds):
    lb = jnp.cumsum(jax.nn.softmax(lower_bounds.astype(jnp.float32), axis=0), axis=0)
    lb = lb - lb[0]
    dt = x_prompt.dtype
    y_p, r_p, k_p, v_p, pool_p, h_p = trunk(
        x_prompt, 0,
        jnp.zeros((DEPTH, BATCH, H_A, DK_A, DV_A), dt),
        jnp.zeros((DEPTH, BATCH, WINDOW, KV_B, HD_B), dt),
        jnp.zeros((DEPTH, BATCH, WINDOW, KV_B, HD_B), dt),
        jnp.zeros((DEPTH, BATCH, POOL_HIST, W_C), dt),
        jnp.zeros((DEPTH, BATCH, H_D, DK_D, DV_D), dt),
        lb, w_in, w_branch, w_out, g_pre, g_post, attn_sink, w_pool, pool_scale, g_hgrn)
    y_s, r_s, k_s, v_s, pool_s, h_s = trunk(
        x_sample, PAST_LEN, state_ret, cache_swa_k, cache_swa_v, state_pool, state_hgrn,
        lb, w_in, w_branch, w_out, g_pre, g_post, attn_sink, w_pool, pool_scale, g_hgrn)
    return (y_p, y_s, r_p, k_p, v_p, pool_p, h_p, r_s, k_s, v_s, pool_s, h_s)
```

```cpp
#include <hip/hip_runtime.h>
#include <hip/hip_cooperative_groups.h>
#include <cstdio>
#include <cstdint>
#include <cmath>
namespace cg = cooperative_groups;

#define LAS __attribute__((address_space(3)))
typedef unsigned short bf16_t;
typedef short bf16x8 __attribute__((ext_vector_type(8)));
typedef float f32x4 __attribute__((ext_vector_type(4)));
typedef unsigned u32x4 __attribute__((ext_vector_type(4)));

constexpr int M_TOT = 16896, M_P = 16384, DM = 1024, DIN = 7680, NPROJ = 3584, NGATE = 4096, WMIX = 1280;
constexpr int C_QA = 0, C_KA = 128, C_VA = 256, C_ZA = 512, C_QB = 768, C_KB = 1280, C_VB = 1408, C_ZB = 1536, C_UC = 2048, C_ZC = 2304,
              C_QD = 2560, C_FD = 2816, C_ID = 3072, C_ZD = 3328;
constexpr int Y_A = 0, Y_B = 256, Y_C = 768, Y_D = 1024;
constexpr size_t O_YP = 0, O_YS = 16777216, O_RETP = 17301504, O_KP = 17367040, O_VP = 17498112, O_POOLP = 17629184, O_HGRNP = 17659904,
                 O_RETS = 17790976, O_KS = 21985280, O_VS = 30373888, O_POOLS = 38762496, O_HGRNS = 40728576, O_END = 49117184;
constexpr float EPS = 1e-6f;
constexpr int NPOS = 8196;

constexpr size_t MiB = 1u << 20;
constexpr size_t WS_ROPEA = 1 * MiB;
constexpr size_t WS_ROPEB = 3 * MiB;
constexpr size_t WS_LB = 3 * MiB + 768 * 1024;
constexpr size_t WS_WIN = 4 * MiB;
constexpr size_t WS_WB = 64 * MiB;
constexpr size_t WS_WOUT = 74 * MiB;
constexpr size_t WS_H = 82 * MiB;
constexpr size_t WS_PROJ = 115 * MiB;
constexpr size_t WS_GATES = 231 * MiB;
constexpr size_t WS_Y = 363 * MiB;
constexpr size_t WS_KVA = 405 * MiB;
constexpr size_t WS_KVD = 413 * MiB;
constexpr size_t WS_DECD = 429 * MiB;
constexpr size_t WS_END = 430 * MiB;

constexpr int LDS_BYTES = 147456;
constexpr int NTHREADS = 512;

struct Params {
    const float* x_prompt; const float* x_sample; const float* state_ret; const float* cache_k; const float* cache_v; const float* state_pool; const float* state_hgrn;
    const float* w_in; const float* w_branch; const float* w_out; const float* g_pre; const float* g_post; const float* attn_sink; const float* w_pool;
    const float* pool_scale; const float* g_hgrn; const float* lower_bounds;
    float* out; unsigned char* ws;
    double invA[16]; double invB[8];
    int ph_lo, ph_hi, coop, pad;
};

__device__ __forceinline__ float bf2f(bf16_t v) { return __uint_as_float(((unsigned)v) << 16); }
__device__ __forceinline__ bf16_t f2bf(float f) { unsigned u = __float_as_uint(f); return (bf16_t)((u + 0x7fffu + ((u >> 16) & 1u)) >> 16); }
__device__ __forceinline__ unsigned pk2(float lo, float hi) { return (unsigned)f2bf(lo) | ((unsigned)f2bf(hi) << 16); }
__device__ __forceinline__ float lo16(unsigned u) { return __uint_as_float(u << 16); }
__device__ __forceinline__ float hi16(unsigned u) { return __uint_as_float(u & 0xffff0000u); }
__device__ __forceinline__ float sigmoid_(float x) { return 1.f / (1.f + __expf(-x)); }
__device__ __forceinline__ float silu_(float x) { return x / (1.f + __expf(-x)); }
__device__ __forceinline__ float wave_sum(float v) {
    v += __shfl_xor(v, 32); v += __shfl_xor(v, 16); v += __shfl_xor(v, 8); v += __shfl_xor(v, 4); v += __shfl_xor(v, 2); v += __shfl_xor(v, 1); return v;
}
__device__ __forceinline__ float quad16_sum(float v) { v += __shfl_xor(v, 8); v += __shfl_xor(v, 4); v += __shfl_xor(v, 2); v += __shfl_xor(v, 1); return v; }
__device__ __forceinline__ float quad16_max(float v) { v = fmaxf(v, __shfl_xor(v, 8)); v = fmaxf(v, __shfl_xor(v, 4)); v = fmaxf(v, __shfl_xor(v, 2)); v = fmaxf(v, __shfl_xor(v, 1)); return v; }
__device__ __forceinline__ f32x4 mfma16(bf16x8 a, bf16x8 b, f32x4 c) { return __builtin_amdgcn_mfma_f32_16x16x32_bf16(a, b, c, 0, 0, 0); }
__device__ __forceinline__ f32x4 mma_tile(const bf16_t* As, int lda, const bf16_t* Bs, int ldb, int K, f32x4 acc, int lane) {
    const bf16_t* ap = As + (lane & 15) * lda + (lane >> 4) * 8;
    const bf16_t* bp = Bs + (lane & 15) * ldb + (lane >> 4) * 8;
    for (int k = 0; k < K; k += 32) acc = mfma16(*(const bf16x8*)(ap + k), *(const bf16x8*)(bp + k), acc);
    return acc;
}

namespace pg8 {
constexpr int BM = 256, BK = 64, HALF = 128, HTB = HALF * BK * 2, STAGE_BYTES = 8 * HTB, NXCD = 8, WGM = 8;
__host__ __device__ __forceinline__ int lds_byte(int r, int c) { const int st = (r >> 4) * 2 + (c >> 5), rr = r & 15, cc = c & 31, ob = rr * 64 + cc * 2; return st * 1024 + (ob ^ (((ob >> 9) & 1) << 5)); }
__host__ __device__ __forceinline__ void stage_rc(int b, int& R, int& C) { const int st = b / 1024, sb = b % 1024, swz = sb ^ (((sb >> 9) & 1) << 5); R = (st >> 1) * 16 + swz / 64; C = (st & 1) * 32 + (swz % 64) / 2; }
__host__ __device__ __forceinline__ int perm32(int rho) { const int n = rho >> 4, i = rho & 15; return 8 * (i >> 2) + 4 * n + (i & 3); }

struct Unit { int pm, pn, k0, nt, br; };
struct Gemm { const bf16_t* A; const bf16_t* Bt; int lda, ldb; };

struct StaticOrder {
    int nM, nN, nwg, G, c, nt;
    __device__ void init(int M, int N, int K, int G_, int c_) { nM = M / BM; nN = N / BM; nwg = nM * nN; G = G_; c = c_; nt = K / BK; }
    __device__ bool next(int i, Unit& u) const {
        const long L = (long)i * G + c; if (L >= nwg) return false;
        int wgid = (int)L; { const int q = nwg / NXCD, r = nwg % NXCD, xcd = wgid % NXCD, off = wgid / NXCD; wgid = (xcd < r ? xcd * (q + 1) : r * (q + 1) + (xcd - r) * q) + off; }
        const int nig = WGM * nN, gid = wgid / nig, fm = gid * WGM, gsz = (nM - fm) < WGM ? (nM - fm) : WGM;
        u.pm = fm + ((wgid % nig) % gsz); u.pn = (wgid % nig) / gsz; u.k0 = 0; u.nt = nt; u.br = 0; return true;
    }
};
struct TileOrder {
    int ntiles, G, c, nt;
    __device__ bool next(int i, Unit& u) const { const int t = i * G + c; if (t >= ntiles) return false; u.pm = t >> 2; u.pn = t & 3; u.k0 = 0; u.nt = nt; u.br = 0; return true; }
};
struct BranchOrder {
    int ntiles, G, c;
    __device__ bool next(int i, Unit& u) const {
        const int t = (i >> 2) * G + c; if (t >= ntiles) return false; const int br = i & 3;
        u.pm = t >> 2; u.pn = t & 3; u.br = br; u.k0 = br == 0 ? 0 : (br == 1 ? 256 : (br == 2 ? 768 : 1024)); u.nt = br == 1 ? 8 : 4; return true;
    }
};

struct EpiProj {
    bf16_t* proj; bf16_t* gates;
    __device__ __forceinline__ void operator()(const f32x4 (&acc)[2][2][4][2], const Unit& u, int wr, int wc, int fr, int fq) const {
        const int row0 = u.pm * BM + wr * 64 + fr;
        const bool isg = u.pn >= 14;
        bf16_t* base = isg ? gates : proj; const int ld = isg ? NGATE : NPROJ;
        const int col0 = (isg ? (u.pn - 14) : u.pn) * BM + wc * 32 + 8 * fq;
#pragma unroll
        for (int ai = 0; ai < 2; ++ai)
#pragma unroll
            for (int m = 0; m < 4; ++m) { bf16_t* rowp = base + (size_t)(row0 + ai * HALF + m * 16) * ld + col0;
#pragma unroll
                for (int bj = 0; bj < 2; ++bj) { f32x4 v0 = acc[ai][bj][m][0], v1 = acc[ai][bj][m][1];
                    if (isg) {
#pragma unroll
                        for (int i = 0; i < 4; ++i) { v0[i] = sigmoid_(v0[i]); v1[i] = sigmoid_(v1[i]); } }
                    u32x4 w; w.x = pk2(v0[0], v0[1]); w.y = pk2(v0[2], v0[3]); w.z = pk2(v1[0], v1[1]); w.w = pk2(v1[2], v1[3]);
                    *(u32x4*)(rowp + bj * HALF) = w; } }
    }
};
struct EpiBranch {
    const bf16_t* gates; float* mf; bf16_t* mb;
    __device__ __forceinline__ void operator()(const f32x4 (&acc)[2][2][4][2], const Unit& u, int wr, int wc, int fr, int fq) const {
        const int row0 = u.pm * BM + wr * 64 + fr, col0 = u.pn * BM + wc * 32 + 8 * fq;
#pragma unroll
        for (int ai = 0; ai < 2; ++ai)
#pragma unroll
            for (int m = 0; m < 4; ++m) { const size_t row = (size_t)(row0 + ai * HALF + m * 16);
#pragma unroll
                for (int bj = 0; bj < 2; ++bj) { const int col = col0 + bj * HALF;
                    const u32x4 g = *(const u32x4*)(gates + row * NGATE + u.br * 1024 + col);
                    f32x4 v0 = acc[ai][bj][m][0], v1 = acc[ai][bj][m][1];
                    v0[0] *= lo16(g.x); v0[1] *= hi16(g.x); v0[2] *= lo16(g.y); v0[3] *= hi16(g.y);
                    v1[0] *= lo16(g.z); v1[1] *= hi16(g.z); v1[2] *= lo16(g.w); v1[3] *= hi16(g.w);
                    float* p = mf + row * DM + col;
                    if (u.br > 0) { v0 += *(const f32x4*)p; v1 += *(const f32x4*)(p + 4); }
                    if (u.br < 3) { *(f32x4*)p = v0; *(f32x4*)(p + 4) = v1; }
                    else { u32x4 w; w.x = pk2(v0[0], v0[1]); w.y = pk2(v0[2], v0[3]); w.z = pk2(v1[0], v1[1]); w.w = pk2(v1[2], v1[3]); *(u32x4*)(mb + row * DM + col) = w; } } }
    }
};
struct EpiF32 {
    float* o;
    __device__ __forceinline__ void operator()(const f32x4 (&acc)[2][2][4][2], const Unit& u, int wr, int wc, int fr, int fq) const {
        const int row0 = u.pm * BM + wr * 64 + fr, col0 = u.pn * BM + wc * 32 + 8 * fq;
#pragma unroll
        for (int ai = 0; ai < 2; ++ai)
#pragma unroll
            for (int m = 0; m < 4; ++m) { float* rowp = o + (size_t)(row0 + ai * HALF + m * 16) * DM + col0;
#pragma unroll
                for (int bj = 0; bj < 2; ++bj) { *(f32x4*)(rowp + bj * HALF) = acc[ai][bj][m][0]; *(f32x4*)(rowp + bj * HALF + 4) = acc[ai][bj][m][1]; } }
    }
};

template <class Epi, class Sched>
__device__ __forceinline__ void gemm_phase(LAS unsigned char* lds, const Gemm g, const Sched& S, const Epi& E, const int tid) {
    const int wid = __builtin_amdgcn_readfirstlane(tid >> 6), lane = tid & 63, wr = wid >> 2, wc = wid & 3, fr = lane & 15, fq = lane >> 4;
    unsigned voffA[2], voffB[2];
#pragma unroll
    for (int i = 0; i < 2; ++i) { int R, C; stage_rc(tid * 16 + i * 8192, R, C); const int Rb = (R & ~31) + perm32(R & 31);
        voffA[i] = (unsigned)(R * g.lda + C) * 2u; voffB[i] = (unsigned)(Rb * g.ldb + C) * 2u; }
    const size_t kstep = (size_t)(BK * 2);
    const size_t hstepA = (size_t)HALF * g.lda * 2, hstepB = (size_t)HALF * g.ldb * 2;
    const size_t tstepA = 2 * hstepA, tstepB = 2 * hstepB;
    const unsigned ldsw = (unsigned)wid * 1024u;
    const int aoff = lds_byte(wr * 64 + fr, fq * 8), boff = lds_byte(wc * 32 + fr, fq * 8);
#define PG8_SA(b, h) (((b) * 2 + (h)) * HTB)
#define PG8_SB(b, h) ((4 + (b) * 2 + (h)) * HTB)
#define PG8_STAGE(bufoff, gbase, voff) do { _Pragma("unroll") for (int _i = 0; _i < 2; ++_i) \
        __builtin_amdgcn_global_load_lds((const unsigned*)((const char*)(gbase) + (voff)[_i]), (LAS unsigned*)(lds + (bufoff) + ldsw + _i * 8192), 16, 0, 0); } while (0)
#define PG8_LDA(dst, b, h) do { _Pragma("unroll") for (int m = 0; m < 4; ++m) _Pragma("unroll") for (int k = 0; k < 2; ++k) dst[m][k] = *(const LAS bf16x8*)(lds + PG8_SA(b, h) + aoff + m * 2048 + k * 1024); } while (0)
#define PG8_LDB(dst, b, h) do { _Pragma("unroll") for (int n = 0; n < 2; ++n) _Pragma("unroll") for (int k = 0; k < 2; ++k) dst[n][k] = *(const LAS bf16x8*)(lds + PG8_SB(b, h) + boff + n * 2048 + k * 1024); } while (0)
#define PG8_MMA(ai, bj, At, Bt) do { __builtin_amdgcn_s_setprio(1); _Pragma("unroll") for (int m = 0; m < 4; ++m) _Pragma("unroll") for (int n = 0; n < 2; ++n) _Pragma("unroll") for (int k = 0; k < 2; ++k) \
        acc[ai][bj][m][n] = __builtin_amdgcn_mfma_f32_16x16x32_bf16(Bt[n][k], At[m][k], acc[ai][bj][m][n], 0, 0, 0); __builtin_amdgcn_s_setprio(0); } while (0)
#define PG8_WAIT_V(n) asm volatile("s_waitcnt vmcnt(" #n ")" ::: "memory")
#define PG8_WAIT_L(n) asm volatile("s_waitcnt lgkmcnt(" #n ")" ::: "memory")
#define PG8_BAR __builtin_amdgcn_s_barrier()
#define PG8_SCHED __builtin_amdgcn_sched_barrier(0)
    Unit cur, nxt; int ui = 0;
    if (!S.next(0, cur)) return;
    f32x4 acc[2][2][4][2];
#pragma unroll
    for (int a = 0; a < 2; ++a)
#pragma unroll
        for (int b = 0; b < 2; ++b)
#pragma unroll
            for (int m = 0; m < 4; ++m)
#pragma unroll
                for (int n = 0; n < 2; ++n) acc[a][b][m][n] = (f32x4){0.f, 0.f, 0.f, 0.f};
    bf16x8 At[4][2], B0[2][2], B1[2][2];
    const char* cA = (const char*)g.A + (size_t)cur.pm * tstepA + (size_t)cur.k0 * 2; const char* cB = (const char*)g.Bt + (size_t)cur.pn * tstepB + (size_t)cur.k0 * 2;
    PG8_STAGE(PG8_SB(0, 0), cB, voffB); PG8_STAGE(PG8_SB(0, 1), cB + hstepB, voffB); PG8_STAGE(PG8_SA(0, 0), cA, voffA); PG8_STAGE(PG8_SA(0, 1), cA + hstepA, voffA);
    if (wr == 1) PG8_BAR;
    PG8_WAIT_V(2); PG8_BAR;
    PG8_STAGE(PG8_SB(1, 0), cB + kstep, voffB); PG8_STAGE(PG8_SA(1, 0), cA + kstep, voffA); PG8_STAGE(PG8_SB(1, 1), cB + hstepB + kstep, voffB);
    PG8_WAIT_V(6); PG8_BAR;
    for (;;) {
        const bool has_next = S.next(ui + 1, nxt);
        const char* nA = has_next ? (const char*)g.A + (size_t)nxt.pm * tstepA + (size_t)nxt.k0 * 2 : cA;
        const char* nB = has_next ? (const char*)g.Bt + (size_t)nxt.pn * tstepB + (size_t)nxt.k0 * 2 : cB;
        const int nt = cur.nt;
        for (int t = 0; t < nt; t += 2) {
            const bool last = (t == nt - 2);
            const char* a1 = cA + (size_t)(t + 1) * kstep;
            const char* a2 = last ? nA : cA + (size_t)(t + 2) * kstep; const char* b2 = last ? nB : cB + (size_t)(t + 2) * kstep;
            const char* a3 = a2 + kstep; const char* b3 = b2 + kstep;
            PG8_LDB(B0, 0, 0); PG8_LDB(B1, 0, 1); PG8_SCHED; PG8_LDA(At, 0, 0); PG8_STAGE(PG8_SA(1, 1), a1 + hstepA, voffA);
            PG8_WAIT_V(8); PG8_WAIT_L(0); PG8_BAR; PG8_MMA(0, 0, At, B0); PG8_MMA(0, 1, At, B1); PG8_BAR; PG8_SCHED;
            PG8_LDA(At, 0, 1); PG8_STAGE(PG8_SB(0, 0), b2, voffB); PG8_STAGE(PG8_SB(0, 1), b2 + hstepB, voffB); PG8_STAGE(PG8_SA(0, 0), a2, voffA);
            PG8_WAIT_V(8); PG8_WAIT_L(0); PG8_BAR; PG8_MMA(1, 0, At, B0); PG8_MMA(1, 1, At, B1); PG8_BAR; PG8_SCHED;
            PG8_LDB(B0, 1, 0); PG8_LDB(B1, 1, 1); PG8_SCHED; PG8_LDA(At, 1, 0); PG8_STAGE(PG8_SA(0, 1), a2 + hstepA, voffA);
            PG8_WAIT_V(8); PG8_WAIT_L(0); PG8_BAR; PG8_MMA(0, 0, At, B0); PG8_MMA(0, 1, At, B1); PG8_BAR; PG8_SCHED;
            PG8_LDA(At, 1, 1); PG8_STAGE(PG8_SB(1, 0), b3, voffB); PG8_STAGE(PG8_SB(1, 1), b3 + hstepB, voffB); PG8_STAGE(PG8_SA(1, 0), a3, voffA);
            PG8_WAIT_V(8); PG8_WAIT_L(0); PG8_BAR; PG8_MMA(1, 0, At, B0); PG8_MMA(1, 1, At, B1); PG8_BAR; PG8_SCHED;
        }
        if (wr == 0) PG8_BAR;
        E(acc, cur, wr, wc, fr, fq);
        if (!has_next) break;
#pragma unroll
        for (int a = 0; a < 2; ++a)
#pragma unroll
            for (int b = 0; b < 2; ++b)
#pragma unroll
                for (int m = 0; m < 4; ++m)
#pragma unroll
                    for (int n = 0; n < 2; ++n) acc[a][b][m][n] = (f32x4){0.f, 0.f, 0.f, 0.f};
        cur = nxt; cA = nA; cB = nB; ++ui;
        if (wr == 1) PG8_BAR;
    }
    PG8_WAIT_V(0);
    PG8_BAR;
#undef PG8_SA
#undef PG8_SB
#undef PG8_STAGE
#undef PG8_LDA
#undef PG8_LDB
#undef PG8_MMA
#undef PG8_WAIT_V
#undef PG8_WAIT_L
#undef PG8_BAR
#undef PG8_SCHED
}
}

struct Ctx {
    int bx;
    bf16_t *win, *wb, *wout, *h, *proj, *gates, *y, *mb;
    float *mf, *of, *kva, *kvd, *decd, *ropeAc, *ropeAs, *ropeBc, *ropeBs, *lbt;
    int tid, lane, w, G;
};

__device__ __forceinline__ void transpose_tile(const float* src, int N, bf16_t* dst, int Kp, int k0, int n0, float* scr, int tid) {
    const int kk = tid >> 3, c8 = (tid & 7) * 8;
    const float4* s = (const float4*)(src + (size_t)(k0 + kk) * N + n0 + c8);
    const float4 a = s[0], b = s[1];
    float* r = scr + kk * 65 + c8;
    r[0] = a.x; r[1] = a.y; r[2] = a.z; r[3] = a.w; r[4] = b.x; r[5] = b.y; r[6] = b.z; r[7] = b.w;
    __syncthreads();
    const int n = tid >> 3, k8 = (tid & 7) * 8;
    const float* q = scr + k8 * 65 + n;
    u32x4 wv; wv.x = pk2(q[0], q[65]); wv.y = pk2(q[130], q[195]); wv.z = pk2(q[260], q[325]); wv.w = pk2(q[390], q[455]);
    *(u32x4*)(dst + (size_t)(n0 + n) * Kp + k0 + k8) = wv;
    __syncthreads();
}

__device__ __forceinline__ void phase_prologue(const Params& P, Ctx& C, unsigned char* lds) {
    const int tid = C.tid;
    float* scr = (float*)lds;
    for (int job = C.bx; job < 4 * 2496; job += C.G) {
        const int l = job / 2496, j = job % 2496;
        if (j < 1920) { const int kt = j / 120, nt = j % 120; transpose_tile(P.w_in + (size_t)l * DM * DIN, DIN, C.win + (size_t)l * DIN * DM, DM, kt * 64, nt * 64, scr, tid); }
        else if (j < 2240) { const int jj = j - 1920, kt = jj / 16, nt = jj % 16; transpose_tile(P.w_branch + (size_t)l * WMIX * DM, DM, C.wb + (size_t)l * DM * WMIX, WMIX, kt * 64, nt * 64, scr, tid); }
        else { const int jj = j - 2240, kt = jj / 16, nt = jj % 16; transpose_tile(P.w_out + (size_t)l * DM * DM, DM, C.wout + (size_t)l * DM * DM, DM, kt * 64, nt * 64, scr, tid); }
    }
    for (int row = C.bx * 8 + C.w; row < M_TOT; row += C.G * 8) {
        const float* xs = row < M_P ? P.x_prompt + (size_t)row * DM : P.x_sample + (size_t)(row - M_P) * DM;
        float4 x[4]; float ss = 0.f;
#pragma unroll
        for (int i = 0; i < 4; ++i) { x[i] = ((const float4*)xs)[C.lane + 64 * i]; ss += x[i].x * x[i].x + x[i].y * x[i].y + x[i].z * x[i].z + x[i].w * x[i].w; }
        ss = wave_sum(ss); const float r = rsqrtf(ss * (1.f / DM) + EPS);
#pragma unroll
        for (int i = 0; i < 4; ++i) { ((float4*)(P.out + (size_t)row * DM))[C.lane + 64 * i] = x[i];
            const float4 g = ((const float4*)P.g_pre)[C.lane + 64 * i];
            uint2 o; o.x = pk2(x[i].x * r * g.x, x[i].y * r * g.y); o.y = pk2(x[i].z * r * g.z, x[i].w * r * g.w);
            ((uint2*)(C.h + (size_t)row * DM))[C.lane + 64 * i] = o; }
    }
    const int gt = C.bx * NTHREADS + tid, gn = C.G * NTHREADS;
    const double TWO_PI = 6.283185307179586476925286766559, INV_2PI = 0.15915494309189533576888376337251;
    for (int i = gt; i < NPOS * 24; i += gn) {
        int pos, f; double inv;
        if (i < NPOS * 16) { pos = i >> 4; f = i & 15; inv = P.invA[f]; } else { const int k = i - NPOS * 16; pos = k >> 3; f = k & 7; inv = P.invB[f]; }
        double r = (double)pos * inv * INV_2PI; r -= floor(r);
        const float a = (float)(r * TWO_PI);
        const float cs = cosf(a), sn = sinf(a);
        if (i < NPOS * 16) { C.ropeAc[i] = cs; C.ropeAs[i] = sn; } else { C.ropeBc[i - NPOS * 16] = cs; C.ropeBs[i - NPOS * 16] = sn; }
    }
    for (int c = gt; c < 256; c += gn) {
        const float v0 = P.lower_bounds[c], v1 = P.lower_bounds[256 + c], v2 = P.lower_bounds[512 + c], v3 = P.lower_bounds[768 + c];
        const float m = fmaxf(fmaxf(v0, v1), fmaxf(v2, v3));
        const float e0 = expf(v0 - m), e1 = expf(v1 - m), e2 = expf(v2 - m), e3 = expf(v3 - m), inv = 1.f / (e0 + e1 + e2 + e3);
        C.lbt[c] = 0.f; C.lbt[256 + c] = e1 * inv; C.lbt[512 + c] = (e1 + e2) * inv; C.lbt[768 + c] = (e1 + e2 + e3) * inv;
    }
}

__device__ __forceinline__ void attn_prompt_unit(const Params& P, Ctx& C, int l, int b, int qb, int kvh, unsigned char* lds) {
    const int tid = C.tid, lane = C.lane, w = C.w, fr = lane & 15, fq = lane >> 4;
    bf16_t* Ks = (bf16_t*)lds;
    bf16_t* Vt = (bf16_t*)(lds + 36864);
    bf16_t* Ps = (bf16_t*)(lds + 36864 + 35840) + w * (16 * 168);
    const int t0 = qb * 128; const size_t R0 = (size_t)b * 8192 + t0;
    const bool last = (qb == 63);
    for (int i = tid; i < 256 * 7; i += NTHREADS) {
        const int kk = i / 7, task = i - kk * 7, tk = t0 - 128 + kk;
        bf16_t* dst = Ks + kk * 72;
        if (tk < 0) { const u32x4 z = {0u, 0u, 0u, 0u}; if (task == 0) { *(u32x4*)dst = z; *(u32x4*)(dst + 8) = z; } else *(u32x4*)(dst + (task + 1) * 8) = z; }
        else {
            const bf16_t* src = C.proj + (size_t)(b * 8192 + tk) * NPROJ + C_KB + kvh * 64;
            float* kp = P.out + O_KP + ((((size_t)l * 2 + b) * 128 + (kk - 128)) * 2 + kvh) * 64;
            if (task == 0) {
                const u32x4 a = *(const u32x4*)src, bb = *(const u32x4*)(src + 8);
                const float4 c0 = *(const float4*)(C.ropeBc + tk * 8), c1 = *(const float4*)(C.ropeBc + tk * 8 + 4), s0 = *(const float4*)(C.ropeBs + tk * 8), s1 = *(const float4*)(C.ropeBs + tk * 8 + 4);
                const float x1[8] = {lo16(a.x), hi16(a.x), lo16(a.y), hi16(a.y), lo16(a.z), hi16(a.z), lo16(a.w), hi16(a.w)};
                const float x2[8] = {lo16(bb.x), hi16(bb.x), lo16(bb.y), hi16(bb.y), lo16(bb.z), hi16(bb.z), lo16(bb.w), hi16(bb.w)};
                const float cs[8] = {c0.x, c0.y, c0.z, c0.w, c1.x, c1.y, c1.z, c1.w}, sn[8] = {s0.x, s0.y, s0.z, s0.w, s1.x, s1.y, s1.z, s1.w};
                float r1[8], r2[8];
#pragma unroll
                for (int j = 0; j < 8; ++j) { r1[j] = x1[j] * cs[j] - x2[j] * sn[j]; r2[j] = x2[j] * cs[j] + x1[j] * sn[j]; }
                u32x4 o1, o2; o1.x = pk2(r1[0], r1[1]); o1.y = pk2(r1[2], r1[3]); o1.z = pk2(r1[4], r1[5]); o1.w = pk2(r1[6], r1[7]);
                o2.x = pk2(r2[0], r2[1]); o2.y = pk2(r2[2], r2[3]); o2.z = pk2(r2[4], r2[5]); o2.w = pk2(r2[6], r2[7]);
                *(u32x4*)dst = o1; *(u32x4*)(dst + 8) = o2;
                if (last && kk >= 128) {
#pragma unroll
                    for (int j = 0; j < 8; ++j) { kp[j] = r1[j]; kp[8 + j] = r2[j]; } }
            } else {
                const int c = task + 1; const u32x4 a = *(const u32x4*)(src + c * 8); *(u32x4*)(dst + c * 8) = a;
                if (last && kk >= 128) { float* o = kp + c * 8; o[0] = lo16(a.x); o[1] = hi16(a.x); o[2] = lo16(a.y); o[3] = hi16(a.y); o[4] = lo16(a.z); o[5] = hi16(a.z); o[6] = lo16(a.w); o[7] = hi16(a.w); }
            }
        }
    }
    for (int i = tid; i < 256 * 8; i += NTHREADS) {
        const int kk = i >> 3, c = i & 7, tk = t0 - 128 + kk;
        u32x4 a = {0u, 0u, 0u, 0u};
        if (tk >= 0) a = *(const u32x4*)(C.proj + (size_t)(b * 8192 + tk) * NPROJ + C_VB + kvh * 64 + c * 8);
        bf16_t* d = Vt + (c * 8) * 280 + kk;
        d[0] = (bf16_t)(a.x & 0xffff); d[280] = (bf16_t)(a.x >> 16); d[560] = (bf16_t)(a.y & 0xffff); d[840] = (bf16_t)(a.y >> 16);
        d[1120] = (bf16_t)(a.z & 0xffff); d[1400] = (bf16_t)(a.z >> 16); d[1680] = (bf16_t)(a.w & 0xffff); d[1960] = (bf16_t)(a.w >> 16);
        if (last && kk >= 128) { float* o = P.out + O_VP + ((((size_t)l * 2 + b) * 128 + (kk - 128)) * 2 + kvh) * 64 + c * 8;
            o[0] = lo16(a.x); o[1] = hi16(a.x); o[2] = lo16(a.y); o[3] = hi16(a.y); o[4] = lo16(a.z); o[5] = hi16(a.z); o[6] = lo16(a.w); o[7] = hi16(a.w); }
    }
    for (int i = tid; i < 64 * 24; i += NTHREADS) Vt[(i / 24) * 280 + 256 + (i % 24)] = 0;
    for (int i = lane; i < 16 * 16; i += 64) Ps[(i >> 4) * 168 + 144 + (i & 15)] = 0;
    __syncthreads();
    const int tq = t0 + w * 16 + fr;
    for (int g = 0; g < 4; ++g) {
        const int h = kvh * 4 + g;
        const bf16_t* qsrc = C.proj + (R0 + w * 16 + fr) * NPROJ + C_QB + h * 64;
        u32x4 q0 = *(const u32x4*)(qsrc + fq * 8); const u32x4 q1 = *(const u32x4*)(qsrc + 32 + fq * 8);
        if (fq < 2) {
            const u32x4 qp = *(const u32x4*)(qsrc + (fq ^ 1) * 8);
            const float4 c0 = *(const float4*)(C.ropeBc + tq * 8), c1 = *(const float4*)(C.ropeBc + tq * 8 + 4), s0 = *(const float4*)(C.ropeBs + tq * 8), s1 = *(const float4*)(C.ropeBs + tq * 8 + 4);
            const float sg = fq == 0 ? -1.f : 1.f;
            const float own[8] = {lo16(q0.x), hi16(q0.x), lo16(q0.y), hi16(q0.y), lo16(q0.z), hi16(q0.z), lo16(q0.w), hi16(q0.w)};
            const float par[8] = {lo16(qp.x), hi16(qp.x), lo16(qp.y), hi16(qp.y), lo16(qp.z), hi16(qp.z), lo16(qp.w), hi16(qp.w)};
            const float cs[8] = {c0.x, c0.y, c0.z, c0.w, c1.x, c1.y, c1.z, c1.w}, sn[8] = {s0.x, s0.y, s0.z, s0.w, s1.x, s1.y, s1.z, s1.w};
            float r[8];
#pragma unroll
            for (int j = 0; j < 8; ++j) r[j] = own[j] * cs[j] + sg * par[j] * sn[j];
            q0.x = pk2(r[0], r[1]); q0.y = pk2(r[2], r[3]); q0.z = pk2(r[4], r[5]); q0.w = pk2(r[6], r[7]);
        }
        const bf16x8 qa0 = __builtin_bit_cast(bf16x8, q0), qa1 = __builtin_bit_cast(bf16x8, q1);
        f32x4 S[9];
#pragma unroll
        for (int jt = 0; jt < 9; ++jt) {
            const bf16_t* kp = Ks + ((w + jt) * 16 + fr) * 72 + fq * 8;
            f32x4 a = {0.f, 0.f, 0.f, 0.f};
            a = mfma16(qa0, *(const bf16x8*)kp, a); a = mfma16(qa1, *(const bf16x8*)(kp + 32), a);
            S[jt] = a;
        }
        const float sink = P.attn_sink[l * 8 + h];
        float mx[4], sm[4];
#pragma unroll
        for (int j = 0; j < 4; ++j) {
            const int r = w * 16 + fq * 4 + j;
            float m = -1e30f;
#pragma unroll
            for (int jt = 0; jt < 9; ++jt) { const int kk = (w + jt) * 16 + fr; const bool ok = (kk >= r) && (kk <= r + 128) && (t0 - 128 + kk >= 0);
                const float s = ok ? S[jt][j] * 0.125f : -1e30f; S[jt][j] = s; m = fmaxf(m, s); }
            m = fmaxf(quad16_max(m), sink); mx[j] = m;
            float su = 0.f;
#pragma unroll
            for (int jt = 0; jt < 9; ++jt) { const float p = __expf(S[jt][j] - m); su += p; Ps[(fq * 4 + j) * 168 + jt * 16 + fr] = f2bf(p); }
            su = quad16_sum(su) + __expf(sink - m); sm[j] = 1.f / su;
        }
        __syncthreads();
        f32x4 O[4];
#pragma unroll
        for (int nt = 0; nt < 4; ++nt) O[nt] = (f32x4){0.f, 0.f, 0.f, 0.f};
#pragma unroll
        for (int kx = 0; kx < 5; ++kx) {
            const bf16x8 a = *(const bf16x8*)(Ps + fr * 168 + kx * 32 + fq * 8);
#pragma unroll
            for (int nt = 0; nt < 4; ++nt) O[nt] = mfma16(a, *(const bf16x8*)(Vt + (nt * 16 + fr) * 280 + w * 16 + kx * 32 + fq * 8), O[nt]);
        }
#pragma unroll
        for (int j = 0; j < 4; ++j) {
            const size_t row = R0 + w * 16 + fq * 4 + j;
#pragma unroll
            for (int nt = 0; nt < 4; ++nt) { const int e = nt * 16 + fr;
                const float z = bf2f(C.proj[row * NPROJ + C_ZB + h * 64 + e]);
                C.y[row * WMIX + Y_B + h * 64 + e] = f2bf(O[nt][j] * sm[j] * silu_(z)); }
        }
        __syncthreads();
    }
}

__device__ __forceinline__ void pool_prompt_unit(const Params& P, Ctx& C, int l, int tile, unsigned char* lds) {
    const int tid = C.tid, lane = C.lane, w = C.w, fr = lane & 15, fq = lane >> 4;
    bf16_t* U = (bf16_t*)lds;
    bf16_t* A = (bf16_t*)(lds + 40448);
    bf16_t* Wt = (bf16_t*)(lds + 40448 + 33792);
    const int b = tile >> 7, t0 = (tile & 127) * 64; const size_t R0 = (size_t)b * 8192 + t0;
    for (int i = tid; i < 79 * 32; i += NTHREADS) { const int r = i >> 5, c = i & 31, t = t0 - 15 + r;
        u32x4 a = {0u, 0u, 0u, 0u}; if (t >= 0) a = *(const u32x4*)(C.proj + (size_t)(b * 8192 + t) * NPROJ + C_UC + c * 8);
        *(u32x4*)(U + r * 256 + c * 8) = a; }
    for (int i = tid; i < 4 * 64 * 64; i += NTHREADS) { const int g = i >> 12, cin = (i >> 6) & 63, dout = i & 63;
        Wt[(g * 64 + dout) * 72 + cin] = f2bf(P.w_pool[(size_t)l * 16384 + i]); }
    __syncthreads();
    { const int c = tid & 255, rh = tid >> 8, g = c >> 6, wn = 2 << g;
      for (int r = rh * 32; r < rh * 32 + 32; ++r) {
          float s = 0.f; for (int j = 0; j < wn; ++j) s += bf2f(U[(r + 15 - j) * 256 + c]);
          const int pos = t0 + r; const float cnt = (float)(pos + 1 < wn ? pos + 1 : wn);
          const float u = bf2f(U[(r + 15) * 256 + c]);
          A[r * 264 + c] = f2bf(s / cnt - u);
          if (t0 == 8128 && r >= 49) P.out[O_POOLP + (((size_t)l * 2 + b) * 15 + (r - 49)) * 256 + c] = u;
      } }
    __syncthreads();
    for (int tl = w; tl < 64; tl += 8) { const int rt = tl >> 4, ct = tl & 15, g = ct >> 2;
        f32x4 acc = {0.f, 0.f, 0.f, 0.f};
        acc = mma_tile(A + rt * 16 * 264 + g * 64, 264, Wt + (g * 64 + (ct & 3) * 16) * 72, 72, 64, acc, lane);
        const int c = ct * 16 + fr; const float sc = P.pool_scale[l * 256 + c];
#pragma unroll
        for (int j = 0; j < 4; ++j) { const size_t row = R0 + rt * 16 + fq * 4 + j;
            const float z = bf2f(C.proj[row * NPROJ + C_ZC + c]);
            C.y[row * WMIX + Y_C + c] = f2bf(acc[j] * sc * silu_(z)); }
    }
    __syncthreads();
}

template <bool IS_D, bool KV>
__device__ __forceinline__ void lin_chunk(const Params& P, Ctx& C, int l, int b, int n, unsigned char* lds) {
    const int tid = C.tid, lane = C.lane, w = C.w, fr = lane & 15, fq = lane >> 4;
    constexpr int DK = IS_D ? 64 : 32;
    float* Bc = (float*)lds;
    bf16_t* Qh = (bf16_t*)(lds + 65536);
    bf16_t* Kh = (bf16_t*)(lds + 74752);
    bf16_t* PQ = (bf16_t*)(lds + 83968);
    bf16_t* VS = (bf16_t*)(lds + 101376);
    bf16_t* KdT = (bf16_t*)(lds + 118784);
    const size_t R0 = (size_t)b * 8192 + n * 64;
    if (IS_D) {
        for (int i = tid; i < 64 * 256; i += NTHREADS) { const int t = i >> 8, c = i & 255;
            const float fv = bf2f(C.proj[(R0 + t) * NPROJ + C_FD + c]); const float lb = C.lbt[l * 256 + c];
            Bc[i] = __logf(lb + (1.f - lb) * sigmoid_(fv)); }
        __syncthreads();
        if (tid < 256) { float a = 0.f; for (int t = 0; t < 64; ++t) { a += Bc[t * 256 + tid]; Bc[t * 256 + tid] = a; } }
        __syncthreads();
    }
    for (int h = 0; h < 4; ++h) {
        float lg = 0.f; if (!IS_D) lg = log1pf(-exp2f(-5.f - (float)h));
        for (int i = tid; i < 64 * DK; i += NTHREADS) {
            const int t = i / DK, d = i % DK;
            float q, k, Bt, Bm, Bl;
            if (IS_D) { const int c = h * 64 + d;
                q = silu_(bf2f(C.proj[(R0 + t) * NPROJ + C_QD + c]));
                const float fv = bf2f(C.proj[(R0 + t) * NPROJ + C_FD + c]); const float lb = C.lbt[l * 256 + c];
                k = 1.f - (lb + (1.f - lb) * sigmoid_(fv));
                Bt = Bc[t * 256 + c]; Bm = Bc[31 * 256 + c]; Bl = Bc[63 * 256 + c];
            } else { const int ii = d & 15, pos = n * 64 + t;
                const bf16_t* pr = C.proj + (R0 + t) * NPROJ;
                const float cs = C.ropeAc[pos * 16 + ii], sn = C.ropeAs[pos * 16 + ii];
                const float q1 = bf2f(pr[C_QA + h * 32 + ii]), q2 = bf2f(pr[C_QA + h * 32 + 16 + ii]);
                const float k1 = bf2f(pr[C_KA + h * 32 + ii]), k2 = bf2f(pr[C_KA + h * 32 + 16 + ii]);
                q = d < 16 ? q1 * cs - q2 * sn : q2 * cs + q1 * sn;
                k = (d < 16 ? k1 * cs - k2 * sn : k2 * cs + k1 * sn) * 0.17677669529663687f;
                Bt = (float)(t + 1) * lg; Bm = 32.f * lg; Bl = 64.f * lg;
            }
            if (!KV) { Qh[t * 72 + d] = f2bf(q * __expf(Bt - Bm)); Kh[t * 72 + d] = f2bf(k * __expf(Bm - Bt)); PQ[t * 136 + 64 + d] = f2bf(q * __expf(Bt)); }
            else KdT[d * 72 + t] = f2bf(k * __expf(Bl - Bt));
        }
        for (int i = tid; i < 64 * 64; i += NTHREADS) { const int s = i >> 6, e = i & 63;
            VS[e * 136 + s] = C.proj[(R0 + s) * NPROJ + (IS_D ? C_ID : C_VA) + h * 64 + e]; }
        float* kvbase = (IS_D ? C.kvd : C.kva) + ((size_t)(b * 128 + n) * 4 + h) * (DK * 64);
        if (!KV) for (int i = tid; i < DK * 64; i += NTHREADS) { const int d = i >> 6, e = i & 63; VS[e * 136 + 64 + d] = f2bf(kvbase[i]); }
        __syncthreads();
        if (KV) {
            for (int tl = w; tl < (DK / 16) * 4; tl += 8) { const int dt = tl >> 2, et = tl & 3;
                f32x4 acc = {0.f, 0.f, 0.f, 0.f};
                acc = mma_tile(KdT + dt * 16 * 72, 72, VS + et * 16 * 136, 136, 64, acc, lane);
#pragma unroll
                for (int j = 0; j < 4; ++j) kvbase[(dt * 16 + fq * 4 + j) * 64 + et * 16 + fr] = acc[j]; }
            if (IS_D && tid < 64) C.decd[(size_t)(b * 128 + n) * 256 + h * 64 + tid] = __expf(Bc[63 * 256 + h * 64 + tid]);
        } else {
            for (int tl = w; tl < 16; tl += 8) { const int rt = tl >> 2, ct = tl & 3;
                f32x4 acc = {0.f, 0.f, 0.f, 0.f};
                if (ct <= rt) acc = mma_tile(Qh + rt * 16 * 72, 72, Kh + ct * 16 * 72, 72, DK, acc, lane);
#pragma unroll
                for (int j = 0; j < 4; ++j) { const int t = rt * 16 + fq * 4 + j, s = ct * 16 + fr; PQ[t * 136 + s] = f2bf(s <= t ? acc[j] : 0.f); } }
            __syncthreads();
            if (w < 4) { const int rt = w;
                f32x4 O[4];
#pragma unroll
                for (int et = 0; et < 4; ++et) { O[et] = (f32x4){0.f, 0.f, 0.f, 0.f}; O[et] = mma_tile(PQ + rt * 16 * 136, 136, VS + et * 16 * 136, 136, 64 + DK, O[et], lane); }
#pragma unroll
                for (int j = 0; j < 4; ++j) {
                    float ss = O[0][j] * O[0][j] + O[1][j] * O[1][j] + O[2][j] * O[2][j] + O[3][j] * O[3][j];
                    ss = quad16_sum(ss); const float r = rsqrtf(ss * (1.f / 64.f) + EPS);
                    const size_t row = R0 + rt * 16 + fq * 4 + j;
#pragma unroll
                    for (int et = 0; et < 4; ++et) { const int e = et * 16 + fr;
                        const float z = bf2f(C.proj[row * NPROJ + (IS_D ? C_ZD : C_ZA) + h * 64 + e]);
                        const float gsc = IS_D ? P.g_hgrn[l * 256 + h * 64 + e] : 1.f;
                        C.y[row * WMIX + (IS_D ? Y_D : Y_A) + h * 64 + e] = f2bf(O[et][j] * r * gsc * silu_(z)); }
                }
            }
        }
        __syncthreads();
    }
}

__device__ __forceinline__ void sample_unit(const Params& P, Ctx& C, int l, int sb, unsigned char* lds) {
    const int tid = C.tid, lane = C.lane, w = C.w;
    bf16_t* prb = (bf16_t*)lds;
    float* qa = (float*)(lds + 28672);
    float* ka = qa + 512;
    float* qd = ka + 512;
    float* fd = qd + 1024;
    float* qbq = fd + 1024;
    float* kn = qbq + 2048;
    float* pl = kn + 512;
    float* ps = pl + 1024;
    float* kv = ps + 32 * 136;
    const size_t R0 = (size_t)M_P + sb * 4;
    for (int i = tid; i < 4 * 448; i += NTHREADS) { const int t = i / 448, c = i % 448;
        *(u32x4*)(prb + t * NPROJ + c * 8) = *(const u32x4*)(C.proj + (R0 + t) * NPROJ + c * 8); }
    __syncthreads();
#define PR(t, c) bf2f(prb[(t) * NPROJ + (c)])
    {
        const int t = tid >> 7, c = tid & 127, h = c >> 5, d = c & 31, ii = d & 15, pos = 8192 + t;
        const float cs = C.ropeAc[pos * 16 + ii], sn = C.ropeAs[pos * 16 + ii];
        const float q1 = PR(t, C_QA + h * 32 + ii), q2 = PR(t, C_QA + h * 32 + 16 + ii), k1 = PR(t, C_KA + h * 32 + ii), k2 = PR(t, C_KA + h * 32 + 16 + ii);
        qa[tid] = d < 16 ? q1 * cs - q2 * sn : q2 * cs + q1 * sn;
        ka[tid] = (d < 16 ? k1 * cs - k2 * sn : k2 * cs + k1 * sn) * 0.17677669529663687f;
    }
    for (int i = tid; i < 1024; i += NTHREADS) { const int t = i >> 8, c = i & 255;
        qd[i] = silu_(PR(t, C_QD + c)); const float lb = C.lbt[l * 256 + c]; fd[i] = lb + (1.f - lb) * sigmoid_(PR(t, C_FD + c));
        const int g = c >> 6, wn = 2 << g; float s = 0.f;
        for (int j = 0; j < wn; ++j) { const int e = 15 + t - j; s += e >= 15 ? PR(e - 15, C_UC + c) : P.state_pool[(((size_t)l * 128 + sb) * 15 + e) * 256 + c]; }
        pl[i] = s / (float)wn - PR(t, C_UC + c); }
    for (int i = tid; i < 2048; i += NTHREADS) { const int t = i >> 9, c = i & 511, h = c >> 6, d = c & 63; const int pos = 8192 + t;
        float v;
        if (d < 16) { const int ii = d & 7; const float cs = C.ropeBc[pos * 8 + ii], sn = C.ropeBs[pos * 8 + ii];
            const float x1 = PR(t, C_QB + h * 64 + ii), x2 = PR(t, C_QB + h * 64 + 8 + ii); v = d < 8 ? x1 * cs - x2 * sn : x2 * cs + x1 * sn; }
        else v = PR(t, C_QB + c);
        qbq[i] = v * 0.125f; }
    { const int t = tid >> 7, c = tid & 127, kh = c >> 6, d = c & 63, pos = 8192 + t;
        float v;
        if (d < 16) { const int ii = d & 7; const float cs = C.ropeBc[pos * 8 + ii], sn = C.ropeBs[pos * 8 + ii];
            const float x1 = PR(t, C_KB + kh * 64 + ii), x2 = PR(t, C_KB + kh * 64 + 8 + ii); v = d < 8 ? x1 * cs - x2 * sn : x2 * cs + x1 * sn; }
        else v = PR(t, C_KB + c);
        kn[tid] = v;
        P.out[O_KS + (((size_t)l * 128 + sb) * 128 + 124 + t) * 128 + c] = v;
        P.out[O_VS + (((size_t)l * 128 + sb) * 128 + 124 + t) * 128 + c] = PR(t, C_VB + c); }
    for (int i = tid; i < 15 * 256; i += NTHREADS) { const int r = i >> 8, c = i & 255;
        P.out[O_POOLS + (((size_t)l * 128 + sb) * 15 + r) * 256 + c] = r < 11 ? P.state_pool[(((size_t)l * 128 + sb) * 15 + r + 4) * 256 + c] : PR(r - 11, C_UC + c); }
    { const float* kc = P.cache_k + ((size_t)l * 128 + sb) * 16384; float* ko = P.out + O_KS + ((size_t)l * 128 + sb) * 16384;
      for (int i = tid; i < 4096; i += NTHREADS) { const float4 v = ((const float4*)kc)[i]; const int e = i * 4, wq = e >> 7, r = e & 127, kh = r >> 6, d = r & 63;
          float* dst = kv + (wq * 2 + kh) * 65 + d; dst[0] = v.x; dst[1] = v.y; dst[2] = v.z; dst[3] = v.w;
          if (wq >= 4) ((float4*)ko)[i - 128] = v; } }
    __syncthreads();
    if (w < 4) { const int h = w, e = lane;
        const float gam = 1.f - exp2f(-5.f - (float)h);
        const float* S0 = P.state_ret + (((size_t)l * 128 + sb) * 4 + h) * 2048; float* S1 = P.out + O_RETS + (((size_t)l * 128 + sb) * 4 + h) * 2048;
        const float v0 = PR(0, C_VA + h * 64 + e), v1 = PR(1, C_VA + h * 64 + e), v2 = PR(2, C_VA + h * 64 + e), v3 = PR(3, C_VA + h * 64 + e);
        float o0 = 0.f, o1 = 0.f, o2 = 0.f, o3 = 0.f;
#pragma unroll 8
        for (int d = 0; d < 32; ++d) { float s = S0[d * 64 + e]; const int c = h * 32 + d;
            s = gam * s + ka[c] * v0; o0 += qa[c] * s; s = gam * s + ka[128 + c] * v1; o1 += qa[128 + c] * s;
            s = gam * s + ka[256 + c] * v2; o2 += qa[256 + c] * s; s = gam * s + ka[384 + c] * v3; o3 += qa[384 + c] * s; S1[d * 64 + e] = s; }
        const float r0 = rsqrtf(wave_sum(o0 * o0) * (1.f / 64.f) + EPS), r1 = rsqrtf(wave_sum(o1 * o1) * (1.f / 64.f) + EPS);
        const float r2 = rsqrtf(wave_sum(o2 * o2) * (1.f / 64.f) + EPS), r3 = rsqrtf(wave_sum(o3 * o3) * (1.f / 64.f) + EPS);
        const int c = h * 64 + e;
        C.y[(R0 + 0) * WMIX + Y_A + c] = f2bf(o0 * r0 * silu_(PR(0, C_ZA + c))); C.y[(R0 + 1) * WMIX + Y_A + c] = f2bf(o1 * r1 * silu_(PR(1, C_ZA + c)));
        C.y[(R0 + 2) * WMIX + Y_A + c] = f2bf(o2 * r2 * silu_(PR(2, C_ZA + c))); C.y[(R0 + 3) * WMIX + Y_A + c] = f2bf(o3 * r3 * silu_(PR(3, C_ZA + c)));
    } else { const int h = w - 4, e = lane;
        const float* S0 = P.state_hgrn + (((size_t)l * 128 + sb) * 4 + h) * 4096; float* S1 = P.out + O_HGRNS + (((size_t)l * 128 + sb) * 4 + h) * 4096;
        const float v0 = PR(0, C_ID + h * 64 + e), v1 = PR(1, C_ID + h * 64 + e), v2 = PR(2, C_ID + h * 64 + e), v3 = PR(3, C_ID + h * 64 + e);
        float o0 = 0.f, o1 = 0.f, o2 = 0.f, o3 = 0.f;
#pragma unroll 8
        for (int d = 0; d < 64; ++d) { float s = S0[d * 64 + e]; const int c = h * 64 + d;
            float f = fd[c]; s = f * s + (1.f - f) * v0; o0 += qd[c] * s; f = fd[256 + c]; s = f * s + (1.f - f) * v1; o1 += qd[256 + c] * s;
            f = fd[512 + c]; s = f * s + (1.f - f) * v2; o2 += qd[512 + c] * s; f = fd[768 + c]; s = f * s + (1.f - f) * v3; o3 += qd[768 + c] * s; S1[d * 64 + e] = s; }
        const float r0 = rsqrtf(wave_sum(o0 * o0) * (1.f / 64.f) + EPS), r1 = rsqrtf(wave_sum(o1 * o1) * (1.f / 64.f) + EPS);
        const float r2 = rsqrtf(wave_sum(o2 * o2) * (1.f / 64.f) + EPS), r3 = rsqrtf(wave_sum(o3 * o3) * (1.f / 64.f) + EPS);
        const int c = h * 64 + e; const float gs = P.g_hgrn[l * 256 + c];
        C.y[(R0 + 0) * WMIX + Y_D + c] = f2bf(o0 * r0 * gs * silu_(PR(0, C_ZD + c))); C.y[(R0 + 1) * WMIX + Y_D + c] = f2bf(o1 * r1 * gs * silu_(PR(1, C_ZD + c)));
        C.y[(R0 + 2) * WMIX + Y_D + c] = f2bf(o2 * r2 * gs * silu_(PR(2, C_ZD + c))); C.y[(R0 + 3) * WMIX + Y_D + c] = f2bf(o3 * r3 * gs * silu_(PR(3, C_ZD + c)));
    }
    { const int c = tid & 255, tp = tid >> 8, g = c >> 6, dout = c & 63;
      float a0 = 0.f, a1 = 0.f; const float* wp = P.w_pool + ((size_t)l * 4 + g) * 4096 + dout;
#pragma unroll 8
      for (int cin = 0; cin < 64; ++cin) { const float wv = wp[cin * 64]; a0 += pl[(2 * tp) * 256 + g * 64 + cin] * wv; a1 += pl[(2 * tp + 1) * 256 + g * 64 + cin] * wv; }
      const float sc = P.pool_scale[l * 256 + c];
      C.y[(R0 + 2 * tp) * WMIX + Y_C + c] = f2bf(a0 * sc * silu_(PR(2 * tp, C_ZC + c)));
      C.y[(R0 + 2 * tp + 1) * WMIX + Y_C + c] = f2bf(a1 * sc * silu_(PR(2 * tp + 1, C_ZC + c))); }
    for (int i = tid; i < 4224; i += NTHREADS) { const int kh = i / 2112, rem = i - kh * 2112, r16 = rem / 132, kk = rem - r16 * 132, g = r16 >> 2, t = r16 & 3, h = kh * 4 + g;
        const bool ok = kk < 128 ? (kk >= t) : (kk - 128 <= t);
        const float* kp = kk < 128 ? kv + (kk * 2 + kh) * 65 : kn + (kk - 128) * 128 + kh * 64;
        const float* qp = qbq + t * 512 + h * 64;
        float s = 0.f;
#pragma unroll 16
        for (int d = 0; d < 64; ++d) s += qp[d] * kp[d];
        ps[(h * 4 + t) * 136 + kk] = ok ? s : -1e30f; }
    __syncthreads();
    { const int h = w; const float sink = P.attn_sink[l * 8 + h];
      for (int t = 0; t < 4; ++t) { float* pr_ = ps + (h * 4 + t) * 136;
          const float s0 = pr_[lane], s1 = pr_[lane + 64], s2 = lane < 4 ? pr_[lane + 128] : -1e30f;
          float m = fmaxf(fmaxf(s0, s1), s2); m = fmaxf(m, __shfl_xor(m, 32)); m = fmaxf(m, __shfl_xor(m, 16)); m = fmaxf(m, __shfl_xor(m, 8)); m = fmaxf(m, __shfl_xor(m, 4)); m = fmaxf(m, __shfl_xor(m, 2)); m = fmaxf(m, __shfl_xor(m, 1));
          m = fmaxf(m, sink);
          const float p0 = __expf(s0 - m), p1 = __expf(s1 - m), p2 = lane < 4 ? __expf(s2 - m) : 0.f;
          const float inv = 1.f / (wave_sum(p0 + p1 + p2) + __expf(sink - m));
          pr_[lane] = p0 * inv; pr_[lane + 64] = p1 * inv; if (lane < 4) pr_[lane + 128] = p2 * inv; } }
    __syncthreads();
    { const float* vc = P.cache_v + ((size_t)l * 128 + sb) * 16384; float* vo = P.out + O_VS + ((size_t)l * 128 + sb) * 16384;
      for (int i = tid; i < 4096; i += NTHREADS) { const float4 v = ((const float4*)vc)[i]; const int e = i * 4, wq = e >> 7, r = e & 127, kh = r >> 6, d = r & 63;
          float* dst = kv + (wq * 2 + kh) * 65 + d; dst[0] = v.x; dst[1] = v.y; dst[2] = v.z; dst[3] = v.w;
          if (wq >= 4) ((float4*)vo)[i - 128] = v; } }
    __syncthreads();
    { const int h = w, kh = h >> 2, e = lane;
      float o0 = 0.f, o1 = 0.f, o2 = 0.f, o3 = 0.f; const float* p0 = ps + (h * 4) * 136;
      for (int kk = 0; kk < 128; ++kk) { const float v = kv[(kk * 2 + kh) * 65 + e]; o0 += p0[kk] * v; o1 += p0[136 + kk] * v; o2 += p0[272 + kk] * v; o3 += p0[408 + kk] * v; }
      for (int kk = 128; kk < 132; ++kk) { const float v = PR(kk - 128, C_VB + kh * 64 + e); o0 += p0[kk] * v; o1 += p0[136 + kk] * v; o2 += p0[272 + kk] * v; o3 += p0[408 + kk] * v; }
      const int c = h * 64 + e;
      C.y[(R0 + 0) * WMIX + Y_B + c] = f2bf(o0 * silu_(PR(0, C_ZB + c))); C.y[(R0 + 1) * WMIX + Y_B + c] = f2bf(o1 * silu_(PR(1, C_ZB + c)));
      C.y[(R0 + 2) * WMIX + Y_B + c] = f2bf(o2 * silu_(PR(2, C_ZB + c))); C.y[(R0 + 3) * WMIX + Y_B + c] = f2bf(o3 * silu_(PR(3, C_ZB + c))); }
#undef PR
    __syncthreads();
}

__device__ __forceinline__ void phase_scan(const Params& P, Ctx& C, int l) {
    for (int g = C.bx * NTHREADS + C.tid; g < 49152; g += C.G * NTHREADS) {
        if (g < 16384) { const int b = g >> 13, r = g & 8191, h = r >> 11, de = r & 2047;
            float* base = C.kva + ((size_t)(b * 128) * 4 + h) * 2048 + de;
            const float dec = __expf(64.f * log1pf(-exp2f(-5.f - (float)h)));
            float S = 0.f;
            for (int n0 = 0; n0 < 128; n0 += 16) { float v[16];
#pragma unroll
                for (int i = 0; i < 16; ++i) v[i] = base[(size_t)(n0 + i) * 8192];
#pragma unroll
                for (int i = 0; i < 16; ++i) { base[(size_t)(n0 + i) * 8192] = S; S = dec * S + v[i]; } }
            P.out[O_RETP + (((size_t)l * 2 + b) * 4 + h) * 2048 + de] = S;
        } else { const int gg = g - 16384, b = gg >> 14, r = gg & 16383, h = r >> 12, de = r & 4095, d = de >> 6;
            float* base = C.kvd + ((size_t)(b * 128) * 4 + h) * 4096 + de;
            const float* dp = C.decd + (size_t)(b * 128) * 256 + h * 64 + d;
            float S = 0.f;
            for (int n0 = 0; n0 < 128; n0 += 16) { float v[16], dc[16];
#pragma unroll
                for (int i = 0; i < 16; ++i) { v[i] = base[(size_t)(n0 + i) * 16384]; dc[i] = dp[(n0 + i) * 256]; }
#pragma unroll
                for (int i = 0; i < 16; ++i) { base[(size_t)(n0 + i) * 16384] = S; S = dc[i] * S + v[i]; } }
            P.out[O_HGRNP + (((size_t)l * 2 + b) * 4 + h) * 4096 + de] = S;
        }
    }
}

__device__ __forceinline__ void phase_finalize(const Params& P, Ctx& C, int l) {
    const int lane = C.lane;
    for (int row = C.bx * 8 + C.w; row < M_TOT; row += C.G * 8) {
        const float4* o4 = (const float4*)(C.of + (size_t)row * DM); float4* x4 = (float4*)(P.out + (size_t)row * DM);
        float4 o[4], x[4]; float ss = 0.f;
#pragma unroll
        for (int i = 0; i < 4; ++i) { o[i] = o4[lane + 64 * i]; x[i] = x4[lane + 64 * i]; ss += o[i].x * o[i].x + o[i].y * o[i].y + o[i].z * o[i].z + o[i].w * o[i].w; }
        ss = wave_sum(ss); const float r = rsqrtf(ss * (1.f / DM) + EPS);
        float s2 = 0.f;
#pragma unroll
        for (int i = 0; i < 4; ++i) { const float4 g = ((const float4*)(P.g_post + l * DM))[lane + 64 * i];
            x[i].x += o[i].x * r * g.x; x[i].y += o[i].y * r * g.y; x[i].z += o[i].z * r * g.z; x[i].w += o[i].w * r * g.w;
            x4[lane + 64 * i] = x[i]; s2 += x[i].x * x[i].x + x[i].y * x[i].y + x[i].z * x[i].z + x[i].w * x[i].w; }
        if (l < 3) { s2 = wave_sum(s2); const float r2 = rsqrtf(s2 * (1.f / DM) + EPS);
#pragma unroll
            for (int i = 0; i < 4; ++i) { const float4 g = ((const float4*)(P.g_pre + (l + 1) * DM))[lane + 64 * i];
                uint2 ov; ov.x = pk2(x[i].x * r2 * g.x, x[i].y * r2 * g.y); ov.y = pk2(x[i].z * r2 * g.z, x[i].w * r2 * g.w);
                ((uint2*)(C.h + (size_t)row * DM))[lane + 64 * i] = ov; } }
    }
}

#ifndef PH_MASK
#define PH_MASK 2047
#endif
__global__ void __launch_bounds__(NTHREADS, 2) fwd_kernel(Params P) {
    extern __shared__ __attribute__((aligned(16))) unsigned char lds[];
    LAS unsigned char* ldsl = (LAS unsigned char*)lds;

    for (int ph = P.ph_lo; ph < P.ph_hi; ++ph) {
        int tid_ = threadIdx.x, bx = blockIdx.x, G_ = gridDim.x; unsigned char* ws = P.ws;
        asm volatile("" : "+v"(tid_)); asm volatile("" : "+s"(bx)); asm volatile("" : "+s"(G_)); asm volatile("" : "+s"(ws));
        Ctx C;
        C.win = (bf16_t*)(ws + WS_WIN); C.wb = (bf16_t*)(ws + WS_WB); C.wout = (bf16_t*)(ws + WS_WOUT); C.h = (bf16_t*)(ws + WS_H); C.mb = (bf16_t*)(ws + WS_H);
        C.proj = (bf16_t*)(ws + WS_PROJ); C.mf = (float*)(ws + WS_PROJ); C.gates = (bf16_t*)(ws + WS_GATES); C.of = (float*)(ws + WS_GATES); C.y = (bf16_t*)(ws + WS_Y);
        C.kva = (float*)(ws + WS_KVA); C.kvd = (float*)(ws + WS_KVD); C.decd = (float*)(ws + WS_DECD);
        C.ropeAc = (float*)(ws + WS_ROPEA); C.ropeAs = C.ropeAc + NPOS * 16; C.ropeBc = (float*)(ws + WS_ROPEB); C.ropeBs = C.ropeBc + NPOS * 8; C.lbt = (float*)(ws + WS_LB);
        C.bx = bx; C.tid = tid_; C.lane = tid_ & 63; C.w = __builtin_amdgcn_readfirstlane(tid_ >> 6); C.G = G_;
        const int vcu = (C.G % 8 == 0) ? (bx % 8) * (C.G / 8) + bx / 8 : bx;
        if (ph == 0) { if (PH_MASK & 1) phase_prologue(P, C, lds); }
        else {
            const int l = (ph - 1) / 7, sp = (ph - 1) % 7;
            if (sp == 0) {
              if (PH_MASK & 2) {
                pg8::Gemm g{C.h, C.win + (size_t)l * DIN * DM, DM, DM}; pg8::StaticOrder S; S.init(M_TOT, DIN, DM, C.G, bx);
                pg8::EpiProj E{C.proj, C.gates};
                pg8::gemm_phase<pg8::EpiProj, pg8::StaticOrder>(ldsl, g, S, E, C.tid); }
            } else if (sp == 1) {
                for (int u = bx; u < 1152; u += C.G) {
                    if (u < 256) { if (PH_MASK & 4) attn_prompt_unit(P, C, l, u >> 7, (u & 127) >> 1, u & 1, lds); }
                    else if (u < 384) { if (PH_MASK & 8) sample_unit(P, C, l, u - 256, lds); }
                    else if (u < 640) { if (PH_MASK & 16) pool_prompt_unit(P, C, l, u - 384, lds); }
                    else if (u < 896) { if (PH_MASK & 32) lin_chunk<false, true>(P, C, l, (u - 640) >> 7, (u - 640) & 127, lds); }
                    else { if (PH_MASK & 32) lin_chunk<true, true>(P, C, l, (u - 896) >> 7, (u - 896) & 127, lds); }
                }
            } else if (sp == 2) { if (PH_MASK & 64) phase_scan(P, C, l); }
            else if (sp == 3) {
                for (int u = bx; u < 512; u += C.G) {
                    if (u < 256) { if (PH_MASK & 128) lin_chunk<false, false>(P, C, l, u >> 7, u & 127, lds); }
                    else { if (PH_MASK & 128) lin_chunk<true, false>(P, C, l, (u - 256) >> 7, (u - 256) & 127, lds); }
                }
            } else if (sp == 4) {
              if (PH_MASK & 256) {
                pg8::Gemm g{C.y, C.wb + (size_t)l * DM * WMIX, WMIX, WMIX}; pg8::BranchOrder S{264, C.G, vcu};
                pg8::EpiBranch E{C.gates, C.mf, C.mb};
                pg8::gemm_phase<pg8::EpiBranch, pg8::BranchOrder>(ldsl, g, S, E, C.tid); }
            } else if (sp == 5) {
              if (PH_MASK & 512) {
                pg8::Gemm g{C.mb, C.wout + (size_t)l * DM * DM, DM, DM}; pg8::TileOrder S{264, C.G, vcu, DM / 64};
                pg8::EpiF32 E{C.of};
                pg8::gemm_phase<pg8::EpiF32, pg8::TileOrder>(ldsl, g, S, E, C.tid); }
            } else { if (PH_MASK & 1024) phase_finalize(P, C, l); }
        }
        if (ph + 1 < P.ph_hi) { if (P.coop) cg::this_grid().sync(); }
    }
}

#ifndef N_LAUNCH_MODE
#define N_LAUNCH_MODE 1
#endif
extern "C" void kernel_launch(void* const* d_in, const int* in_sizes, int n_in, void* d_out, int out_size, void* d_ws, size_t ws_size, hipStream_t stream) {
    static int grid = 0;
    if (grid == 0) {
        if (n_in != 17 || (size_t)out_size != O_END || ws_size < WS_END) { fprintf(stderr, "kernel_launch: unexpected sizes n_in %d out %d ws %zu\n", n_in, out_size, ws_size); grid = -1; return; }
        int dev = 0, cus = 0, per_cu = 0;
        hipGetDevice(&dev); hipDeviceGetAttribute(&cus, hipDeviceAttributeMultiprocessorCount, dev);
        if (hipFuncSetAttribute((const void*)fwd_kernel, hipFuncAttributeMaxDynamicSharedMemorySize, LDS_BYTES) != hipSuccess) { fprintf(stderr, "hipFuncSetAttribute failed\n"); grid = -1; return; }
        if (hipOccupancyMaxActiveBlocksPerMultiprocessor(&per_cu, (const void*)fwd_kernel, NTHREADS, LDS_BYTES) != hipSuccess || per_cu < 1) { fprintf(stderr, "occupancy query: %d\n", per_cu); per_cu = 1; }
        (void)hipGetLastError();
        grid = cus * 1;
        if (per_cu < 1) grid = -1;
    }
    if (grid < 0) return;
    Params p{};
    const float* const* in = (const float* const*)d_in;
    p.x_prompt = in[0]; p.x_sample = in[1]; p.state_ret = in[2]; p.cache_k = in[3]; p.cache_v = in[4]; p.state_pool = in[5]; p.state_hgrn = in[6];
    p.w_in = in[7]; p.w_branch = in[8]; p.w_out = in[9]; p.g_pre = in[10]; p.g_post = in[11]; p.attn_sink = in[12]; p.w_pool = in[13];
    p.pool_scale = in[14]; p.g_hgrn = in[15]; p.lower_bounds = in[16];
    p.out = (float*)d_out; p.ws = (unsigned char*)d_ws;
    for (int i = 0; i < 16; ++i) p.invA[i] = pow(10000.0, -(double)i / 16.0);
    for (int i = 0; i < 8; ++i) p.invB[i] = pow(500000.0, -(double)i / 8.0);
    const int NPH = 29;
#if N_LAUNCH_MODE == 1
    p.ph_lo = 0; p.ph_hi = NPH; p.coop = 1; p.pad = 0;
    void* args[] = {&p};
    hipError_t e = hipLaunchCooperativeKernel((const void*)fwd_kernel, dim3(grid), dim3(NTHREADS), args, LDS_BYTES, stream);
    if (e != hipSuccess) fprintf(stderr, "cooperative launch failed: %s (grid %d)\n", hipGetErrorString(e), grid);
#else
    for (int ph = 0; ph < NPH; ++ph) {
        p.ph_lo = ph; p.ph_hi = ph + 1; p.coop = 0; p.pad = 0;
        hipLaunchKernelGGL(fwd_kernel, dim3(grid), dim3(NTHREADS), LDS_BYTES, stream, p);
    }
#endif
}
```

```cpp
#include <hip/hip_runtime.h>
#include <hip/hip_cooperative_groups.h>
#include <cstdio>
#include <cstdint>
#include <cmath>
namespace cg = cooperative_groups;

#define LAS __attribute__((address_space(3)))
typedef unsigned short bf16_t;
typedef short bf16x8 __attribute__((ext_vector_type(8)));
typedef float f32x4 __attribute__((ext_vector_type(4)));
typedef unsigned u32x4 __attribute__((ext_vector_type(4)));

constexpr int M_TOT = 16896, M_P = 16384, DM = 1024, DIN = 7680, NPROJ = 3584, NGATE = 4096, WMIX = 1280;
constexpr int C_QA = 0, C_KA = 128, C_VA = 256, C_ZA = 512, C_QB = 768, C_KB = 1280, C_VB = 1408, C_ZB = 1536, C_UC = 2048, C_ZC = 2304,
              C_QD = 2560, C_FD = 2816, C_ID = 3072, C_ZD = 3328;
constexpr int Y_A = 0, Y_B = 256, Y_C = 768, Y_D = 1024;
constexpr size_t O_YP = 0, O_YS = 16777216, O_RETP = 17301504, O_KP = 17367040, O_VP = 17498112, O_POOLP = 17629184, O_HGRNP = 17659904,
                 O_RETS = 17790976, O_KS = 21985280, O_VS = 30373888, O_POOLS = 38762496, O_HGRNS = 40728576, O_END = 49117184;
constexpr float EPS = 1e-6f;
constexpr int NPOS = 8196;

constexpr size_t MiB = 1u << 20;
constexpr size_t WS_ROPEA = 1 * MiB;
constexpr size_t WS_ROPEB = 3 * MiB;
constexpr size_t WS_LB = 3 * MiB + 768 * 1024;
constexpr size_t WS_WIN = 4 * MiB;
constexpr size_t WS_WB = 64 * MiB;
constexpr size_t WS_WOUT = 74 * MiB;
constexpr size_t WS_H = 82 * MiB;
constexpr size_t WS_PROJ = 115 * MiB;
constexpr size_t WS_GATES = 231 * MiB;
constexpr size_t WS_Y = 363 * MiB;
constexpr size_t WS_KVA = 405 * MiB;
constexpr size_t WS_KVD = 413 * MiB;
constexpr size_t WS_DECD = 429 * MiB;
constexpr size_t WS_END = 430 * MiB;

constexpr int LDS_BYTES = 147456;
constexpr int NTHREADS = 512;

struct Params {
    const float* x_prompt; const float* x_sample; const float* state_ret; const float* cache_k; const float* cache_v; const float* state_pool; const float* state_hgrn;
    const float* w_in; const float* w_branch; const float* w_out; const float* g_pre; const float* g_post; const float* attn_sink; const float* w_pool;
    const float* pool_scale; const float* g_hgrn; const float* lower_bounds;
    float* out; unsigned char* ws;
    double invA[16]; double invB[8];
    int ph_lo, ph_hi, coop, pad;
};

__device__ __forceinline__ float bf2f(bf16_t v) { return __uint_as_float(((unsigned)v) << 16); }
__device__ __forceinline__ bf16_t f2bf(float f) { unsigned u = __float_as_uint(f); return (bf16_t)((u + 0x7fffu + ((u >> 16) & 1u)) >> 16); }
__device__ __forceinline__ unsigned pk2(float lo, float hi) { return (unsigned)f2bf(lo) | ((unsigned)f2bf(hi) << 16); }
__device__ __forceinline__ float lo16(unsigned u) { return __uint_as_float(u << 16); }
__device__ __forceinline__ float hi16(unsigned u) { return __uint_as_float(u & 0xffff0000u); }
__device__ __forceinline__ float sigmoid_(float x) { return 1.f / (1.f + __expf(-x)); }
__device__ __forceinline__ float silu_(float x) { return x / (1.f + __expf(-x)); }
__device__ __forceinline__ float wave_sum(float v) {
    v += __shfl_xor(v, 32); v += __shfl_xor(v, 16); v += __shfl_xor(v, 8); v += __shfl_xor(v, 4); v += __shfl_xor(v, 2); v += __shfl_xor(v, 1); return v;
}
__device__ __forceinline__ float quad16_sum(float v) { v += __shfl_xor(v, 8); v += __shfl_xor(v, 4); v += __shfl_xor(v, 2); v += __shfl_xor(v, 1); return v; }
__device__ __forceinline__ float quad16_max(float v) { v = fmaxf(v, __shfl_xor(v, 8)); v = fmaxf(v, __shfl_xor(v, 4)); v = fmaxf(v, __shfl_xor(v, 2)); v = fmaxf(v, __shfl_xor(v, 1)); return v; }
__device__ __forceinline__ f32x4 mfma16(bf16x8 a, bf16x8 b, f32x4 c) { return __builtin_amdgcn_mfma_f32_16x16x32_bf16(a, b, c, 0, 0, 0); }
__device__ __forceinline__ f32x4 mma_tile(const bf16_t* As, int lda, const bf16_t* Bs, int ldb, int K, f32x4 acc, int lane) {
    const bf16_t* ap = As + (lane & 15) * lda + (lane >> 4) * 8;
    const bf16_t* bp = Bs + (lane & 15) * ldb + (lane >> 4) * 8;
    for (int k = 0; k < K; k += 32) acc = mfma16(*(const bf16x8*)(ap + k), *(const bf16x8*)(bp + k), acc);
    return acc;
}

namespace pg8 {
constexpr int BM = 256, BK = 64, HALF = 128, HTB = HALF * BK * 2, STAGE_BYTES = 8 * HTB, NXCD = 8, WGM = 8;
__host__ __device__ __forceinline__ int lds_byte(int r, int c) { const int st = (r >> 4) * 2 + (c >> 5), rr = r & 15, cc = c & 31, ob = rr * 64 + cc * 2; return st * 1024 + (ob ^ (((ob >> 9) & 1) << 5)); }
__host__ __device__ __forceinline__ void stage_rc(int b, int& R, int& C) { const int st = b / 1024, sb = b % 1024, swz = sb ^ (((sb >> 9) & 1) << 5); R = (st >> 1) * 16 + swz / 64; C = (st & 1) * 32 + (swz % 64) / 2; }
__host__ __device__ __forceinline__ int perm32(int rho) { const int n = rho >> 4, i = rho & 15; return 8 * (i >> 2) + 4 * n + (i & 3); }

struct Unit { int pm, pn, k0, nt, br; };
struct Gemm { const bf16_t* A; const bf16_t* Bt; int lda, ldb; };

struct StaticOrder {
    int nM, nN, nwg, G, c, nt;
    __device__ void init(int M, int N, int K, int G_, int c_) { nM = M / BM; nN = N / BM; nwg = nM * nN; G = G_; c = c_; nt = K / BK; }
    __device__ bool next(int i, Unit& u) const {
        const long L = (long)i * G + c; if (L >= nwg) return false;
        int wgid = (int)L; { const int q = nwg / NXCD, r = nwg % NXCD, xcd = wgid % NXCD, off = wgid / NXCD; wgid = (xcd < r ? xcd * (q + 1) : r * (q + 1) + (xcd - r) * q) + off; }
        const int nig = WGM * nN, gid = wgid / nig, fm = gid * WGM, gsz = (nM - fm) < WGM ? (nM - fm) : WGM;
        u.pm = fm + ((wgid % nig) % gsz); u.pn = (wgid % nig) / gsz; u.k0 = 0; u.nt = nt; u.br = 0; return true;
    }
};
struct TileOrder {
    int ntiles, G, c, nt;
    __device__ bool next(int i, Unit& u) const { const int t = i * G + c; if (t >= ntiles) return false; u.pm = t >> 2; u.pn = t & 3; u.k0 = 0; u.nt = nt; u.br = 0; return true; }
};
struct BranchOrder {
    int ntiles, G, c;
    __device__ bool next(int i, Unit& u) const {
        const int t = (i >> 2) * G + c; if (t >= ntiles) return false; const int br = i & 3;
        u.pm = t >> 2; u.pn = t & 3; u.br = br; u.k0 = br == 0 ? 0 : (br == 1 ? 256 : (br == 2 ? 768 : 1024)); u.nt = br == 1 ? 8 : 4; return true;
    }
};

struct EpiProj {
    static __device__ __forceinline__ bool reset(const Unit&) { return true; }
    bf16_t* proj; bf16_t* gates;
    __device__ __forceinline__ void operator()(f32x4 (&acc)[2][2][4][2], const Unit& u, int wr, int wc, int fr, int fq) const {
        const int row0 = u.pm * BM + wr * 64 + fr;
        const bool isg = u.pn >= 14;
        bf16_t* base = isg ? gates : proj; const int ld = isg ? NGATE : NPROJ;
        const int col0 = (isg ? (u.pn - 14) : u.pn) * BM + wc * 32 + 8 * fq;
#pragma unroll
        for (int ai = 0; ai < 2; ++ai)
#pragma unroll
            for (int m = 0; m < 4; ++m) { bf16_t* rowp = base + (size_t)(row0 + ai * HALF + m * 16) * ld + col0;
#pragma unroll
                for (int bj = 0; bj < 2; ++bj) { f32x4 v0 = acc[ai][bj][m][0], v1 = acc[ai][bj][m][1];
                    if (isg) {
#pragma unroll
                        for (int i = 0; i < 4; ++i) { v0[i] = fmaxf(sigmoid_(v0[i]), 1e-6f); v1[i] = fmaxf(sigmoid_(v1[i]), 1e-6f); } }
                    u32x4 w; w.x = pk2(v0[0], v0[1]); w.y = pk2(v0[2], v0[3]); w.z = pk2(v1[0], v1[1]); w.w = pk2(v1[2], v1[3]);
                    *(u32x4*)(rowp + bj * HALF) = w; } }
    }
};
struct EpiBranch {
    static __device__ __forceinline__ bool reset(const Unit& u) { return u.br == 3; }
    const bf16_t* gates; bf16_t* mb;
    __device__ __forceinline__ void operator()(f32x4 (&acc)[2][2][4][2], const Unit& u, int wr, int wc, int fr, int fq) const {
        const int row0 = u.pm * BM + wr * 64 + fr, col0 = u.pn * BM + wc * 32 + 8 * fq;
#pragma unroll
        for (int ai = 0; ai < 2; ++ai)
#pragma unroll
            for (int m = 0; m < 4; ++m) { const size_t row = (size_t)(row0 + ai * HALF + m * 16);
#pragma unroll
                for (int bj = 0; bj < 2; ++bj) { const int col = col0 + bj * HALF;
                    const u32x4 g = *(const u32x4*)(gates + row * NGATE + u.br * 1024 + col);
                    float s[8] = {lo16(g.x), hi16(g.x), lo16(g.y), hi16(g.y), lo16(g.z), hi16(g.z), lo16(g.w), hi16(g.w)};
                    if (u.br < 3) { const u32x4 gn = *(const u32x4*)(gates + row * NGATE + (u.br + 1) * 1024 + col);
                        s[0] *= __builtin_amdgcn_rcpf(lo16(gn.x)); s[1] *= __builtin_amdgcn_rcpf(hi16(gn.x)); s[2] *= __builtin_amdgcn_rcpf(lo16(gn.y)); s[3] *= __builtin_amdgcn_rcpf(hi16(gn.y));
                        s[4] *= __builtin_amdgcn_rcpf(lo16(gn.z)); s[5] *= __builtin_amdgcn_rcpf(hi16(gn.z)); s[6] *= __builtin_amdgcn_rcpf(lo16(gn.w)); s[7] *= __builtin_amdgcn_rcpf(hi16(gn.w)); }
                    f32x4 v0 = acc[ai][bj][m][0], v1 = acc[ai][bj][m][1];
                    v0[0] *= s[0]; v0[1] *= s[1]; v0[2] *= s[2]; v0[3] *= s[3]; v1[0] *= s[4]; v1[1] *= s[5]; v1[2] *= s[6]; v1[3] *= s[7];
                    if (u.br < 3) { acc[ai][bj][m][0] = v0; acc[ai][bj][m][1] = v1; }
                    else { u32x4 w; w.x = pk2(v0[0], v0[1]); w.y = pk2(v0[2], v0[3]); w.z = pk2(v1[0], v1[1]); w.w = pk2(v1[2], v1[3]); *(u32x4*)(mb + row * DM + col) = w; } } }
    }
};
struct EpiF32 {
    static __device__ __forceinline__ bool reset(const Unit&) { return true; }
    float* o;
    __device__ __forceinline__ void operator()(f32x4 (&acc)[2][2][4][2], const Unit& u, int wr, int wc, int fr, int fq) const {
        const int row0 = u.pm * BM + wr * 64 + fr, col0 = u.pn * BM + wc * 32 + 8 * fq;
#pragma unroll
        for (int ai = 0; ai < 2; ++ai)
#pragma unroll
            for (int m = 0; m < 4; ++m) { float* rowp = o + (size_t)(row0 + ai * HALF + m * 16) * DM + col0;
#pragma unroll
                for (int bj = 0; bj < 2; ++bj) { *(f32x4*)(rowp + bj * HALF) = acc[ai][bj][m][0]; *(f32x4*)(rowp + bj * HALF + 4) = acc[ai][bj][m][1]; } }
    }
};

template <class Epi, class Sched>
__device__ __forceinline__ void gemm_phase(LAS unsigned char* lds, const Gemm g, const Sched& S, const Epi& E, const int tid) {
    const int wid = __builtin_amdgcn_readfirstlane(tid >> 6), lane = tid & 63, wr = wid >> 2, wc = wid & 3, fr = lane & 15, fq = lane >> 4;
    unsigned voffA[2], voffB[2];
#pragma unroll
    for (int i = 0; i < 2; ++i) { int R, C; stage_rc(tid * 16 + i * 8192, R, C); const int Rb = (R & ~31) + perm32(R & 31);
        voffA[i] = (unsigned)(R * g.lda + C) * 2u; voffB[i] = (unsigned)(Rb * g.ldb + C) * 2u; }
    const size_t kstep = (size_t)(BK * 2);
    const size_t hstepA = (size_t)HALF * g.lda * 2, hstepB = (size_t)HALF * g.ldb * 2;
    const size_t tstepA = 2 * hstepA, tstepB = 2 * hstepB;
    const unsigned ldsw = (unsigned)wid * 1024u;
    const int aoff = lds_byte(wr * 64 + fr, fq * 8), boff = lds_byte(wc * 32 + fr, fq * 8);
#define PG8_SA(b, h) (((b) * 2 + (h)) * HTB)
#define PG8_SB(b, h) ((4 + (b) * 2 + (h)) * HTB)
#define PG8_STAGE(bufoff, gbase, voff) do { _Pragma("unroll") for (int _i = 0; _i < 2; ++_i) \
        __builtin_amdgcn_global_load_lds((const unsigned*)((const char*)(gbase) + (voff)[_i]), (LAS unsigned*)(lds + (bufoff) + ldsw + _i * 8192), 16, 0, 0); } while (0)
#define PG8_LDA(dst, b, h) do { _Pragma("unroll") for (int m = 0; m < 4; ++m) _Pragma("unroll") for (int k = 0; k < 2; ++k) dst[m][k] = *(const LAS bf16x8*)(lds + PG8_SA(b, h) + aoff + m * 2048 + k * 1024); } while (0)
#define PG8_LDB(dst, b, h) do { _Pragma("unroll") for (int n = 0; n < 2; ++n) _Pragma("unroll") for (int k = 0; k < 2; ++k) dst[n][k] = *(const LAS bf16x8*)(lds + PG8_SB(b, h) + boff + n * 2048 + k * 1024); } while (0)
#define PG8_MMA(ai, bj, At, Bt) do { __builtin_amdgcn_s_setprio(1); _Pragma("unroll") for (int m = 0; m < 4; ++m) _Pragma("unroll") for (int n = 0; n < 2; ++n) _Pragma("unroll") for (int k = 0; k < 2; ++k) \
        acc[ai][bj][m][n] = __builtin_amdgcn_mfma_f32_16x16x32_bf16(Bt[n][k], At[m][k], acc[ai][bj][m][n], 0, 0, 0); __builtin_amdgcn_s_setprio(0); } while (0)
#define PG8_WAIT_V(n) asm volatile("s_waitcnt vmcnt(" #n ")" ::: "memory")
#define PG8_WAIT_L(n) asm volatile("s_waitcnt lgkmcnt(" #n ")" ::: "memory")
#define PG8_BAR __builtin_amdgcn_s_barrier()
#define PG8_SCHED __builtin_amdgcn_sched_barrier(0)
    Unit cur, nxt; int ui = 0;
    if (!S.next(0, cur)) return;
    f32x4 acc[2][2][4][2];
#pragma unroll
    for (int a = 0; a < 2; ++a)
#pragma unroll
        for (int b = 0; b < 2; ++b)
#pragma unroll
            for (int m = 0; m < 4; ++m)
#pragma unroll
                for (int n = 0; n < 2; ++n) acc[a][b][m][n] = (f32x4){0.f, 0.f, 0.f, 0.f};
    bf16x8 At[4][2], B0[2][2], B1[2][2];
    const char* cA = (const char*)g.A + (size_t)cur.pm * tstepA + (size_t)cur.k0 * 2; const char* cB = (const char*)g.Bt + (size_t)cur.pn * tstepB + (size_t)cur.k0 * 2;
    PG8_STAGE(PG8_SB(0, 0), cB, voffB); PG8_STAGE(PG8_SB(0, 1), cB + hstepB, voffB); PG8_STAGE(PG8_SA(0, 0), cA, voffA); PG8_STAGE(PG8_SA(0, 1), cA + hstepA, voffA);
    if (wr == 1) PG8_BAR;
    PG8_WAIT_V(2); PG8_BAR;
    PG8_STAGE(PG8_SB(1, 0), cB + kstep, voffB); PG8_STAGE(PG8_SA(1, 0), cA + kstep, voffA); PG8_STAGE(PG8_SB(1, 1), cB + hstepB + kstep, voffB);
    PG8_WAIT_V(6); PG8_BAR;
    for (;;) {
        const bool has_next = S.next(ui + 1, nxt);
        const char* nA = has_next ? (const char*)g.A + (size_t)nxt.pm * tstepA + (size_t)nxt.k0 * 2 : cA;
        const char* nB = has_next ? (const char*)g.Bt + (size_t)nxt.pn * tstepB + (size_t)nxt.k0 * 2 : cB;
        const int nt = cur.nt;
        for (int t = 0; t < nt; t += 2) {
            const bool last = (t == nt - 2);
            const char* a1 = cA + (size_t)(t + 1) * kstep;
            const char* a2 = last ? nA : cA + (size_t)(t + 2) * kstep; const char* b2 = last ? nB : cB + (size_t)(t + 2) * kstep;
            const char* a3 = a2 + kstep; const char* b3 = b2 + kstep;
            PG8_LDB(B0, 0, 0); PG8_LDB(B1, 0, 1); PG8_SCHED; PG8_LDA(At, 0, 0); PG8_STAGE(PG8_SA(1, 1), a1 + hstepA, voffA);
            PG8_WAIT_V(8); PG8_WAIT_L(0); PG8_BAR; PG8_MMA(0, 0, At, B0); PG8_MMA(0, 1, At, B1); PG8_BAR; PG8_SCHED;
            PG8_LDA(At, 0, 1); PG8_STAGE(PG8_SB(0, 0), b2, voffB); PG8_STAGE(PG8_SB(0, 1), b2 + hstepB, voffB); PG8_STAGE(PG8_SA(0, 0), a2, voffA);
            PG8_WAIT_V(8); PG8_WAIT_L(0); PG8_BAR; PG8_MMA(1, 0, At, B0); PG8_MMA(1, 1, At, B1); PG8_BAR; PG8_SCHED;
            PG8_LDB(B0, 1, 0); PG8_LDB(B1, 1, 1); PG8_SCHED; PG8_LDA(At, 1, 0); PG8_STAGE(PG8_SA(0, 1), a2 + hstepA, voffA);
            PG8_WAIT_V(8); PG8_WAIT_L(0); PG8_BAR; PG8_MMA(0, 0, At, B0); PG8_MMA(0, 1, At, B1); PG8_BAR; PG8_SCHED;
            PG8_LDA(At, 1, 1); PG8_STAGE(PG8_SB(1, 0), b3, voffB); PG8_STAGE(PG8_SB(1, 1), b3 + hstepB, voffB); PG8_STAGE(PG8_SA(1, 0), a3, voffA);
            PG8_WAIT_V(8); PG8_WAIT_L(0); PG8_BAR; PG8_MMA(1, 0, At, B0); PG8_MMA(1, 1, At, B1); PG8_BAR; PG8_SCHED;
        }
        if (wr == 0) PG8_BAR;
        E(acc, cur, wr, wc, fr, fq);
        if (!has_next) break;
        if (Epi::reset(cur))
#pragma unroll
        for (int a = 0; a < 2; ++a)
#pragma unroll
            for (int b = 0; b < 2; ++b)
#pragma unroll
                for (int m = 0; m < 4; ++m)
#pragma unroll
                    for (int n = 0; n < 2; ++n) acc[a][b][m][n] = (f32x4){0.f, 0.f, 0.f, 0.f};
        cur = nxt; cA = nA; cB = nB; ++ui;
        if (wr == 1) PG8_BAR;
    }
    PG8_WAIT_V(0);
    PG8_BAR;
#undef PG8_SA
#undef PG8_SB
#undef PG8_STAGE
#undef PG8_LDA
#undef PG8_LDB
#undef PG8_MMA
#undef PG8_WAIT_V
#undef PG8_WAIT_L
#undef PG8_BAR
#undef PG8_SCHED
}
}


#define XB_TMO      128
#define XB_XCNT(j)  (256  + 64 * (j))
#define XB_XSUB(j)  (1280 + 64 * (j))
#define XB_XGEN(j)  (2304 + 64 * (j))
#define XB_TOP      3328
#define XB_TOPGEN   3392
#define XCD_BAR_WORDS 3456
#define XB_SPIN_CAP (1u << 18)
__device__ __forceinline__ unsigned xb_ld(unsigned* p)              { return __hip_atomic_load(p, __ATOMIC_RELAXED, __HIP_MEMORY_SCOPE_AGENT); }
__device__ __forceinline__ unsigned xb_add(unsigned* p, unsigned v) { return __hip_atomic_fetch_add(p, v, __ATOMIC_RELAXED, __HIP_MEMORY_SCOPE_AGENT); }
__device__ __forceinline__ unsigned xb_xcc_id() { return (unsigned)__builtin_amdgcn_s_getreg((3 << 11) | 20) & 0xFu; }
#define XB_SPIN(cond, bar) do { unsigned _sp = 0; while (cond) { __builtin_amdgcn_s_sleep(1); \
    if ((++_sp & 255u) == 0u) { if (xb_ld(&(bar)[XB_TMO])) break; if (_sp > XB_SPIN_CAP) { atomicAdd(&(bar)[XB_TMO], 1u); break; } } } } while (0)
__device__ __forceinline__ void xcd_barrier_complete(unsigned* bar, unsigned x, unsigned& nloc, unsigned& nx) {
    const unsigned G = gridDim.x * gridDim.y * gridDim.z;
    unsigned sum, cnt, mine, sp = 0u;
    for (;;) {
        sum = 0u; cnt = 0u; mine = 0u;
#pragma unroll
        for (unsigned j = 0; j < 16; ++j) { const unsigned c = xb_ld(&bar[XB_XCNT(j)]); sum += c; cnt += (c > 0u) ? 1u : 0u; mine = (j == x) ? c : mine; }
        if (sum == G) break;
        __builtin_amdgcn_s_sleep(1);
        if ((++sp & 255u) == 0u) { if (xb_ld(&bar[XB_TMO])) break; if (sp > XB_SPIN_CAP) { atomicAdd(&bar[XB_TMO], 1u); break; } }
    }
    nloc = mine > 0u ? mine : 1u; nx = cnt > 0u ? cnt : 1u;
}
__device__ __forceinline__ void xcd_barrier(unsigned* bar, volatile LAS unsigned* st) {
    asm volatile("s_waitcnt vmcnt(0)" ::: "memory");
    __syncthreads();
    if (threadIdx.x == 0) {
        const unsigned x = xb_xcc_id();
        __builtin_amdgcn_s_waitcnt(0);
        unsigned nloc = st[0], nx = st[1];
        if (nloc == 0u) { xcd_barrier_complete(bar, x, nloc, nx); st[0] = nloc; st[1] = nx; }
        const unsigned old = xb_add(&bar[XB_XSUB(x)], 1u);
        const unsigned gen = old / nloc;
        if (old + 1u == (gen + 1u) * nloc) {
            __builtin_amdgcn_fence(__ATOMIC_RELEASE, "agent");
            asm volatile("s_waitcnt vmcnt(0)" ::: "memory");
            const unsigned og = xb_add(&bar[XB_TOP], 1u);
            const unsigned tg = og / nx;
            if (og + 1u == (tg + 1u) * nx) xb_add(&bar[XB_TOPGEN], 1u);
            else XB_SPIN(xb_ld(&bar[XB_TOPGEN]) == tg, bar);
            __builtin_amdgcn_fence(__ATOMIC_ACQUIRE, "agent");
            xb_add(&bar[XB_XGEN(x)], 1u);
            asm volatile("s_waitcnt vmcnt(0)" ::: "memory");
        } else {
            XB_SPIN(xb_ld(&bar[XB_XGEN(x)]) == gen, bar);
            __builtin_amdgcn_fence(__ATOMIC_ACQUIRE, "agent");
            asm volatile("s_waitcnt vmcnt(0)" ::: "memory");
        }
    }
    __syncthreads();
}

struct Ctx {
    int bx;
    bf16_t *win, *wb, *wout, *h, *proj, *gates, *y, *mb;
    float *mf, *of, *kva, *kvd, *decd, *ropeAc, *ropeAs, *ropeBc, *ropeBs, *lbt;
    int tid, lane, w, G;
};

__device__ __forceinline__ void transpose_tile(const float* src, int N, bf16_t* dst, int Kp, int k0, int n0, float* scr, int tid) {
    const int kk = tid >> 3, c8 = (tid & 7) * 8;
    const float4* s = (const float4*)(src + (size_t)(k0 + kk) * N + n0 + c8);
    const float4 a = s[0], b = s[1];
    float* r = scr + kk * 65 + c8;
    r[0] = a.x; r[1] = a.y; r[2] = a.z; r[3] = a.w; r[4] = b.x; r[5] = b.y; r[6] = b.z; r[7] = b.w;
    __syncthreads();
    const int n = tid >> 3, k8 = (tid & 7) * 8;
    const float* q = scr + k8 * 65 + n;
    u32x4 wv; wv.x = pk2(q[0], q[65]); wv.y = pk2(q[130], q[195]); wv.z = pk2(q[260], q[325]); wv.w = pk2(q[390], q[455]);
    *(u32x4*)(dst + (size_t)(n0 + n) * Kp + k0 + k8) = wv;
    __syncthreads();
}

__device__ __forceinline__ void phase_prologue(const Params& P, Ctx& C, unsigned char* lds) {
    const int tid = C.tid;
    float* scr = (float*)lds;
    for (int job = C.bx; job < 4 * 2496; job += C.G) {
        const int l = job / 2496, j = job % 2496;
        if (j < 1920) { const int kt = j / 120, nt = j % 120; transpose_tile(P.w_in + (size_t)l * DM * DIN, DIN, C.win + (size_t)l * DIN * DM, DM, kt * 64, nt * 64, scr, tid); }
        else if (j < 2240) { const int jj = j - 1920, kt = jj / 16, nt = jj % 16; transpose_tile(P.w_branch + (size_t)l * WMIX * DM, DM, C.wb + (size_t)l * DM * WMIX, WMIX, kt * 64, nt * 64, scr, tid); }
        else { const int jj = j - 2240, kt = jj / 16, nt = jj % 16; transpose_tile(P.w_out + (size_t)l * DM * DM, DM, C.wout + (size_t)l * DM * DM, DM, kt * 64, nt * 64, scr, tid); }
    }
    for (int row = C.bx * 8 + C.w; row < M_TOT; row += C.G * 8) {
        const float* xs = row < M_P ? P.x_prompt + (size_t)row * DM : P.x_sample + (size_t)(row - M_P) * DM;
        float4 x[4]; float ss = 0.f;
#pragma unroll
        for (int i = 0; i < 4; ++i) { x[i] = ((const float4*)xs)[C.lane + 64 * i]; ss += x[i].x * x[i].x + x[i].y * x[i].y + x[i].z * x[i].z + x[i].w * x[i].w; }
        ss = wave_sum(ss); const float r = rsqrtf(ss * (1.f / DM) + EPS);
#pragma unroll
        for (int i = 0; i < 4; ++i) { ((float4*)(P.out + (size_t)row * DM))[C.lane + 64 * i] = x[i];
            const float4 g = ((const float4*)P.g_pre)[C.lane + 64 * i];
            uint2 o; o.x = pk2(x[i].x * r * g.x, x[i].y * r * g.y); o.y = pk2(x[i].z * r * g.z, x[i].w * r * g.w);
            ((uint2*)(C.h + (size_t)row * DM))[C.lane + 64 * i] = o; }
    }
    const int gt = C.bx * NTHREADS + tid, gn = C.G * NTHREADS;
    const double TWO_PI = 6.283185307179586476925286766559, INV_2PI = 0.15915494309189533576888376337251;
    for (int i = gt; i < NPOS * 24; i += gn) {
        int pos, f; double inv;
        if (i < NPOS * 16) { pos = i >> 4; f = i & 15; inv = P.invA[f]; } else { const int k = i - NPOS * 16; pos = k >> 3; f = k & 7; inv = P.invB[f]; }
        double r = (double)pos * inv * INV_2PI; r -= floor(r);
        const float a = (float)(r * TWO_PI);
        const float cs = cosf(a), sn = sinf(a);
        if (i < NPOS * 16) { C.ropeAc[i] = cs; C.ropeAs[i] = sn; } else { C.ropeBc[i - NPOS * 16] = cs; C.ropeBs[i - NPOS * 16] = sn; }
    }
    for (int c = gt; c < 256; c += gn) {
        const float v0 = P.lower_bounds[c], v1 = P.lower_bounds[256 + c], v2 = P.lower_bounds[512 + c], v3 = P.lower_bounds[768 + c];
        const float m = fmaxf(fmaxf(v0, v1), fmaxf(v2, v3));
        const float e0 = expf(v0 - m), e1 = expf(v1 - m), e2 = expf(v2 - m), e3 = expf(v3 - m), inv = 1.f / (e0 + e1 + e2 + e3);
        C.lbt[c] = 0.f; C.lbt[256 + c] = e1 * inv; C.lbt[512 + c] = (e1 + e2) * inv; C.lbt[768 + c] = (e1 + e2 + e3) * inv;
    }
}

__device__ __forceinline__ void attn_prompt_unit(const Params& P, Ctx& C, int l, int b, int qb, int kvh, unsigned char* lds) {
    const int tid = C.tid, lane = C.lane, w = C.w, fr = lane & 15, fq = lane >> 4;
    bf16_t* Ks = (bf16_t*)lds;
    bf16_t* Vt = (bf16_t*)(lds + 36864);
    bf16_t* Ps = (bf16_t*)(lds + 36864 + 35840) + w * (16 * 168);
    const int t0 = qb * 128; const size_t R0 = (size_t)b * 8192 + t0;
    const bool last = (qb == 63);
    for (int i = tid; i < 256 * 7; i += NTHREADS) {
        const int kk = i / 7, task = i - kk * 7, tk = t0 - 128 + kk;
        bf16_t* dst = Ks + kk * 72;
        if (tk < 0) { const u32x4 z = {0u, 0u, 0u, 0u}; if (task == 0) { *(u32x4*)dst = z; *(u32x4*)(dst + 8) = z; } else *(u32x4*)(dst + (task + 1) * 8) = z; }
        else {
            const bf16_t* src = C.proj + (size_t)(b * 8192 + tk) * NPROJ + C_KB + kvh * 64;
            float* kp = P.out + O_KP + ((((size_t)l * 2 + b) * 128 + (kk - 128)) * 2 + kvh) * 64;
            if (task == 0) {
                const u32x4 a = *(const u32x4*)src, bb = *(const u32x4*)(src + 8);
                const float4 c0 = *(const float4*)(C.ropeBc + tk * 8), c1 = *(const float4*)(C.ropeBc + tk * 8 + 4), s0 = *(const float4*)(C.ropeBs + tk * 8), s1 = *(const float4*)(C.ropeBs + tk * 8 + 4);
                const float x1[8] = {lo16(a.x), hi16(a.x), lo16(a.y), hi16(a.y), lo16(a.z), hi16(a.z), lo16(a.w), hi16(a.w)};
                const float x2[8] = {lo16(bb.x), hi16(bb.x), lo16(bb.y), hi16(bb.y), lo16(bb.z), hi16(bb.z), lo16(bb.w), hi16(bb.w)};
                const float cs[8] = {c0.x, c0.y, c0.z, c0.w, c1.x, c1.y, c1.z, c1.w}, sn[8] = {s0.x, s0.y, s0.z, s0.w, s1.x, s1.y, s1.z, s1.w};
                float r1[8], r2[8];
#pragma unroll
                for (int j = 0; j < 8; ++j) { r1[j] = x1[j] * cs[j] - x2[j] * sn[j]; r2[j] = x2[j] * cs[j] + x1[j] * sn[j]; }
                u32x4 o1, o2; o1.x = pk2(r1[0], r1[1]); o1.y = pk2(r1[2], r1[3]); o1.z = pk2(r1[4], r1[5]); o1.w = pk2(r1[6], r1[7]);
                o2.x = pk2(r2[0], r2[1]); o2.y = pk2(r2[2], r2[3]); o2.z = pk2(r2[4], r2[5]); o2.w = pk2(r2[6], r2[7]);
                *(u32x4*)dst = o1; *(u32x4*)(dst + 8) = o2;
                if (last && kk >= 128) {
#pragma unroll
                    for (int j = 0; j < 8; ++j) { kp[j] = r1[j]; kp[8 + j] = r2[j]; } }
            } else {
                const int c = task + 1; const u32x4 a = *(const u32x4*)(src + c * 8); *(u32x4*)(dst + c * 8) = a;
                if (last && kk >= 128) { float* o = kp + c * 8; o[0] = lo16(a.x); o[1] = hi16(a.x); o[2] = lo16(a.y); o[3] = hi16(a.y); o[4] = lo16(a.z); o[5] = hi16(a.z); o[6] = lo16(a.w); o[7] = hi16(a.w); }
            }
        }
    }
    for (int i = tid; i < 256 * 8; i += NTHREADS) {
        const int kk = i >> 3, c = i & 7, tk = t0 - 128 + kk;
        u32x4 a = {0u, 0u, 0u, 0u};
        if (tk >= 0) a = *(const u32x4*)(C.proj + (size_t)(b * 8192 + tk) * NPROJ + C_VB + kvh * 64 + c * 8);
        bf16_t* d = Vt + (c * 8) * 280 + kk;
        d[0] = (bf16_t)(a.x & 0xffff); d[280] = (bf16_t)(a.x >> 16); d[560] = (bf16_t)(a.y & 0xffff); d[840] = (bf16_t)(a.y >> 16);
        d[1120] = (bf16_t)(a.z & 0xffff); d[1400] = (bf16_t)(a.z >> 16); d[1680] = (bf16_t)(a.w & 0xffff); d[1960] = (bf16_t)(a.w >> 16);
        if (last && kk >= 128) { float* o = P.out + O_VP + ((((size_t)l * 2 + b) * 128 + (kk - 128)) * 2 + kvh) * 64 + c * 8;
            o[0] = lo16(a.x); o[1] = hi16(a.x); o[2] = lo16(a.y); o[3] = hi16(a.y); o[4] = lo16(a.z); o[5] = hi16(a.z); o[6] = lo16(a.w); o[7] = hi16(a.w); }
    }
    for (int i = tid; i < 64 * 24; i += NTHREADS) Vt[(i / 24) * 280 + 256 + (i % 24)] = 0;
    for (int i = lane; i < 16 * 16; i += 64) Ps[(i >> 4) * 168 + 144 + (i & 15)] = 0;
    __syncthreads();
    const int tq = t0 + w * 16 + fr;
    for (int g = 0; g < 4; ++g) {
        const int h = kvh * 4 + g;
        const bf16_t* qsrc = C.proj + (R0 + w * 16 + fr) * NPROJ + C_QB + h * 64;
        u32x4 q0 = *(const u32x4*)(qsrc + fq * 8); const u32x4 q1 = *(const u32x4*)(qsrc + 32 + fq * 8);
        if (fq < 2) {
            const u32x4 qp = *(const u32x4*)(qsrc + (fq ^ 1) * 8);
            const float4 c0 = *(const float4*)(C.ropeBc + tq * 8), c1 = *(const float4*)(C.ropeBc + tq * 8 + 4), s0 = *(const float4*)(C.ropeBs + tq * 8), s1 = *(const float4*)(C.ropeBs + tq * 8 + 4);
            const float sg = fq == 0 ? -1.f : 1.f;
            const float own[8] = {lo16(q0.x), hi16(q0.x), lo16(q0.y), hi16(q0.y), lo16(q0.z), hi16(q0.z), lo16(q0.w), hi16(q0.w)};
            const float par[8] = {lo16(qp.x), hi16(qp.x), lo16(qp.y), hi16(qp.y), lo16(qp.z), hi16(qp.z), lo16(qp.w), hi16(qp.w)};
            const float cs[8] = {c0.x, c0.y, c0.z, c0.w, c1.x, c1.y, c1.z, c1.w}, sn[8] = {s0.x, s0.y, s0.z, s0.w, s1.x, s1.y, s1.z, s1.w};
            float r[8];
#pragma unroll
            for (int j = 0; j < 8; ++j) r[j] = own[j] * cs[j] + sg * par[j] * sn[j];
            q0.x = pk2(r[0], r[1]); q0.y = pk2(r[2], r[3]); q0.z = pk2(r[4], r[5]); q0.w = pk2(r[6], r[7]);
        }
        const bf16x8 qa0 = __builtin_bit_cast(bf16x8, q0), qa1 = __builtin_bit_cast(bf16x8, q1);
        f32x4 S[9];
#pragma unroll
        for (int jt = 0; jt < 9; ++jt) {
            const bf16_t* kp = Ks + ((w + jt) * 16 + fr) * 72 + fq * 8;
            f32x4 a = {0.f, 0.f, 0.f, 0.f};
            a = mfma16(qa0, *(const bf16x8*)kp, a); a = mfma16(qa1, *(const bf16x8*)(kp + 32), a);
            S[jt] = a;
        }
        const float sink = P.attn_sink[l * 8 + h];
        float mx[4], sm[4];
#pragma unroll
        for (int j = 0; j < 4; ++j) {
            const int r = w * 16 + fq * 4 + j;
            float m = -1e30f;
#pragma unroll
            for (int jt = 0; jt < 9; ++jt) { const int kk = (w + jt) * 16 + fr; const bool ok = (kk >= r) && (kk <= r + 128) && (t0 - 128 + kk >= 0);
                const float s = ok ? S[jt][j] * 0.125f : -1e30f; S[jt][j] = s; m = fmaxf(m, s); }
            m = fmaxf(quad16_max(m), sink); mx[j] = m;
            float su = 0.f;
#pragma unroll
            for (int jt = 0; jt < 9; ++jt) { const float p = __expf(S[jt][j] - m); su += p; Ps[(fq * 4 + j) * 168 + jt * 16 + fr] = f2bf(p); }
            su = quad16_sum(su) + __expf(sink - m); sm[j] = 1.f / su;
        }
        __syncthreads();
        f32x4 O[4];
#pragma unroll
        for (int nt = 0; nt < 4; ++nt) O[nt] = (f32x4){0.f, 0.f, 0.f, 0.f};
#pragma unroll
        for (int kx = 0; kx < 5; ++kx) {
            const bf16x8 a = *(const bf16x8*)(Ps + fr * 168 + kx * 32 + fq * 8);
#pragma unroll
            for (int nt = 0; nt < 4; ++nt) O[nt] = mfma16(a, *(const bf16x8*)(Vt + (nt * 16 + fr) * 280 + w * 16 + kx * 32 + fq * 8), O[nt]);
        }
#pragma unroll
        for (int j = 0; j < 4; ++j) {
            const size_t row = R0 + w * 16 + fq * 4 + j;
#pragma unroll
            for (int nt = 0; nt < 4; ++nt) { const int e = nt * 16 + fr;
                const float z = bf2f(C.proj[row * NPROJ + C_ZB + h * 64 + e]);
                C.y[row * WMIX + Y_B + h * 64 + e] = f2bf(O[nt][j] * sm[j] * silu_(z)); }
        }
        __syncthreads();
    }
}

__device__ __forceinline__ void pool_prompt_unit(const Params& P, Ctx& C, int l, int tile, unsigned char* lds) {
    const int tid = C.tid, lane = C.lane, w = C.w, fr = lane & 15, fq = lane >> 4;
    bf16_t* U = (bf16_t*)lds;
    bf16_t* A = (bf16_t*)(lds + 40448);
    bf16_t* Wt = (bf16_t*)(lds + 40448 + 33792);
    const int b = tile >> 7, t0 = (tile & 127) * 64; const size_t R0 = (size_t)b * 8192 + t0;
    for (int i = tid; i < 79 * 32; i += NTHREADS) { const int r = i >> 5, c = i & 31, t = t0 - 15 + r;
        u32x4 a = {0u, 0u, 0u, 0u}; if (t >= 0) a = *(const u32x4*)(C.proj + (size_t)(b * 8192 + t) * NPROJ + C_UC + c * 8);
        *(u32x4*)(U + r * 256 + c * 8) = a; }
    for (int i = tid; i < 4 * 64 * 64; i += NTHREADS) { const int g = i >> 12, cin = (i >> 6) & 63, dout = i & 63;
        Wt[(g * 64 + dout) * 72 + cin] = f2bf(P.w_pool[(size_t)l * 16384 + i]); }
    __syncthreads();
    { const int c = tid & 255, rh = tid >> 8, g = c >> 6, wn = 2 << g;
      for (int r = rh * 32; r < rh * 32 + 32; ++r) {
          float s = 0.f; for (int j = 0; j < wn; ++j) s += bf2f(U[(r + 15 - j) * 256 + c]);
          const int pos = t0 + r; const float cnt = (float)(pos + 1 < wn ? pos + 1 : wn);
          const float u = bf2f(U[(r + 15) * 256 + c]);
          A[r * 264 + c] = f2bf(s / cnt - u);
          if (t0 == 8128 && r >= 49) P.out[O_POOLP + (((size_t)l * 2 + b) * 15 + (r - 49)) * 256 + c] = u;
      } }
    __syncthreads();
    for (int tl = w; tl < 64; tl += 8) { const int rt = tl >> 4, ct = tl & 15, g = ct >> 2;
        f32x4 acc = {0.f, 0.f, 0.f, 0.f};
        acc = mma_tile(A + rt * 16 * 264 + g * 64, 264, Wt + (g * 64 + (ct & 3) * 16) * 72, 72, 64, acc, lane);
        const int c = ct * 16 + fr; const float sc = P.pool_scale[l * 256 + c];
#pragma unroll
        for (int j = 0; j < 4; ++j) { const size_t row = R0 + rt * 16 + fq * 4 + j;
            const float z = bf2f(C.proj[row * NPROJ + C_ZC + c]);
            C.y[row * WMIX + Y_C + c] = f2bf(acc[j] * sc * silu_(z)); }
    }
    __syncthreads();
}

template <bool IS_D, bool KV>
__device__ __forceinline__ void lin_chunk(const Params& P, Ctx& C, int l, int b, int n, unsigned char* lds) {
    const int tid = C.tid, lane = C.lane, w = C.w, fr = lane & 15, fq = lane >> 4;
    constexpr int DK = IS_D ? 64 : 32;
    float* Bc = (float*)lds;
    bf16_t* Qh = (bf16_t*)(lds + 65536);
    bf16_t* Kh = (bf16_t*)(lds + 74752);
    bf16_t* PQ = (bf16_t*)(lds + 83968);
    bf16_t* VS = (bf16_t*)(lds + 101376);
    bf16_t* KdT = (bf16_t*)(lds + 118784);
    const size_t R0 = (size_t)b * 8192 + n * 64;
    if (IS_D) {
        for (int i = tid; i < 64 * 256; i += NTHREADS) { const int t = i >> 8, c = i & 255;
            const float fv = bf2f(C.proj[(R0 + t) * NPROJ + C_FD + c]); const float lb = C.lbt[l * 256 + c];
            Bc[i] = __logf(lb + (1.f - lb) * sigmoid_(fv)); }
        __syncthreads();
        if (tid < 256) { float a = 0.f; for (int t = 0; t < 64; ++t) { a += Bc[t * 256 + tid]; Bc[t * 256 + tid] = a; } }
        __syncthreads();
    }
    for (int h = 0; h < 4; ++h) {
        float lg = 0.f; if (!IS_D) lg = log1pf(-exp2f(-5.f - (float)h));
        for (int i = tid; i < 64 * DK; i += NTHREADS) {
            const int t = i / DK, d = i % DK;
            float q, k, Bt, Bm, Bl;
            if (IS_D) { const int c = h * 64 + d;
                q = silu_(bf2f(C.proj[(R0 + t) * NPROJ + C_QD + c]));
                const float fv = bf2f(C.proj[(R0 + t) * NPROJ + C_FD + c]); const float lb = C.lbt[l * 256 + c];
                k = 1.f - (lb + (1.f - lb) * sigmoid_(fv));
                Bt = Bc[t * 256 + c]; Bm = Bc[31 * 256 + c]; Bl = Bc[63 * 256 + c];
            } else { const int ii = d & 15, pos = n * 64 + t;
                const bf16_t* pr = C.proj + (R0 + t) * NPROJ;
                const float cs = C.ropeAc[pos * 16 + ii], sn = C.ropeAs[pos * 16 + ii];
                const float q1 = bf2f(pr[C_QA + h * 32 + ii]), q2 = bf2f(pr[C_QA + h * 32 + 16 + ii]);
                const float k1 = bf2f(pr[C_KA + h * 32 + ii]), k2 = bf2f(pr[C_KA + h * 32 + 16 + ii]);
                q = d < 16 ? q1 * cs - q2 * sn : q2 * cs + q1 * sn;
                k = (d < 16 ? k1 * cs - k2 * sn : k2 * cs + k1 * sn) * 0.17677669529663687f;
                Bt = (float)(t + 1) * lg; Bm = 32.f * lg; Bl = 64.f * lg;
            }
            if (!KV) { Qh[t * 72 + d] = f2bf(q * __expf(Bt - Bm)); Kh[t * 72 + d] = f2bf(k * __expf(Bm - Bt)); PQ[t * 136 + 64 + d] = f2bf(q * __expf(Bt)); }
            else KdT[d * 72 + t] = f2bf(k * __expf(Bl - Bt));
        }
        for (int i = tid; i < 64 * 64; i += NTHREADS) { const int s = i >> 6, e = i & 63;
            VS[e * 136 + s] = C.proj[(R0 + s) * NPROJ + (IS_D ? C_ID : C_VA) + h * 64 + e]; }
        float* kvbase = (IS_D ? C.kvd : C.kva) + ((size_t)(b * 128 + n) * 4 + h) * (DK * 64);
        if (!KV) for (int i = tid; i < DK * 64; i += NTHREADS) { const int d = i >> 6, e = i & 63; VS[e * 136 + 64 + d] = f2bf(kvbase[i]); }
        __syncthreads();
        if (KV) {
            for (int tl = w; tl < (DK / 16) * 4; tl += 8) { const int dt = tl >> 2, et = tl & 3;
                f32x4 acc = {0.f, 0.f, 0.f, 0.f};
                acc = mma_tile(KdT + dt * 16 * 72, 72, VS + et * 16 * 136, 136, 64, acc, lane);
#pragma unroll
                for (int j = 0; j < 4; ++j) kvbase[(dt * 16 + fq * 4 + j) * 64 + et * 16 + fr] = acc[j]; }
            if (IS_D && tid < 64) C.decd[(size_t)(b * 128 + n) * 256 + h * 64 + tid] = __expf(Bc[63 * 256 + h * 64 + tid]);
        } else {
            for (int tl = w; tl < 16; tl += 8) { const int rt = tl >> 2, ct = tl & 3;
                f32x4 acc = {0.f, 0.f, 0.f, 0.f};
                if (ct <= rt) acc = mma_tile(Qh + rt * 16 * 72, 72, Kh + ct * 16 * 72, 72, DK, acc, lane);
#pragma unroll
                for (int j = 0; j < 4; ++j) { const int t = rt * 16 + fq * 4 + j, s = ct * 16 + fr; PQ[t * 136 + s] = f2bf(s <= t ? acc[j] : 0.f); } }
            __syncthreads();
            if (w < 4) { const int rt = w;
                f32x4 O[4];
#pragma unroll
                for (int et = 0; et < 4; ++et) { O[et] = (f32x4){0.f, 0.f, 0.f, 0.f}; O[et] = mma_tile(PQ + rt * 16 * 136, 136, VS + et * 16 * 136, 136, 64 + DK, O[et], lane); }
#pragma unroll
                for (int j = 0; j < 4; ++j) {
                    float ss = O[0][j] * O[0][j] + O[1][j] * O[1][j] + O[2][j] * O[2][j] + O[3][j] * O[3][j];
                    ss = quad16_sum(ss); const float r = rsqrtf(ss * (1.f / 64.f) + EPS);
                    const size_t row = R0 + rt * 16 + fq * 4 + j;
#pragma unroll
                    for (int et = 0; et < 4; ++et) { const int e = et * 16 + fr;
                        const float z = bf2f(C.proj[row * NPROJ + (IS_D ? C_ZD : C_ZA) + h * 64 + e]);
                        const float gsc = IS_D ? P.g_hgrn[l * 256 + h * 64 + e] : 1.f;
                        C.y[row * WMIX + (IS_D ? Y_D : Y_A) + h * 64 + e] = f2bf(O[et][j] * r * gsc * silu_(z)); }
                }
            }
        }
        __syncthreads();
    }
}

__device__ __forceinline__ void sample_unit(const Params& P, Ctx& C, int l, int sb, unsigned char* lds) {
    const int tid = C.tid, lane = C.lane, w = C.w;
    bf16_t* prb = (bf16_t*)lds;
    float* qa = (float*)(lds + 28672);
    float* ka = qa + 512;
    float* qd = ka + 512;
    float* fd = qd + 1024;
    float* qbq = fd + 1024;
    float* kn = qbq + 2048;
    float* pl = kn + 512;
    float* ps = pl + 1024;
    float* kv = ps + 32 * 136;
    const size_t R0 = (size_t)M_P + sb * 4;
    for (int i = tid; i < 4 * 448; i += NTHREADS) { const int t = i / 448, c = i % 448;
        *(u32x4*)(prb + t * NPROJ + c * 8) = *(const u32x4*)(C.proj + (R0 + t) * NPROJ + c * 8); }
    __syncthreads();
#define PR(t, c) bf2f(prb[(t) * NPROJ + (c)])
    {
        const int t = tid >> 7, c = tid & 127, h = c >> 5, d = c & 31, ii = d & 15, pos = 8192 + t;
        const float cs = C.ropeAc[pos * 16 + ii], sn = C.ropeAs[pos * 16 + ii];
        const float q1 = PR(t, C_QA + h * 32 + ii), q2 = PR(t, C_QA + h * 32 + 16 + ii), k1 = PR(t, C_KA + h * 32 + ii), k2 = PR(t, C_KA + h * 32 + 16 + ii);
        qa[tid] = d < 16 ? q1 * cs - q2 * sn : q2 * cs + q1 * sn;
        ka[tid] = (d < 16 ? k1 * cs - k2 * sn : k2 * cs + k1 * sn) * 0.17677669529663687f;
    }
    for (int i = tid; i < 1024; i += NTHREADS) { const int t = i >> 8, c = i & 255;
        qd[i] = silu_(PR(t, C_QD + c)); const float lb = C.lbt[l * 256 + c]; fd[i] = lb + (1.f - lb) * sigmoid_(PR(t, C_FD + c));
        const int g = c >> 6, wn = 2 << g; float s = 0.f;
        for (int j = 0; j < wn; ++j) { const int e = 15 + t - j; s += e >= 15 ? PR(e - 15, C_UC + c) : P.state_pool[(((size_t)l * 128 + sb) * 15 + e) * 256 + c]; }
        pl[i] = s / (float)wn - PR(t, C_UC + c); }
    for (int i = tid; i < 2048; i += NTHREADS) { const int t = i >> 9, c = i & 511, h = c >> 6, d = c & 63; const int pos = 8192 + t;
        float v;
        if (d < 16) { const int ii = d & 7; const float cs = C.ropeBc[pos * 8 + ii], sn = C.ropeBs[pos * 8 + ii];
            const float x1 = PR(t, C_QB + h * 64 + ii), x2 = PR(t, C_QB + h * 64 + 8 + ii); v = d < 8 ? x1 * cs - x2 * sn : x2 * cs + x1 * sn; }
        else v = PR(t, C_QB + c);
        qbq[i] = v * 0.125f; }
    { const int t = tid >> 7, c = tid & 127, kh = c >> 6, d = c & 63, pos = 8192 + t;
        float v;
        if (d < 16) { const int ii = d & 7; const float cs = C.ropeBc[pos * 8 + ii], sn = C.ropeBs[pos * 8 + ii];
            const float x1 = PR(t, C_KB + kh * 64 + ii), x2 = PR(t, C_KB + kh * 64 + 8 + ii); v = d < 8 ? x1 * cs - x2 * sn : x2 * cs + x1 * sn; }
        else v = PR(t, C_KB + c);
        kn[tid] = v;
        P.out[O_KS + (((size_t)l * 128 + sb) * 128 + 124 + t) * 128 + c] = v;
        P.out[O_VS + (((size_t)l * 128 + sb) * 128 + 124 + t) * 128 + c] = PR(t, C_VB + c); }
    for (int i = tid; i < 15 * 256; i += NTHREADS) { const int r = i >> 8, c = i & 255;
        P.out[O_POOLS + (((size_t)l * 128 + sb) * 15 + r) * 256 + c] = r < 11 ? P.state_pool[(((size_t)l * 128 + sb) * 15 + r + 4) * 256 + c] : PR(r - 11, C_UC + c); }
    { const float* kc = P.cache_k + ((size_t)l * 128 + sb) * 16384; float* ko = P.out + O_KS + ((size_t)l * 128 + sb) * 16384;
      for (int i = tid; i < 4096; i += NTHREADS) { const float4 v = ((const float4*)kc)[i]; const int e = i * 4, wq = e >> 7, r = e & 127, kh = r >> 6, d = r & 63;
          float* dst = kv + (wq * 2 + kh) * 65 + d; dst[0] = v.x; dst[1] = v.y; dst[2] = v.z; dst[3] = v.w;
          if (wq >= 4) ((float4*)ko)[i - 128] = v; } }
    __syncthreads();
    if (w < 4) { const int h = w, e = lane;
        const float gam = 1.f - exp2f(-5.f - (float)h);
        const float* S0 = P.state_ret + (((size_t)l * 128 + sb) * 4 + h) * 2048; float* S1 = P.out + O_RETS + (((size_t)l * 128 + sb) * 4 + h) * 2048;
        const float v0 = PR(0, C_VA + h * 64 + e), v1 = PR(1, C_VA + h * 64 + e), v2 = PR(2, C_VA + h * 64 + e), v3 = PR(3, C_VA + h * 64 + e);
        float o0 = 0.f, o1 = 0.f, o2 = 0.f, o3 = 0.f;
#pragma unroll 8
        for (int d = 0; d < 32; ++d) { float s = S0[d * 64 + e]; const int c = h * 32 + d;
            s = gam * s + ka[c] * v0; o0 += qa[c] * s; s = gam * s + ka[128 + c] * v1; o1 += qa[128 + c] * s;
            s = gam * s + ka[256 + c] * v2; o2 += qa[256 + c] * s; s = gam * s + ka[384 + c] * v3; o3 += qa[384 + c] * s; S1[d * 64 + e] = s; }
        const float r0 = rsqrtf(wave_sum(o0 * o0) * (1.f / 64.f) + EPS), r1 = rsqrtf(wave_sum(o1 * o1) * (1.f / 64.f) + EPS);
        const float r2 = rsqrtf(wave_sum(o2 * o2) * (1.f / 64.f) + EPS), r3 = rsqrtf(wave_sum(o3 * o3) * (1.f / 64.f) + EPS);
        const int c = h * 64 + e;
        C.y[(R0 + 0) * WMIX + Y_A + c] = f2bf(o0 * r0 * silu_(PR(0, C_ZA + c))); C.y[(R0 + 1) * WMIX + Y_A + c] = f2bf(o1 * r1 * silu_(PR(1, C_ZA + c)));
        C.y[(R0 + 2) * WMIX + Y_A + c] = f2bf(o2 * r2 * silu_(PR(2, C_ZA + c))); C.y[(R0 + 3) * WMIX + Y_A + c] = f2bf(o3 * r3 * silu_(PR(3, C_ZA + c)));
    } else { const int h = w - 4, e = lane;
        const float* S0 = P.state_hgrn + (((size_t)l * 128 + sb) * 4 + h) * 4096; float* S1 = P.out + O_HGRNS + (((size_t)l * 128 + sb) * 4 + h) * 4096;
        const float v0 = PR(0, C_ID + h * 64 + e), v1 = PR(1, C_ID + h * 64 + e), v2 = PR(2, C_ID + h * 64 + e), v3 = PR(3, C_ID + h * 64 + e);
        float o0 = 0.f, o1 = 0.f, o2 = 0.f, o3 = 0.f;
#pragma unroll 8
        for (int d = 0; d < 64; ++d) { float s = S0[d * 64 + e]; const int c = h * 64 + d;
            float f = fd[c]; s = f * s + (1.f - f) * v0; o0 += qd[c] * s; f = fd[256 + c]; s = f * s + (1.f - f) * v1; o1 += qd[256 + c] * s;
            f = fd[512 + c]; s = f * s + (1.f - f) * v2; o2 += qd[512 + c] * s; f = fd[768 + c]; s = f * s + (1.f - f) * v3; o3 += qd[768 + c] * s; S1[d * 64 + e] = s; }
        const float r0 = rsqrtf(wave_sum(o0 * o0) * (1.f / 64.f) + EPS), r1 = rsqrtf(wave_sum(o1 * o1) * (1.f / 64.f) + EPS);
        const float r2 = rsqrtf(wave_sum(o2 * o2) * (1.f / 64.f) + EPS), r3 = rsqrtf(wave_sum(o3 * o3) * (1.f / 64.f) + EPS);
        const int c = h * 64 + e; const float gs = P.g_hgrn[l * 256 + c];
        C.y[(R0 + 0) * WMIX + Y_D + c] = f2bf(o0 * r0 * gs * silu_(PR(0, C_ZD + c))); C.y[(R0 + 1) * WMIX + Y_D + c] = f2bf(o1 * r1 * gs * silu_(PR(1, C_ZD + c)));
        C.y[(R0 + 2) * WMIX + Y_D + c] = f2bf(o2 * r2 * gs * silu_(PR(2, C_ZD + c))); C.y[(R0 + 3) * WMIX + Y_D + c] = f2bf(o3 * r3 * gs * silu_(PR(3, C_ZD + c)));
    }
    { const int c = tid & 255, tp = tid >> 8, g = c >> 6, dout = c & 63;
      float a0 = 0.f, a1 = 0.f; const float* wp = P.w_pool + ((size_t)l * 4 + g) * 4096 + dout;
#pragma unroll 8
      for (int cin = 0; cin < 64; ++cin) { const float wv = wp[cin * 64]; a0 += pl[(2 * tp) * 256 + g * 64 + cin] * wv; a1 += pl[(2 * tp + 1) * 256 + g * 64 + cin] * wv; }
      const float sc = P.pool_scale[l * 256 + c];
      C.y[(R0 + 2 * tp) * WMIX + Y_C + c] = f2bf(a0 * sc * silu_(PR(2 * tp, C_ZC + c)));
      C.y[(R0 + 2 * tp + 1) * WMIX + Y_C + c] = f2bf(a1 * sc * silu_(PR(2 * tp + 1, C_ZC + c))); }
    for (int i = tid; i < 4224; i += NTHREADS) { const int kh = i / 2112, rem = i - kh * 2112, r16 = rem / 132, kk = rem - r16 * 132, g = r16 >> 2, t = r16 & 3, h = kh * 4 + g;
        const bool ok = kk < 128 ? (kk >= t) : (kk - 128 <= t);
        const float* kp = kk < 128 ? kv + (kk * 2 + kh) * 65 : kn + (kk - 128) * 128 + kh * 64;
        const float* qp = qbq + t * 512 + h * 64;
        float s = 0.f;
#pragma unroll 16
        for (int d = 0; d < 64; ++d) s += qp[d] * kp[d];
        ps[(h * 4 + t) * 136 + kk] = ok ? s : -1e30f; }
    __syncthreads();
    { const int h = w; const float sink = P.attn_sink[l * 8 + h];
      for (int t = 0; t < 4; ++t) { float* pr_ = ps + (h * 4 + t) * 136;
          const float s0 = pr_[lane], s1 = pr_[lane + 64], s2 = lane < 4 ? pr_[lane + 128] : -1e30f;
          float m = fmaxf(fmaxf(s0, s1), s2); m = fmaxf(m, __shfl_xor(m, 32)); m = fmaxf(m, __shfl_xor(m, 16)); m = fmaxf(m, __shfl_xor(m, 8)); m = fmaxf(m, __shfl_xor(m, 4)); m = fmaxf(m, __shfl_xor(m, 2)); m = fmaxf(m, __shfl_xor(m, 1));
          m = fmaxf(m, sink);
          const float p0 = __expf(s0 - m), p1 = __expf(s1 - m), p2 = lane < 4 ? __expf(s2 - m) : 0.f;
          const float inv = 1.f / (wave_sum(p0 + p1 + p2) + __expf(sink - m));
          pr_[lane] = p0 * inv; pr_[lane + 64] = p1 * inv; if (lane < 4) pr_[lane + 128] = p2 * inv; } }
    __syncthreads();
    { const float* vc = P.cache_v + ((size_t)l * 128 + sb) * 16384; float* vo = P.out + O_VS + ((size_t)l * 128 + sb) * 16384;
      for (int i = tid; i < 4096; i += NTHREADS) { const float4 v = ((const float4*)vc)[i]; const int e = i * 4, wq = e >> 7, r = e & 127, kh = r >> 6, d = r & 63;
          float* dst = kv + (wq * 2 + kh) * 65 + d; dst[0] = v.x; dst[1] = v.y; dst[2] = v.z; dst[3] = v.w;
          if (wq >= 4) ((float4*)vo)[i - 128] = v; } }
    __syncthreads();
    { const int h = w, kh = h >> 2, e = lane;
      float o0 = 0.f, o1 = 0.f, o2 = 0.f, o3 = 0.f; const float* p0 = ps + (h * 4) * 136;
      for (int kk = 0; kk < 128; ++kk) { const float v = kv[(kk * 2 + kh) * 65 + e]; o0 += p0[kk] * v; o1 += p0[136 + kk] * v; o2 += p0[272 + kk] * v; o3 += p0[408 + kk] * v; }
      for (int kk = 128; kk < 132; ++kk) { const float v = PR(kk - 128, C_VB + kh * 64 + e); o0 += p0[kk] * v; o1 += p0[136 + kk] * v; o2 += p0[272 + kk] * v; o3 += p0[408 + kk] * v; }
      const int c = h * 64 + e;
      C.y[(R0 + 0) * WMIX + Y_B + c] = f2bf(o0 * silu_(PR(0, C_ZB + c))); C.y[(R0 + 1) * WMIX + Y_B + c] = f2bf(o1 * silu_(PR(1, C_ZB + c)));
      C.y[(R0 + 2) * WMIX + Y_B + c] = f2bf(o2 * silu_(PR(2, C_ZB + c))); C.y[(R0 + 3) * WMIX + Y_B + c] = f2bf(o3 * silu_(PR(3, C_ZB + c))); }
#undef PR
    __syncthreads();
}

__device__ __forceinline__ void phase_scan(const Params& P, Ctx& C, int l) {
    for (int g = C.bx * NTHREADS + C.tid; g < 49152; g += C.G * NTHREADS) {
        if (g < 16384) { const int b = g >> 13, r = g & 8191, h = r >> 11, de = r & 2047;
            float* base = C.kva + ((size_t)(b * 128) * 4 + h) * 2048 + de;
            const float dec = __expf(64.f * log1pf(-exp2f(-5.f - (float)h)));
            float S = 0.f;
            for (int n0 = 0; n0 < 128; n0 += 16) { float v[16];
#pragma unroll
                for (int i = 0; i < 16; ++i) v[i] = base[(size_t)(n0 + i) * 8192];
#pragma unroll
                for (int i = 0; i < 16; ++i) { base[(size_t)(n0 + i) * 8192] = S; S = dec * S + v[i]; } }
            P.out[O_RETP + (((size_t)l * 2 + b) * 4 + h) * 2048 + de] = S;
        } else { const int gg = g - 16384, b = gg >> 14, r = gg & 16383, h = r >> 12, de = r & 4095, d = de >> 6;
            float* base = C.kvd + ((size_t)(b * 128) * 4 + h) * 4096 + de;
            const float* dp = C.decd + (size_t)(b * 128) * 256 + h * 64 + d;
            float S = 0.f;
            for (int n0 = 0; n0 < 128; n0 += 16) { float v[16], dc[16];
#pragma unroll
                for (int i = 0; i < 16; ++i) { v[i] = base[(size_t)(n0 + i) * 16384]; dc[i] = dp[(n0 + i) * 256]; }
#pragma unroll
                for (int i = 0; i < 16; ++i) { base[(size_t)(n0 + i) * 16384] = S; S = dc[i] * S + v[i]; } }
            P.out[O_HGRNP + (((size_t)l * 2 + b) * 4 + h) * 4096 + de] = S;
        }
    }
}

__device__ __forceinline__ void phase_finalize(const Params& P, Ctx& C, int l) {
    const int lane = C.lane;
    for (int row = C.bx * 8 + C.w; row < M_TOT; row += C.G * 8) {
        const float4* o4 = (const float4*)(C.of + (size_t)row * DM); float4* x4 = (float4*)(P.out + (size_t)row * DM);
        float4 o[4], x[4]; float ss = 0.f;
#pragma unroll
        for (int i = 0; i < 4; ++i) { o[i] = o4[lane + 64 * i]; x[i] = x4[lane + 64 * i]; ss += o[i].x * o[i].x + o[i].y * o[i].y + o[i].z * o[i].z + o[i].w * o[i].w; }
        ss = wave_sum(ss); const float r = rsqrtf(ss * (1.f / DM) + EPS);
        float s2 = 0.f;
#pragma unroll
        for (int i = 0; i < 4; ++i) { const float4 g = ((const float4*)(P.g_post + l * DM))[lane + 64 * i];
            x[i].x += o[i].x * r * g.x; x[i].y += o[i].y * r * g.y; x[i].z += o[i].z * r * g.z; x[i].w += o[i].w * r * g.w;
            x4[lane + 64 * i] = x[i]; s2 += x[i].x * x[i].x + x[i].y * x[i].y + x[i].z * x[i].z + x[i].w * x[i].w; }
        if (l < 3) { s2 = wave_sum(s2); const float r2 = rsqrtf(s2 * (1.f / DM) + EPS);
#pragma unroll
            for (int i = 0; i < 4; ++i) { const float4 g = ((const float4*)(P.g_pre + (l + 1) * DM))[lane + 64 * i];
                uint2 ov; ov.x = pk2(x[i].x * r2 * g.x, x[i].y * r2 * g.y); ov.y = pk2(x[i].z * r2 * g.z, x[i].w * r2 * g.w);
                ((uint2*)(C.h + (size_t)row * DM))[lane + 64 * i] = ov; } }
    }
}

#ifndef PH_MASK
#define PH_MASK 2047
#endif
__global__ void __launch_bounds__(NTHREADS, 2) fwd_kernel(Params P) {
    extern __shared__ __attribute__((aligned(16))) unsigned char lds[];
    LAS unsigned char* ldsl = (LAS unsigned char*)lds;
    volatile LAS unsigned* bst = (volatile LAS unsigned*)(ldsl + LDS_BYTES - 16);
    if (threadIdx.x == 0) { bst[0] = 0u; bst[1] = 0u; if (P.coop) (void)xb_add((unsigned*)P.ws + XB_XCNT(xb_xcc_id()), 1u); }
    __syncthreads();

    for (int ph = P.ph_lo; ph < P.ph_hi; ++ph) {
        int nrep = 1;
#ifdef DUP_SP
        if (ph > 0 && ((ph - 1) % 7) == DUP_SP) nrep = 2;
#endif
        for (int rep = 0; rep < nrep; ++rep) {
        if (rep) xcd_barrier((unsigned*)P.ws, bst);
        int tid_ = threadIdx.x, bx = blockIdx.x, G_ = gridDim.x; __attribute__((address_space(1))) unsigned char* wsg = (__attribute__((address_space(1))) unsigned char*)P.ws;
        asm volatile("" : "+v"(tid_)); asm volatile("" : "+s"(bx)); asm volatile("" : "+s"(G_)); asm volatile("" : "+s"(wsg));
        unsigned char* ws = (unsigned char*)wsg;
        Ctx C;
        C.win = (bf16_t*)(ws + WS_WIN); C.wb = (bf16_t*)(ws + WS_WB); C.wout = (bf16_t*)(ws + WS_WOUT); C.h = (bf16_t*)(ws + WS_H); C.mb = (bf16_t*)(ws + WS_H);
        C.proj = (bf16_t*)(ws + WS_PROJ); C.mf = (float*)(ws + WS_PROJ); C.gates = (bf16_t*)(ws + WS_GATES); C.of = (float*)(ws + WS_GATES); C.y = (bf16_t*)(ws + WS_Y);
        C.kva = (float*)(ws + WS_KVA); C.kvd = (float*)(ws + WS_KVD); C.decd = (float*)(ws + WS_DECD);
        C.ropeAc = (float*)(ws + WS_ROPEA); C.ropeAs = C.ropeAc + NPOS * 16; C.ropeBc = (float*)(ws + WS_ROPEB); C.ropeBs = C.ropeBc + NPOS * 8; C.lbt = (float*)(ws + WS_LB);
        C.bx = bx; C.tid = tid_; C.lane = tid_ & 63; C.w = __builtin_amdgcn_readfirstlane(tid_ >> 6); C.G = G_;
        const int vcu = (C.G % 8 == 0) ? (bx % 8) * (C.G / 8) + bx / 8 : bx;
        if (ph == 0) { if (PH_MASK & 1) phase_prologue(P, C, lds); }
        else {
            const int l = (ph - 1) / 7, sp = (ph - 1) % 7;
            if (sp == 0) {
              if (PH_MASK & 2) {
                pg8::Gemm g{C.h, C.win + (size_t)l * DIN * DM, DM, DM}; pg8::StaticOrder S; S.init(M_TOT, DIN, DM, C.G, bx);
                pg8::EpiProj E{C.proj, C.gates};
                pg8::gemm_phase<pg8::EpiProj, pg8::StaticOrder>(ldsl, g, S, E, C.tid); }
            } else if (sp == 1) {
                for (int u = bx; u < 1152; u += C.G) {
                    if (u < 256) { if (PH_MASK & 4) attn_prompt_unit(P, C, l, u >> 7, (u & 127) >> 1, u & 1, lds); }
                    else if (u < 384) { if (PH_MASK & 8) sample_unit(P, C, l, u - 256, lds); }
                    else if (u < 640) { if (PH_MASK & 16) pool_prompt_unit(P, C, l, u - 384, lds); }
                    else if (u < 896) { if (PH_MASK & 32) lin_chunk<false, true>(P, C, l, (u - 640) >> 7, (u - 640) & 127, lds); }
                    else { if (PH_MASK & 32) lin_chunk<true, true>(P, C, l, (u - 896) >> 7, (u - 896) & 127, lds); }
                }
            } else if (sp == 2) { if (PH_MASK & 64) phase_scan(P, C, l); }
            else if (sp == 3) {
                for (int u = bx; u < 512; u += C.G) {
                    if (u < 256) { if (PH_MASK & 128) lin_chunk<false, false>(P, C, l, u >> 7, u & 127, lds); }
                    else { if (PH_MASK & 128) lin_chunk<true, false>(P, C, l, (u - 256) >> 7, (u - 256) & 127, lds); }
                }
            } else if (sp == 4) {
              if (PH_MASK & 256) {
                pg8::Gemm g{C.y, C.wb + (size_t)l * DM * WMIX, WMIX, WMIX}; pg8::BranchOrder S{264, C.G, vcu};
                pg8::EpiBranch E{C.gates, C.mb};
                pg8::gemm_phase<pg8::EpiBranch, pg8::BranchOrder>(ldsl, g, S, E, C.tid); }
            } else if (sp == 5) {
              if (PH_MASK & 512) {
                pg8::Gemm g{C.mb, C.wout + (size_t)l * DM * DM, DM, DM}; pg8::TileOrder S{264, C.G, vcu, DM / 64};
                pg8::EpiF32 E{C.of};
                pg8::gemm_phase<pg8::EpiF32, pg8::TileOrder>(ldsl, g, S, E, C.tid); }
            } else { if (PH_MASK & 1024) phase_finalize(P, C, l); }
        }
        }
        if (ph + 1 < P.ph_hi && P.coop) { if (ph == 0) cg::this_grid().sync(); else xcd_barrier((unsigned*)P.ws, bst); }
    }
}

#ifndef N_LAUNCH_MODE
#define N_LAUNCH_MODE 1
#endif
extern "C" void kernel_launch(void* const* d_in, const int* in_sizes, int n_in, void* d_out, int out_size, void* d_ws, size_t ws_size, hipStream_t stream) {
    static int grid = 0;
    if (grid == 0) {
        if (n_in != 17 || (size_t)out_size != O_END || ws_size < WS_END) { fprintf(stderr, "kernel_launch: unexpected sizes n_in %d out %d ws %zu\n", n_in, out_size, ws_size); grid = -1; return; }
        int dev = 0, cus = 0, per_cu = 0;
        hipGetDevice(&dev); hipDeviceGetAttribute(&cus, hipDeviceAttributeMultiprocessorCount, dev);
        if (hipFuncSetAttribute((const void*)fwd_kernel, hipFuncAttributeMaxDynamicSharedMemorySize, LDS_BYTES) != hipSuccess) { fprintf(stderr, "hipFuncSetAttribute failed\n"); grid = -1; return; }
        if (hipOccupancyMaxActiveBlocksPerMultiprocessor(&per_cu, (const void*)fwd_kernel, NTHREADS, LDS_BYTES) != hipSuccess || per_cu < 1) { fprintf(stderr, "occupancy query: %d\n", per_cu); per_cu = 1; }
        (void)hipGetLastError();
        grid = cus * 1;
        if (per_cu < 1) grid = -1;
    }
    if (grid < 0) return;
    Params p{};
    const float* const* in = (const float* const*)d_in;
    p.x_prompt = in[0]; p.x_sample = in[1]; p.state_ret = in[2]; p.cache_k = in[3]; p.cache_v = in[4]; p.state_pool = in[5]; p.state_hgrn = in[6];
    p.w_in = in[7]; p.w_branch = in[8]; p.w_out = in[9]; p.g_pre = in[10]; p.g_post = in[11]; p.attn_sink = in[12]; p.w_pool = in[13];
    p.pool_scale = in[14]; p.g_hgrn = in[15]; p.lower_bounds = in[16];
    p.out = (float*)d_out; p.ws = (unsigned char*)d_ws;
    for (int i = 0; i < 16; ++i) p.invA[i] = pow(10000.0, -(double)i / 16.0);
    for (int i = 0; i < 8; ++i) p.invB[i] = pow(500000.0, -(double)i / 8.0);
    const int NPH = 29;
#if N_LAUNCH_MODE == 1
    (void)hipMemsetAsync(d_ws, 0, 16384, stream);
    p.ph_lo = 0; p.ph_hi = NPH; p.coop = 1; p.pad = 0;
    void* args[] = {&p};
    hipError_t e = hipLaunchCooperativeKernel((const void*)fwd_kernel, dim3(grid), dim3(NTHREADS), args, LDS_BYTES, stream);
    if (e != hipSuccess) fprintf(stderr, "cooperative launch failed: %s (grid %d)\n", hipGetErrorString(e), grid);
#else
    for (int ph = 0; ph < NPH; ++ph) {
        p.ph_lo = ph; p.ph_hi = ph + 1; p.coop = 0; p.pad = 0;
        hipLaunchKernelGGL(fwd_kernel, dim3(grid), dim3(NTHREADS), LDS_BYTES, stream, p);
    }
#endif
}
```

```cpp
#include <hip/hip_runtime.h>
#include <hip/hip_cooperative_groups.h>
#include <cstdio>
#include <cstdint>
#include <cmath>
namespace cg = cooperative_groups;

#define LAS __attribute__((address_space(3)))
typedef unsigned short bf16_t;
typedef short bf16x8 __attribute__((ext_vector_type(8)));
typedef float f32x4 __attribute__((ext_vector_type(4)));
typedef unsigned u32x4 __attribute__((ext_vector_type(4)));

constexpr int M_TOT = 16896, M_P = 16384, DM = 1024, DIN = 7680, NPROJ = 3584, NGATE = 4096, WMIX = 1280;
constexpr int C_QA = 0, C_KA = 128, C_VA = 256, C_ZA = 512, C_QB = 768, C_KB = 1280, C_VB = 1408, C_ZB = 1536, C_UC = 2048, C_ZC = 2304,
              C_QD = 2560, C_FD = 2816, C_ID = 3072, C_ZD = 3328;
constexpr int Y_A = 0, Y_B = 256, Y_C = 768, Y_D = 1024;
constexpr size_t O_YP = 0, O_YS = 16777216, O_RETP = 17301504, O_KP = 17367040, O_VP = 17498112, O_POOLP = 17629184, O_HGRNP = 17659904,
                 O_RETS = 17790976, O_KS = 21985280, O_VS = 30373888, O_POOLS = 38762496, O_HGRNS = 40728576, O_END = 49117184;
constexpr float EPS = 1e-6f;
constexpr int NPOS = 8196;

constexpr size_t MiB = 1u << 20;
constexpr size_t WS_ROPEA = 1 * MiB;
constexpr size_t WS_ROPEB = 3 * MiB;
constexpr size_t WS_LB = 3 * MiB + 768 * 1024;
constexpr size_t WS_WIN = 4 * MiB;
constexpr size_t WS_WB = 64 * MiB;
constexpr size_t WS_WOUT = 74 * MiB;
constexpr size_t WS_H = 82 * MiB;
constexpr size_t WS_PROJ = 115 * MiB;
constexpr size_t WS_GATES = 231 * MiB;
constexpr size_t WS_Y = 363 * MiB;
constexpr size_t WS_KVA = 405 * MiB;
constexpr size_t WS_KVD = 413 * MiB;
constexpr size_t WS_DECD = 429 * MiB;
constexpr size_t WS_END = 430 * MiB;

constexpr int LDS_BYTES = 147456;
constexpr int NTHREADS = 512;

struct Params {
    const float* x_prompt; const float* x_sample; const float* state_ret; const float* cache_k; const float* cache_v; const float* state_pool; const float* state_hgrn;
    const float* w_in; const float* w_branch; const float* w_out; const float* g_pre; const float* g_post; const float* attn_sink; const float* w_pool;
    const float* pool_scale; const float* g_hgrn; const float* lower_bounds;
    float* out; unsigned char* ws;
    double invA[16]; double invB[8];
    int ph_lo, ph_hi, coop, pad;
};

__device__ __forceinline__ float bf2f(bf16_t v) { return __uint_as_float(((unsigned)v) << 16); }
__device__ __forceinline__ bf16_t f2bf(float f) { unsigned u = __float_as_uint(f); return (bf16_t)((u + 0x7fffu + ((u >> 16) & 1u)) >> 16); }
__device__ __forceinline__ unsigned pk2(float lo, float hi) { return (unsigned)f2bf(lo) | ((unsigned)f2bf(hi) << 16); }
__device__ __forceinline__ float lo16(unsigned u) { return __uint_as_float(u << 16); }
__device__ __forceinline__ float hi16(unsigned u) { return __uint_as_float(u & 0xffff0000u); }
__device__ __forceinline__ float sigmoid_(float x) { return 1.f / (1.f + __expf(-x)); }
__device__ __forceinline__ float silu_(float x) { return x / (1.f + __expf(-x)); }
__device__ __forceinline__ float wave_sum(float v) {
    v += __shfl_xor(v, 32); v += __shfl_xor(v, 16); v += __shfl_xor(v, 8); v += __shfl_xor(v, 4); v += __shfl_xor(v, 2); v += __shfl_xor(v, 1); return v;
}
__device__ __forceinline__ float quad16_sum(float v) { v += __shfl_xor(v, 8); v += __shfl_xor(v, 4); v += __shfl_xor(v, 2); v += __shfl_xor(v, 1); return v; }
__device__ __forceinline__ float quad16_max(float v) { v = fmaxf(v, __shfl_xor(v, 8)); v = fmaxf(v, __shfl_xor(v, 4)); v = fmaxf(v, __shfl_xor(v, 2)); v = fmaxf(v, __shfl_xor(v, 1)); return v; }
__device__ __forceinline__ f32x4 mfma16(bf16x8 a, bf16x8 b, f32x4 c) { return __builtin_amdgcn_mfma_f32_16x16x32_bf16(a, b, c, 0, 0, 0); }
__device__ __forceinline__ f32x4 mma_tile(const bf16_t* As, int lda, const bf16_t* Bs, int ldb, int K, f32x4 acc, int lane) {
    const bf16_t* ap = As + (lane & 15) * lda + (lane >> 4) * 8;
    const bf16_t* bp = Bs + (lane & 15) * ldb + (lane >> 4) * 8;
    for (int k = 0; k < K; k += 32) acc = mfma16(*(const bf16x8*)(ap + k), *(const bf16x8*)(bp + k), acc);
    return acc;
}

namespace pg8 {
constexpr int BM = 256, BK = 64, HALF = 128, HTB = HALF * BK * 2, STAGE_BYTES = 8 * HTB, NXCD = 8, WGM = 8;
__host__ __device__ __forceinline__ int lds_byte(int r, int c) { const int st = (r >> 4) * 2 + (c >> 5), rr = r & 15, cc = c & 31, ob = rr * 64 + cc * 2; return st * 1024 + (ob ^ (((ob >> 9) & 1) << 5)); }
__host__ __device__ __forceinline__ void stage_rc(int b, int& R, int& C) { const int st = b / 1024, sb = b % 1024, swz = sb ^ (((sb >> 9) & 1) << 5); R = (st >> 1) * 16 + swz / 64; C = (st & 1) * 32 + (swz % 64) / 2; }
__host__ __device__ __forceinline__ int perm32(int rho) { const int n = rho >> 4, i = rho & 15; return 8 * (i >> 2) + 4 * n + (i & 3); }

struct Unit { int pm, pn, k0, nt, br; };
struct Gemm { const bf16_t* A; const bf16_t* Bt; int lda, ldb; };

struct StaticOrder {
    int nM, nN, nwg, G, c, nt;
    __device__ void init(int M, int N, int K, int G_, int c_) { nM = M / BM; nN = N / BM; nwg = nM * nN; G = G_; c = c_; nt = K / BK; }
    __device__ bool next(int i, Unit& u) const {
        const long L = (long)i * G + c; if (L >= nwg) return false;
        int wgid = (int)L; { const int q = nwg / NXCD, r = nwg % NXCD, xcd = wgid % NXCD, off = wgid / NXCD; wgid = (xcd < r ? xcd * (q + 1) : r * (q + 1) + (xcd - r) * q) + off; }
        const int nig = WGM * nN, gid = wgid / nig, fm = gid * WGM, gsz = (nM - fm) < WGM ? (nM - fm) : WGM;
        u.pm = fm + ((wgid % nig) % gsz); u.pn = (wgid % nig) / gsz; u.k0 = 0; u.nt = nt; u.br = 0; return true;
    }
};
struct TileOrder {
    int ntiles, G, c, nt;
    __device__ bool next(int i, Unit& u) const { const int t = i * G + c; if (t >= ntiles) return false; u.pm = t >> 2; u.pn = t & 3; u.k0 = 0; u.nt = nt; u.br = 0; return true; }
};
struct BranchOrder {
    int ntiles, G, c;
    __device__ bool next(int i, Unit& u) const {
        const int t = (i >> 2) * G + c; if (t >= ntiles) return false; const int br = i & 3;
        u.pm = t >> 2; u.pn = t & 3; u.br = br; u.k0 = br == 0 ? 0 : (br == 1 ? 256 : (br == 2 ? 768 : 1024)); u.nt = br == 1 ? 8 : 4; return true;
    }
};

struct EpiProj {
    static __device__ __forceinline__ bool reset(const Unit&) { return true; }
    bf16_t* proj; bf16_t* gates;
    __device__ __forceinline__ void operator()(f32x4 (&acc)[2][2][4][2], const Unit& u, int wr, int wc, int fr, int fq) const {
        const int row0 = u.pm * BM + wr * 64 + fr;
        const bool isg = u.pn >= 14;
        bf16_t* base = isg ? gates : proj; const int ld = isg ? NGATE : NPROJ;
        const int col0 = (isg ? (u.pn - 14) : u.pn) * BM + wc * 32 + 8 * fq;
#pragma unroll
        for (int ai = 0; ai < 2; ++ai)
#pragma unroll
            for (int m = 0; m < 4; ++m) { bf16_t* rowp = base + (size_t)(row0 + ai * HALF + m * 16) * ld + col0;
#pragma unroll
                for (int bj = 0; bj < 2; ++bj) { f32x4 v0 = acc[ai][bj][m][0], v1 = acc[ai][bj][m][1];
                    if (isg) {
#pragma unroll
                        for (int i = 0; i < 4; ++i) { v0[i] = fmaxf(sigmoid_(v0[i]), 1e-6f); v1[i] = fmaxf(sigmoid_(v1[i]), 1e-6f); } }
                    u32x4 w; w.x = pk2(v0[0], v0[1]); w.y = pk2(v0[2], v0[3]); w.z = pk2(v1[0], v1[1]); w.w = pk2(v1[2], v1[3]);
                    *(u32x4*)(rowp + bj * HALF) = w; } }
    }
};
struct EpiBranch {
    static __device__ __forceinline__ bool reset(const Unit& u) { return u.br == 3; }
    const bf16_t* gates; bf16_t* mb;
    __device__ __forceinline__ void operator()(f32x4 (&acc)[2][2][4][2], const Unit& u, int wr, int wc, int fr, int fq) const {
        const int row0 = u.pm * BM + wr * 64 + fr, col0 = u.pn * BM + wc * 32 + 8 * fq;
#pragma unroll
        for (int ai = 0; ai < 2; ++ai)
#pragma unroll
            for (int m = 0; m < 4; ++m) { const size_t row = (size_t)(row0 + ai * HALF + m * 16);
#pragma unroll
                for (int bj = 0; bj < 2; ++bj) { const int col = col0 + bj * HALF;
                    const u32x4 g = *(const u32x4*)(gates + row * NGATE + u.br * 1024 + col);
                    float s[8] = {lo16(g.x), hi16(g.x), lo16(g.y), hi16(g.y), lo16(g.z), hi16(g.z), lo16(g.w), hi16(g.w)};
                    if (u.br < 3) { const u32x4 gn = *(const u32x4*)(gates + row * NGATE + (u.br + 1) * 1024 + col);
                        s[0] *= __builtin_amdgcn_rcpf(lo16(gn.x)); s[1] *= __builtin_amdgcn_rcpf(hi16(gn.x)); s[2] *= __builtin_amdgcn_rcpf(lo16(gn.y)); s[3] *= __builtin_amdgcn_rcpf(hi16(gn.y));
                        s[4] *= __builtin_amdgcn_rcpf(lo16(gn.z)); s[5] *= __builtin_amdgcn_rcpf(hi16(gn.z)); s[6] *= __builtin_amdgcn_rcpf(lo16(gn.w)); s[7] *= __builtin_amdgcn_rcpf(hi16(gn.w)); }
                    f32x4 v0 = acc[ai][bj][m][0], v1 = acc[ai][bj][m][1];
                    v0[0] *= s[0]; v0[1] *= s[1]; v0[2] *= s[2]; v0[3] *= s[3]; v1[0] *= s[4]; v1[1] *= s[5]; v1[2] *= s[6]; v1[3] *= s[7];
                    if (u.br < 3) { acc[ai][bj][m][0] = v0; acc[ai][bj][m][1] = v1; }
                    else { u32x4 w; w.x = pk2(v0[0], v0[1]); w.y = pk2(v0[2], v0[3]); w.z = pk2(v1[0], v1[1]); w.w = pk2(v1[2], v1[3]); *(u32x4*)(mb + row * DM + col) = w; } } }
    }
};
struct EpiF32 {
    static __device__ __forceinline__ bool reset(const Unit&) { return true; }
    float* o;
    __device__ __forceinline__ void operator()(f32x4 (&acc)[2][2][4][2], const Unit& u, int wr, int wc, int fr, int fq) const {
        const int row0 = u.pm * BM + wr * 64 + fr, col0 = u.pn * BM + wc * 32 + 8 * fq;
#pragma unroll
        for (int ai = 0; ai < 2; ++ai)
#pragma unroll
            for (int m = 0; m < 4; ++m) { float* rowp = o + (size_t)(row0 + ai * HALF + m * 16) * DM + col0;
#pragma unroll
                for (int bj = 0; bj < 2; ++bj) { *(f32x4*)(rowp + bj * HALF) = acc[ai][bj][m][0]; *(f32x4*)(rowp + bj * HALF + 4) = acc[ai][bj][m][1]; } }
    }
};

template <class Epi, class Sched>
__device__ __forceinline__ void gemm_phase(LAS unsigned char* lds, const Gemm g, const Sched& S, const Epi& E, const int tid) {
    const int wid = __builtin_amdgcn_readfirstlane(tid >> 6), lane = tid & 63, wr = wid >> 2, wc = wid & 3, fr = lane & 15, fq = lane >> 4;
    unsigned voffA[2], voffB[2];
#pragma unroll
    for (int i = 0; i < 2; ++i) { int R, C; stage_rc(tid * 16 + i * 8192, R, C); const int Rb = (R & ~31) + perm32(R & 31);
        voffA[i] = (unsigned)(R * g.lda + C) * 2u; voffB[i] = (unsigned)(Rb * g.ldb + C) * 2u; }
    const size_t kstep = (size_t)(BK * 2);
    const size_t hstepA = (size_t)HALF * g.lda * 2, hstepB = (size_t)HALF * g.ldb * 2;
    const size_t tstepA = 2 * hstepA, tstepB = 2 * hstepB;
    const unsigned ldsw = (unsigned)wid * 1024u;
    const int aoff = lds_byte(wr * 64 + fr, fq * 8), boff = lds_byte(wc * 32 + fr, fq * 8);
#define PG8_SA(b, h) (((b) * 2 + (h)) * HTB)
#define PG8_SB(b, h) ((4 + (b) * 2 + (h)) * HTB)
#define PG8_STAGE(bufoff, gbase, voff) do { _Pragma("unroll") for (int _i = 0; _i < 2; ++_i) \
        __builtin_amdgcn_global_load_lds((const unsigned*)((const char*)(gbase) + (voff)[_i]), (LAS unsigned*)(lds + (bufoff) + ldsw + _i * 8192), 16, 0, 0); } while (0)
#define PG8_LDA(dst, b, h) do { _Pragma("unroll") for (int m = 0; m < 4; ++m) _Pragma("unroll") for (int k = 0; k < 2; ++k) dst[m][k] = *(const LAS bf16x8*)(lds + PG8_SA(b, h) + aoff + m * 2048 + k * 1024); } while (0)
#define PG8_LDB(dst, b, h) do { _Pragma("unroll") for (int n = 0; n < 2; ++n) _Pragma("unroll") for (int k = 0; k < 2; ++k) dst[n][k] = *(const LAS bf16x8*)(lds + PG8_SB(b, h) + boff + n * 2048 + k * 1024); } while (0)
#define PG8_MMA(ai, bj, At, Bt) do { __builtin_amdgcn_s_setprio(1); _Pragma("unroll") for (int m = 0; m < 4; ++m) _Pragma("unroll") for (int n = 0; n < 2; ++n) _Pragma("unroll") for (int k = 0; k < 2; ++k) \
        acc[ai][bj][m][n] = __builtin_amdgcn_mfma_f32_16x16x32_bf16(Bt[n][k], At[m][k], acc[ai][bj][m][n], 0, 0, 0); __builtin_amdgcn_s_setprio(0); } while (0)
#define PG8_WAIT_V(n) asm volatile("s_waitcnt vmcnt(" #n ")" ::: "memory")
#define PG8_WAIT_L(n) asm volatile("s_waitcnt lgkmcnt(" #n ")" ::: "memory")
#define PG8_BAR __builtin_amdgcn_s_barrier()
#define PG8_SCHED __builtin_amdgcn_sched_barrier(0)
    Unit cur, nxt; int ui = 0;
    if (!S.next(0, cur)) return;
    f32x4 acc[2][2][4][2];
#pragma unroll
    for (int a = 0; a < 2; ++a)
#pragma unroll
        for (int b = 0; b < 2; ++b)
#pragma unroll
            for (int m = 0; m < 4; ++m)
#pragma unroll
                for (int n = 0; n < 2; ++n) acc[a][b][m][n] = (f32x4){0.f, 0.f, 0.f, 0.f};
    bf16x8 At[4][2], B0[2][2], B1[2][2];
    const char* cA = (const char*)g.A + (size_t)cur.pm * tstepA + (size_t)cur.k0 * 2; const char* cB = (const char*)g.Bt + (size_t)cur.pn * tstepB + (size_t)cur.k0 * 2;
    PG8_STAGE(PG8_SB(0, 0), cB, voffB); PG8_STAGE(PG8_SB(0, 1), cB + hstepB, voffB); PG8_STAGE(PG8_SA(0, 0), cA, voffA); PG8_STAGE(PG8_SA(0, 1), cA + hstepA, voffA);
    if (wr == 1) PG8_BAR;
    PG8_WAIT_V(2); PG8_BAR;
    PG8_STAGE(PG8_SB(1, 0), cB + kstep, voffB); PG8_STAGE(PG8_SA(1, 0), cA + kstep, voffA); PG8_STAGE(PG8_SB(1, 1), cB + hstepB + kstep, voffB);
    PG8_WAIT_V(6); PG8_BAR;
    for (;;) {
        const bool has_next = S.next(ui + 1, nxt);
        const char* nA = has_next ? (const char*)g.A + (size_t)nxt.pm * tstepA + (size_t)nxt.k0 * 2 : cA;
        const char* nB = has_next ? (const char*)g.Bt + (size_t)nxt.pn * tstepB + (size_t)nxt.k0 * 2 : cB;
        const int nt = cur.nt;
        for (int t = 0; t < nt; t += 2) {
            const bool last = (t == nt - 2);
            const char* a1 = cA + (size_t)(t + 1) * kstep;
            const char* a2 = last ? nA : cA + (size_t)(t + 2) * kstep; const char* b2 = last ? nB : cB + (size_t)(t + 2) * kstep;
            const char* a3 = a2 + kstep; const char* b3 = b2 + kstep;
            PG8_LDB(B0, 0, 0); PG8_LDB(B1, 0, 1); PG8_SCHED; PG8_LDA(At, 0, 0); PG8_STAGE(PG8_SA(1, 1), a1 + hstepA, voffA);
            PG8_WAIT_V(8); PG8_WAIT_L(0); PG8_BAR; PG8_MMA(0, 0, At, B0); PG8_MMA(0, 1, At, B1); PG8_BAR; PG8_SCHED;
            PG8_LDA(At, 0, 1); PG8_STAGE(PG8_SB(0, 0), b2, voffB); PG8_STAGE(PG8_SB(0, 1), b2 + hstepB, voffB); PG8_STAGE(PG8_SA(0, 0), a2, voffA);
            PG8_WAIT_V(8); PG8_WAIT_L(0); PG8_BAR; PG8_MMA(1, 0, At, B0); PG8_MMA(1, 1, At, B1); PG8_BAR; PG8_SCHED;
            PG8_LDB(B0, 1, 0); PG8_LDB(B1, 1, 1); PG8_SCHED; PG8_LDA(At, 1, 0); PG8_STAGE(PG8_SA(0, 1), a2 + hstepA, voffA);
            PG8_WAIT_V(8); PG8_WAIT_L(0); PG8_BAR; PG8_MMA(0, 0, At, B0); PG8_MMA(0, 1, At, B1); PG8_BAR; PG8_SCHED;
            PG8_LDA(At, 1, 1); PG8_STAGE(PG8_SB(1, 0), b3, voffB); PG8_STAGE(PG8_SB(1, 1), b3 + hstepB, voffB); PG8_STAGE(PG8_SA(1, 0), a3, voffA);
            PG8_WAIT_V(8); PG8_WAIT_L(0); PG8_BAR; PG8_MMA(1, 0, At, B0); PG8_MMA(1, 1, At, B1); PG8_BAR; PG8_SCHED;
        }
        if (wr == 0) PG8_BAR;
        E(acc, cur, wr, wc, fr, fq);
        if (!has_next) break;
        if (Epi::reset(cur))
#pragma unroll
        for (int a = 0; a < 2; ++a)
#pragma unroll
            for (int b = 0; b < 2; ++b)
#pragma unroll
                for (int m = 0; m < 4; ++m)
#pragma unroll
                    for (int n = 0; n < 2; ++n) acc[a][b][m][n] = (f32x4){0.f, 0.f, 0.f, 0.f};
        cur = nxt; cA = nA; cB = nB; ++ui;
        if (wr == 1) PG8_BAR;
    }
    PG8_WAIT_V(0);
    PG8_BAR;
#undef PG8_SA
#undef PG8_SB
#undef PG8_STAGE
#undef PG8_LDA
#undef PG8_LDB
#undef PG8_MMA
#undef PG8_WAIT_V
#undef PG8_WAIT_L
#undef PG8_BAR
#undef PG8_SCHED
}
}


#define XB_TMO      128
#define XB_XCNT(j)  (256  + 64 * (j))
#define XB_XSUB(j)  (1280 + 64 * (j))
#define XB_XGEN(j)  (2304 + 64 * (j))
#define XB_TOP      3328
#define XB_TOPGEN   3392
#define XCD_BAR_WORDS 3456
#define XB_SPIN_CAP (1u << 18)
__device__ __forceinline__ unsigned xb_ld(unsigned* p)              { return __hip_atomic_load(p, __ATOMIC_RELAXED, __HIP_MEMORY_SCOPE_AGENT); }
__device__ __forceinline__ unsigned xb_add(unsigned* p, unsigned v) { return __hip_atomic_fetch_add(p, v, __ATOMIC_RELAXED, __HIP_MEMORY_SCOPE_AGENT); }
__device__ __forceinline__ unsigned xb_xcc_id() { return (unsigned)__builtin_amdgcn_s_getreg((3 << 11) | 20) & 0xFu; }
#define XB_SPIN(cond, bar) do { unsigned _sp = 0; while (cond) { __builtin_amdgcn_s_sleep(1); \
    if ((++_sp & 255u) == 0u) { if (xb_ld(&(bar)[XB_TMO])) break; if (_sp > XB_SPIN_CAP) { atomicAdd(&(bar)[XB_TMO], 1u); break; } } } } while (0)
__device__ __forceinline__ void xcd_barrier_complete(unsigned* bar, unsigned x, unsigned& nloc, unsigned& nx) {
    const unsigned G = gridDim.x * gridDim.y * gridDim.z;
    unsigned sum, cnt, mine, sp = 0u;
    for (;;) {
        sum = 0u; cnt = 0u; mine = 0u;
#pragma unroll
        for (unsigned j = 0; j < 16; ++j) { const unsigned c = xb_ld(&bar[XB_XCNT(j)]); sum += c; cnt += (c > 0u) ? 1u : 0u; mine = (j == x) ? c : mine; }
        if (sum == G) break;
        __builtin_amdgcn_s_sleep(1);
        if ((++sp & 255u) == 0u) { if (xb_ld(&bar[XB_TMO])) break; if (sp > XB_SPIN_CAP) { atomicAdd(&bar[XB_TMO], 1u); break; } }
    }
    nloc = mine > 0u ? mine : 1u; nx = cnt > 0u ? cnt : 1u;
}
__device__ __forceinline__ void xcd_barrier(unsigned* bar, volatile LAS unsigned* st) {
    asm volatile("s_waitcnt vmcnt(0)" ::: "memory");
    __syncthreads();
    if (threadIdx.x == 0) {
        const unsigned x = xb_xcc_id();
        __builtin_amdgcn_s_waitcnt(0);
        unsigned nloc = st[0], nx = st[1];
        if (nloc == 0u) { xcd_barrier_complete(bar, x, nloc, nx); st[0] = nloc; st[1] = nx; }
        const unsigned old = xb_add(&bar[XB_XSUB(x)], 1u);
        const unsigned gen = old / nloc;
        if (old + 1u == (gen + 1u) * nloc) {
            __builtin_amdgcn_fence(__ATOMIC_RELEASE, "agent");
            asm volatile("s_waitcnt vmcnt(0)" ::: "memory");
            const unsigned og = xb_add(&bar[XB_TOP], 1u);
            const unsigned tg = og / nx;
            if (og + 1u == (tg + 1u) * nx) xb_add(&bar[XB_TOPGEN], 1u);
            else XB_SPIN(xb_ld(&bar[XB_TOPGEN]) == tg, bar);
            __builtin_amdgcn_fence(__ATOMIC_ACQUIRE, "agent");
            xb_add(&bar[XB_XGEN(x)], 1u);
            asm volatile("s_waitcnt vmcnt(0)" ::: "memory");
        } else {
            XB_SPIN(xb_ld(&bar[XB_XGEN(x)]) == gen, bar);
            __builtin_amdgcn_fence(__ATOMIC_ACQUIRE, "agent");
            asm volatile("s_waitcnt vmcnt(0)" ::: "memory");
        }
    }
    __syncthreads();
}

struct Ctx {
    int bx;
    bf16_t *win, *wb, *wout, *h, *proj, *gates, *y, *mb;
    float *mf, *of, *kva, *kvd, *decd, *ropeAc, *ropeAs, *ropeBc, *ropeBs, *lbt;
    int tid, lane, w, G;
};

__device__ __forceinline__ void transpose_tile(const float* src, int N, bf16_t* dst, int Kp, int k0, int n0, float* scr, int tid) {
    const int kk = tid >> 3, c8 = (tid & 7) * 8;
    const float4* s = (const float4*)(src + (size_t)(k0 + kk) * N + n0 + c8);
    const float4 a = s[0], b = s[1];
    float* r = scr + kk * 65 + c8;
    r[0] = a.x; r[1] = a.y; r[2] = a.z; r[3] = a.w; r[4] = b.x; r[5] = b.y; r[6] = b.z; r[7] = b.w;
    __syncthreads();
    const int n = tid >> 3, k8 = (tid & 7) * 8;
    const float* q = scr + k8 * 65 + n;
    u32x4 wv; wv.x = pk2(q[0], q[65]); wv.y = pk2(q[130], q[195]); wv.z = pk2(q[260], q[325]); wv.w = pk2(q[390], q[455]);
    *(u32x4*)(dst + (size_t)(n0 + n) * Kp + k0 + k8) = wv;
    __syncthreads();
}

__device__ __forceinline__ void phase_prologue(const Params& P, Ctx& C, unsigned char* lds) {
    const int tid = C.tid;
    float* scr = (float*)lds;
    for (int job = C.bx; job < 4 * 2496; job += C.G) {
        const int l = job / 2496, j = job % 2496;
        if (j < 1920) { const int kt = j / 120, nt = j % 120; transpose_tile(P.w_in + (size_t)l * DM * DIN, DIN, C.win + (size_t)l * DIN * DM, DM, kt * 64, nt * 64, scr, tid); }
        else if (j < 2240) { const int jj = j - 1920, kt = jj / 16, nt = jj % 16; transpose_tile(P.w_branch + (size_t)l * WMIX * DM, DM, C.wb + (size_t)l * DM * WMIX, WMIX, kt * 64, nt * 64, scr, tid); }
        else { const int jj = j - 2240, kt = jj / 16, nt = jj % 16; transpose_tile(P.w_out + (size_t)l * DM * DM, DM, C.wout + (size_t)l * DM * DM, DM, kt * 64, nt * 64, scr, tid); }
    }
    for (int row = C.bx * 8 + C.w; row < M_TOT; row += C.G * 8) {
        const float* xs = row < M_P ? P.x_prompt + (size_t)row * DM : P.x_sample + (size_t)(row - M_P) * DM;
        float4 x[4]; float ss = 0.f;
#pragma unroll
        for (int i = 0; i < 4; ++i) { x[i] = ((const float4*)xs)[C.lane + 64 * i]; ss += x[i].x * x[i].x + x[i].y * x[i].y + x[i].z * x[i].z + x[i].w * x[i].w; }
        ss = wave_sum(ss); const float r = rsqrtf(ss * (1.f / DM) + EPS);
#pragma unroll
        for (int i = 0; i < 4; ++i) { ((float4*)(P.out + (size_t)row * DM))[C.lane + 64 * i] = x[i];
            const float4 g = ((const float4*)P.g_pre)[C.lane + 64 * i];
            uint2 o; o.x = pk2(x[i].x * r * g.x, x[i].y * r * g.y); o.y = pk2(x[i].z * r * g.z, x[i].w * r * g.w);
            ((uint2*)(C.h + (size_t)row * DM))[C.lane + 64 * i] = o; }
    }
    const int gt = C.bx * NTHREADS + tid, gn = C.G * NTHREADS;
    const double TWO_PI = 6.283185307179586476925286766559, INV_2PI = 0.15915494309189533576888376337251;
    for (int i = gt; i < NPOS * 24; i += gn) {
        int pos, f; double inv;
        if (i < NPOS * 16) { pos = i >> 4; f = i & 15; inv = P.invA[f]; } else { const int k = i - NPOS * 16; pos = k >> 3; f = k & 7; inv = P.invB[f]; }
        double r = (double)pos * inv * INV_2PI; r -= floor(r);
        const float a = (float)(r * TWO_PI);
        const float cs = cosf(a), sn = sinf(a);
        if (i < NPOS * 16) { C.ropeAc[i] = cs; C.ropeAs[i] = sn; } else { C.ropeBc[i - NPOS * 16] = cs; C.ropeBs[i - NPOS * 16] = sn; }
    }
    for (int c = gt; c < 256; c += gn) {
        const float v0 = P.lower_bounds[c], v1 = P.lower_bounds[256 + c], v2 = P.lower_bounds[512 + c], v3 = P.lower_bounds[768 + c];
        const float m = fmaxf(fmaxf(v0, v1), fmaxf(v2, v3));
        const float e0 = expf(v0 - m), e1 = expf(v1 - m), e2 = expf(v2 - m), e3 = expf(v3 - m), inv = 1.f / (e0 + e1 + e2 + e3);
        C.lbt[c] = 0.f; C.lbt[256 + c] = e1 * inv; C.lbt[512 + c] = (e1 + e2) * inv; C.lbt[768 + c] = (e1 + e2 + e3) * inv;
    }
}

__device__ __forceinline__ void attn_prompt_unit(const Params& P, Ctx& C, int l, int b, int qb, int kvh, unsigned char* lds) {
    const int tid = C.tid, lane = C.lane, w = C.w, fr = lane & 15, fq = lane >> 4;
    bf16_t* Ks = (bf16_t*)lds;
    bf16_t* Vt = (bf16_t*)(lds + 36864);
    bf16_t* Ps = (bf16_t*)(lds + 36864 + 35840) + w * (16 * 168);
    const int t0 = qb * 128; const size_t R0 = (size_t)b * 8192 + t0;
    const bool last = (qb == 63);
    for (int i = tid; i < 256 * 7; i += NTHREADS) {
        const int kk = i / 7, task = i - kk * 7, tk = t0 - 128 + kk;
        bf16_t* dst = Ks + kk * 72;
        if (tk < 0) { const u32x4 z = {0u, 0u, 0u, 0u}; if (task == 0) { *(u32x4*)dst = z; *(u32x4*)(dst + 8) = z; } else *(u32x4*)(dst + (task + 1) * 8) = z; }
        else {
            const bf16_t* src = C.proj + (size_t)(b * 8192 + tk) * NPROJ + C_KB + kvh * 64;
            float* kp = P.out + O_KP + ((((size_t)l * 2 + b) * 128 + (kk - 128)) * 2 + kvh) * 64;
            if (task == 0) {
                const u32x4 a = *(const u32x4*)src, bb = *(const u32x4*)(src + 8);
                const float4 c0 = *(const float4*)(C.ropeBc + tk * 8), c1 = *(const float4*)(C.ropeBc + tk * 8 + 4), s0 = *(const float4*)(C.ropeBs + tk * 8), s1 = *(const float4*)(C.ropeBs + tk * 8 + 4);
                const float x1[8] = {lo16(a.x), hi16(a.x), lo16(a.y), hi16(a.y), lo16(a.z), hi16(a.z), lo16(a.w), hi16(a.w)};
                const float x2[8] = {lo16(bb.x), hi16(bb.x), lo16(bb.y), hi16(bb.y), lo16(bb.z), hi16(bb.z), lo16(bb.w), hi16(bb.w)};
                const float cs[8] = {c0.x, c0.y, c0.z, c0.w, c1.x, c1.y, c1.z, c1.w}, sn[8] = {s0.x, s0.y, s0.z, s0.w, s1.x, s1.y, s1.z, s1.w};
                float r1[8], r2[8];
#pragma unroll
                for (int j = 0; j < 8; ++j) { r1[j] = x1[j] * cs[j] - x2[j] * sn[j]; r2[j] = x2[j] * cs[j] + x1[j] * sn[j]; }
                u32x4 o1, o2; o1.x = pk2(r1[0], r1[1]); o1.y = pk2(r1[2], r1[3]); o1.z = pk2(r1[4], r1[5]); o1.w = pk2(r1[6], r1[7]);
                o2.x = pk2(r2[0], r2[1]); o2.y = pk2(r2[2], r2[3]); o2.z = pk2(r2[4], r2[5]); o2.w = pk2(r2[6], r2[7]);
                *(u32x4*)dst = o1; *(u32x4*)(dst + 8) = o2;
                if (last && kk >= 128) {
#pragma unroll
                    for (int j = 0; j < 8; ++j) { kp[j] = r1[j]; kp[8 + j] = r2[j]; } }
            } else {
                const int c = task + 1; const u32x4 a = *(const u32x4*)(src + c * 8); *(u32x4*)(dst + c * 8) = a;
                if (last && kk >= 128) { float* o = kp + c * 8; o[0] = lo16(a.x); o[1] = hi16(a.x); o[2] = lo16(a.y); o[3] = hi16(a.y); o[4] = lo16(a.z); o[5] = hi16(a.z); o[6] = lo16(a.w); o[7] = hi16(a.w); }
            }
        }
    }
    for (int i = tid; i < 256 * 8; i += NTHREADS) {
        const int kk = i >> 3, c = i & 7, tk = t0 - 128 + kk;
        u32x4 a = {0u, 0u, 0u, 0u};
        if (tk >= 0) a = *(const u32x4*)(C.proj + (size_t)(b * 8192 + tk) * NPROJ + C_VB + kvh * 64 + c * 8);
        bf16_t* d = Vt + (c * 8) * 280 + kk;
        d[0] = (bf16_t)(a.x & 0xffff); d[280] = (bf16_t)(a.x >> 16); d[560] = (bf16_t)(a.y & 0xffff); d[840] = (bf16_t)(a.y >> 16);
        d[1120] = (bf16_t)(a.z & 0xffff); d[1400] = (bf16_t)(a.z >> 16); d[1680] = (bf16_t)(a.w & 0xffff); d[1960] = (bf16_t)(a.w >> 16);
        if (last && kk >= 128) { float* o = P.out + O_VP + ((((size_t)l * 2 + b) * 128 + (kk - 128)) * 2 + kvh) * 64 + c * 8;
            o[0] = lo16(a.x); o[1] = hi16(a.x); o[2] = lo16(a.y); o[3] = hi16(a.y); o[4] = lo16(a.z); o[5] = hi16(a.z); o[6] = lo16(a.w); o[7] = hi16(a.w); }
    }
    for (int i = tid; i < 64 * 24; i += NTHREADS) Vt[(i / 24) * 280 + 256 + (i % 24)] = 0;
    for (int i = lane; i < 16 * 16; i += 64) Ps[(i >> 4) * 168 + 144 + (i & 15)] = 0;
    __syncthreads();
    const int tq = t0 + w * 16 + fr;
    for (int g = 0; g < 4; ++g) {
        const int h = kvh * 4 + g;
        const bf16_t* qsrc = C.proj + (R0 + w * 16 + fr) * NPROJ + C_QB + h * 64;
        u32x4 q0 = *(const u32x4*)(qsrc + fq * 8); const u32x4 q1 = *(const u32x4*)(qsrc + 32 + fq * 8);
        if (fq < 2) {
            const u32x4 qp = *(const u32x4*)(qsrc + (fq ^ 1) * 8);
            const float4 c0 = *(const float4*)(C.ropeBc + tq * 8), c1 = *(const float4*)(C.ropeBc + tq * 8 + 4), s0 = *(const float4*)(C.ropeBs + tq * 8), s1 = *(const float4*)(C.ropeBs + tq * 8 + 4);
            const float sg = fq == 0 ? -1.f : 1.f;
            const float own[8] = {lo16(q0.x), hi16(q0.x), lo16(q0.y), hi16(q0.y), lo16(q0.z), hi16(q0.z), lo16(q0.w), hi16(q0.w)};
            const float par[8] = {lo16(qp.x), hi16(qp.x), lo16(qp.y), hi16(qp.y), lo16(qp.z), hi16(qp.z), lo16(qp.w), hi16(qp.w)};
            const float cs[8] = {c0.x, c0.y, c0.z, c0.w, c1.x, c1.y, c1.z, c1.w}, sn[8] = {s0.x, s0.y, s0.z, s0.w, s1.x, s1.y, s1.z, s1.w};
            float r[8];
#pragma unroll
            for (int j = 0; j < 8; ++j) r[j] = own[j] * cs[j] + sg * par[j] * sn[j];
            q0.x = pk2(r[0], r[1]); q0.y = pk2(r[2], r[3]); q0.z = pk2(r[4], r[5]); q0.w = pk2(r[6], r[7]);
        }
        const bf16x8 qa0 = __builtin_bit_cast(bf16x8, q0), qa1 = __builtin_bit_cast(bf16x8, q1);
        f32x4 S[9];
#pragma unroll
        for (int jt = 0; jt < 9; ++jt) {
            const bf16_t* kp = Ks + ((w + jt) * 16 + fr) * 72 + fq * 8;
            f32x4 a = {0.f, 0.f, 0.f, 0.f};
            a = mfma16(qa0, *(const bf16x8*)kp, a); a = mfma16(qa1, *(const bf16x8*)(kp + 32), a);
            S[jt] = a;
        }
        const float sink = P.attn_sink[l * 8 + h];
        float mx[4], sm[4];
#pragma unroll
        for (int j = 0; j < 4; ++j) {
            const int r = w * 16 + fq * 4 + j;
            float m = -1e30f;
#pragma unroll
            for (int jt = 0; jt < 9; ++jt) { const int kk = (w + jt) * 16 + fr; const bool ok = (kk >= r) && (kk <= r + 128) && (t0 - 128 + kk >= 0);
                const float s = ok ? S[jt][j] * 0.125f : -1e30f; S[jt][j] = s; m = fmaxf(m, s); }
            m = fmaxf(quad16_max(m), sink); mx[j] = m;
            float su = 0.f;
#pragma unroll
            for (int jt = 0; jt < 9; ++jt) { const float p = __expf(S[jt][j] - m); su += p; Ps[(fq * 4 + j) * 168 + jt * 16 + fr] = f2bf(p); }
            su = quad16_sum(su) + __expf(sink - m); sm[j] = 1.f / su;
        }
        __syncthreads();
        f32x4 O[4];
#pragma unroll
        for (int nt = 0; nt < 4; ++nt) O[nt] = (f32x4){0.f, 0.f, 0.f, 0.f};
#pragma unroll
        for (int kx = 0; kx < 5; ++kx) {
            const bf16x8 a = *(const bf16x8*)(Ps + fr * 168 + kx * 32 + fq * 8);
#pragma unroll
            for (int nt = 0; nt < 4; ++nt) O[nt] = mfma16(a, *(const bf16x8*)(Vt + (nt * 16 + fr) * 280 + w * 16 + kx * 32 + fq * 8), O[nt]);
        }
#pragma unroll
        for (int j = 0; j < 4; ++j) {
            const size_t row = R0 + w * 16 + fq * 4 + j;
#pragma unroll
            for (int nt = 0; nt < 4; ++nt) { const int e = nt * 16 + fr;
                const float z = bf2f(C.proj[row * NPROJ + C_ZB + h * 64 + e]);
                C.y[row * WMIX + Y_B + h * 64 + e] = f2bf(O[nt][j] * sm[j] * silu_(z)); }
        }
        __syncthreads();
    }
}

__device__ __forceinline__ void pool_prompt_unit(const Params& P, Ctx& C, int l, int tile, unsigned char* lds) {
    const int tid = C.tid, lane = C.lane, w = C.w, fr = lane & 15, fq = lane >> 4;
    bf16_t* U = (bf16_t*)lds;
    bf16_t* A = (bf16_t*)(lds + 40448);
    bf16_t* Wt = (bf16_t*)(lds + 40448 + 33792);
    const int b = tile >> 7, t0 = (tile & 127) * 64; const size_t R0 = (size_t)b * 8192 + t0;
    for (int i = tid; i < 79 * 32; i += NTHREADS) { const int r = i >> 5, c = i & 31, t = t0 - 15 + r;
        u32x4 a = {0u, 0u, 0u, 0u}; if (t >= 0) a = *(const u32x4*)(C.proj + (size_t)(b * 8192 + t) * NPROJ + C_UC + c * 8);
        *(u32x4*)(U + r * 256 + c * 8) = a; }
    for (int i = tid; i < 4 * 64 * 64; i += NTHREADS) { const int g = i >> 12, cin = (i >> 6) & 63, dout = i & 63;
        Wt[(g * 64 + dout) * 72 + cin] = f2bf(P.w_pool[(size_t)l * 16384 + i]); }
    __syncthreads();
    { const int c = tid & 255, rh = tid >> 8, g = c >> 6, wn = 2 << g;
      for (int r = rh * 32; r < rh * 32 + 32; ++r) {
          float s = 0.f; for (int j = 0; j < wn; ++j) s += bf2f(U[(r + 15 - j) * 256 + c]);
          const int pos = t0 + r; const float cnt = (float)(pos + 1 < wn ? pos + 1 : wn);
          const float u = bf2f(U[(r + 15) * 256 + c]);
          A[r * 264 + c] = f2bf(s / cnt - u);
          if (t0 == 8128 && r >= 49) P.out[O_POOLP + (((size_t)l * 2 + b) * 15 + (r - 49)) * 256 + c] = u;
      } }
    __syncthreads();
    for (int tl = w; tl < 64; tl += 8) { const int rt = tl >> 4, ct = tl & 15, g = ct >> 2;
        f32x4 acc = {0.f, 0.f, 0.f, 0.f};
        acc = mma_tile(A + rt * 16 * 264 + g * 64, 264, Wt + (g * 64 + (ct & 3) * 16) * 72, 72, 64, acc, lane);
        const int c = ct * 16 + fr; const float sc = P.pool_scale[l * 256 + c];
#pragma unroll
        for (int j = 0; j < 4; ++j) { const size_t row = R0 + rt * 16 + fq * 4 + j;
            const float z = bf2f(C.proj[row * NPROJ + C_ZC + c]);
            C.y[row * WMIX + Y_C + c] = f2bf(acc[j] * sc * silu_(z)); }
    }
    __syncthreads();
}

template <bool IS_D, bool KV>
__device__ __forceinline__ void lin_chunk(const Params& P, Ctx& C, int l, int b, int n, unsigned char* lds) {
    const int tid = C.tid, lane = C.lane, w = C.w, fr = lane & 15, fq = lane >> 4;
    constexpr int DK = IS_D ? 64 : 32;
    float* Bc = (float*)lds;
    bf16_t* Qh = (bf16_t*)(lds + 65536);
    bf16_t* Kh = (bf16_t*)(lds + 74752);
    bf16_t* PQ = (bf16_t*)(lds + 83968);
    bf16_t* VS = (bf16_t*)(lds + 101376);
    bf16_t* KdT = (bf16_t*)(lds + 118784);
    const size_t R0 = (size_t)b * 8192 + n * 64;
    if (IS_D) {
        for (int i = tid; i < 64 * 256; i += NTHREADS) { const int t = i >> 8, c = i & 255;
            const float fv = bf2f(C.proj[(R0 + t) * NPROJ + C_FD + c]); const float lb = C.lbt[l * 256 + c];
            Bc[i] = __logf(lb + (1.f - lb) * sigmoid_(fv)); }
        __syncthreads();
        if (tid < 256) { float a = 0.f; for (int t = 0; t < 64; ++t) { a += Bc[t * 256 + tid]; Bc[t * 256 + tid] = a; } }
        __syncthreads();
    }
    for (int h = 0; h < 4; ++h) {
        float lg = 0.f; if (!IS_D) lg = log1pf(-exp2f(-5.f - (float)h));
        for (int i = tid; i < 64 * DK; i += NTHREADS) {
            const int t = i / DK, d = i % DK;
            float q, k, Bt, Bm, Bl;
            if (IS_D) { const int c = h * 64 + d;
                q = silu_(bf2f(C.proj[(R0 + t) * NPROJ + C_QD + c]));
                const float fv = bf2f(C.proj[(R0 + t) * NPROJ + C_FD + c]); const float lb = C.lbt[l * 256 + c];
                k = 1.f - (lb + (1.f - lb) * sigmoid_(fv));
                Bt = Bc[t * 256 + c]; Bm = Bc[31 * 256 + c]; Bl = Bc[63 * 256 + c];
            } else { const int ii = d & 15, pos = n * 64 + t;
                const bf16_t* pr = C.proj + (R0 + t) * NPROJ;
                const float cs = C.ropeAc[pos * 16 + ii], sn = C.ropeAs[pos * 16 + ii];
                const float q1 = bf2f(pr[C_QA + h * 32 + ii]), q2 = bf2f(pr[C_QA + h * 32 + 16 + ii]);
                const float k1 = bf2f(pr[C_KA + h * 32 + ii]), k2 = bf2f(pr[C_KA + h * 32 + 16 + ii]);
                q = d < 16 ? q1 * cs - q2 * sn : q2 * cs + q1 * sn;
                k = (d < 16 ? k1 * cs - k2 * sn : k2 * cs + k1 * sn) * 0.17677669529663687f;
                Bt = (float)(t + 1) * lg; Bm = 32.f * lg; Bl = 64.f * lg;
            }
            if (!KV) { Qh[t * 72 + d] = f2bf(q * __expf(Bt - Bm)); Kh[t * 72 + d] = f2bf(k * __expf(Bm - Bt)); PQ[t * 136 + 64 + d] = f2bf(q * __expf(Bt)); }
            else KdT[d * 72 + t] = f2bf(k * __expf(Bl - Bt));
        }
        for (int i = tid; i < 64 * 64; i += NTHREADS) { const int s = i >> 6, e = i & 63;
            VS[e * 136 + s] = C.proj[(R0 + s) * NPROJ + (IS_D ? C_ID : C_VA) + h * 64 + e]; }
        float* kvbase = (IS_D ? C.kvd : C.kva) + ((size_t)(b * 128 + n) * 4 + h) * (DK * 64);
        if (!KV) for (int i = tid; i < DK * 64; i += NTHREADS) { const int d = i >> 6, e = i & 63; VS[e * 136 + 64 + d] = f2bf(kvbase[i]); }
        __syncthreads();
        if (KV) {
            for (int tl = w; tl < (DK / 16) * 4; tl += 8) { const int dt = tl >> 2, et = tl & 3;
                f32x4 acc = {0.f, 0.f, 0.f, 0.f};
                acc = mma_tile(KdT + dt * 16 * 72, 72, VS + et * 16 * 136, 136, 64, acc, lane);
#pragma unroll
                for (int j = 0; j < 4; ++j) kvbase[(dt * 16 + fq * 4 + j) * 64 + et * 16 + fr] = acc[j]; }
            if (IS_D && tid < 64) C.decd[(size_t)(b * 128 + n) * 256 + h * 64 + tid] = __expf(Bc[63 * 256 + h * 64 + tid]);
        } else {
            for (int tl = w; tl < 16; tl += 8) { const int rt = tl >> 2, ct = tl & 3;
                f32x4 acc = {0.f, 0.f, 0.f, 0.f};
                if (ct <= rt) acc = mma_tile(Qh + rt * 16 * 72, 72, Kh + ct * 16 * 72, 72, DK, acc, lane);
#pragma unroll
                for (int j = 0; j < 4; ++j) { const int t = rt * 16 + fq * 4 + j, s = ct * 16 + fr; PQ[t * 136 + s] = f2bf(s <= t ? acc[j] : 0.f); } }
            __syncthreads();
            if (w < 4) { const int rt = w;
                f32x4 O[4];
#pragma unroll
                for (int et = 0; et < 4; ++et) { O[et] = (f32x4){0.f, 0.f, 0.f, 0.f}; O[et] = mma_tile(PQ + rt * 16 * 136, 136, VS + et * 16 * 136, 136, 64 + DK, O[et], lane); }
#pragma unroll
                for (int j = 0; j < 4; ++j) {
                    float ss = O[0][j] * O[0][j] + O[1][j] * O[1][j] + O[2][j] * O[2][j] + O[3][j] * O[3][j];
                    ss = quad16_sum(ss); const float r = rsqrtf(ss * (1.f / 64.f) + EPS);
                    const size_t row = R0 + rt * 16 + fq * 4 + j;
#pragma unroll
                    for (int et = 0; et < 4; ++et) { const int e = et * 16 + fr;
                        const float z = bf2f(C.proj[row * NPROJ + (IS_D ? C_ZD : C_ZA) + h * 64 + e]);
                        const float gsc = IS_D ? P.g_hgrn[l * 256 + h * 64 + e] : 1.f;
                        C.y[row * WMIX + (IS_D ? Y_D : Y_A) + h * 64 + e] = f2bf(O[et][j] * r * gsc * silu_(z)); }
                }
            }
        }
        __syncthreads();
    }
}

__device__ __forceinline__ void sample_unit(const Params& P, Ctx& C, int l, int sb, unsigned char* lds) {
    const int tid = C.tid, lane = C.lane, w = C.w;
    bf16_t* prb = (bf16_t*)lds;
    float* qa = (float*)(lds + 28672);
    float* ka = qa + 512;
    float* qd = ka + 512;
    float* fd = qd + 1024;
    float* qbq = fd + 1024;
    float* kn = qbq + 2048;
    float* pl = kn + 512;
    float* ps = pl + 1024;
    float* kv = ps + 32 * 136;
    const size_t R0 = (size_t)M_P + sb * 4;
    for (int i = tid; i < 4 * 448; i += NTHREADS) { const int t = i / 448, c = i % 448;
        *(u32x4*)(prb + t * NPROJ + c * 8) = *(const u32x4*)(C.proj + (R0 + t) * NPROJ + c * 8); }
    __syncthreads();
#define PR(t, c) bf2f(prb[(t) * NPROJ + (c)])
    {
        const int t = tid >> 7, c = tid & 127, h = c >> 5, d = c & 31, ii = d & 15, pos = 8192 + t;
        const float cs = C.ropeAc[pos * 16 + ii], sn = C.ropeAs[pos * 16 + ii];
        const float q1 = PR(t, C_QA + h * 32 + ii), q2 = PR(t, C_QA + h * 32 + 16 + ii), k1 = PR(t, C_KA + h * 32 + ii), k2 = PR(t, C_KA + h * 32 + 16 + ii);
        qa[tid] = d < 16 ? q1 * cs - q2 * sn : q2 * cs + q1 * sn;
        ka[tid] = (d < 16 ? k1 * cs - k2 * sn : k2 * cs + k1 * sn) * 0.17677669529663687f;
    }
    for (int i = tid; i < 1024; i += NTHREADS) { const int t = i >> 8, c = i & 255;
        qd[i] = silu_(PR(t, C_QD + c)); const float lb = C.lbt[l * 256 + c]; fd[i] = lb + (1.f - lb) * sigmoid_(PR(t, C_FD + c));
        const int g = c >> 6, wn = 2 << g; float s = 0.f;
        for (int j = 0; j < wn; ++j) { const int e = 15 + t - j; s += e >= 15 ? PR(e - 15, C_UC + c) : P.state_pool[(((size_t)l * 128 + sb) * 15 + e) * 256 + c]; }
        pl[i] = s / (float)wn - PR(t, C_UC + c); }
    for (int i = tid; i < 2048; i += NTHREADS) { const int t = i >> 9, c = i & 511, h = c >> 6, d = c & 63; const int pos = 8192 + t;
        float v;
        if (d < 16) { const int ii = d & 7; const float cs = C.ropeBc[pos * 8 + ii], sn = C.ropeBs[pos * 8 + ii];
            const float x1 = PR(t, C_QB + h * 64 + ii), x2 = PR(t, C_QB + h * 64 + 8 + ii); v = d < 8 ? x1 * cs - x2 * sn : x2 * cs + x1 * sn; }
        else v = PR(t, C_QB + c);
        qbq[i] = v * 0.125f; }
    { const int t = tid >> 7, c = tid & 127, kh = c >> 6, d = c & 63, pos = 8192 + t;
        float v;
        if (d < 16) { const int ii = d & 7; const float cs = C.ropeBc[pos * 8 + ii], sn = C.ropeBs[pos * 8 + ii];
            const float x1 = PR(t, C_KB + kh * 64 + ii), x2 = PR(t, C_KB + kh * 64 + 8 + ii); v = d < 8 ? x1 * cs - x2 * sn : x2 * cs + x1 * sn; }
        else v = PR(t, C_KB + c);
        kn[tid] = v;
        P.out[O_KS + (((size_t)l * 128 + sb) * 128 + 124 + t) * 128 + c] = v;
        P.out[O_VS + (((size_t)l * 128 + sb) * 128 + 124 + t) * 128 + c] = PR(t, C_VB + c); }
    for (int i = tid; i < 15 * 256; i += NTHREADS) { const int r = i >> 8, c = i & 255;
        P.out[O_POOLS + (((size_t)l * 128 + sb) * 15 + r) * 256 + c] = r < 11 ? P.state_pool[(((size_t)l * 128 + sb) * 15 + r + 4) * 256 + c] : PR(r - 11, C_UC + c); }
    { const float* kc = P.cache_k + ((size_t)l * 128 + sb) * 16384; float* ko = P.out + O_KS + ((size_t)l * 128 + sb) * 16384;
      for (int i = tid; i < 4096; i += NTHREADS) { const float4 v = ((const float4*)kc)[i]; const int e = i * 4, wq = e >> 7, r = e & 127, kh = r >> 6, d = r & 63;
          float* dst = kv + (wq * 2 + kh) * 65 + d; dst[0] = v.x; dst[1] = v.y; dst[2] = v.z; dst[3] = v.w;
          if (wq >= 4) ((float4*)ko)[i - 128] = v; } }
    __syncthreads();
    if (w < 4) { const int h = w, e = lane;
        const float gam = 1.f - exp2f(-5.f - (float)h);
        const float* S0 = P.state_ret + (((size_t)l * 128 + sb) * 4 + h) * 2048; float* S1 = P.out + O_RETS + (((size_t)l * 128 + sb) * 4 + h) * 2048;
        const float v0 = PR(0, C_VA + h * 64 + e), v1 = PR(1, C_VA + h * 64 + e), v2 = PR(2, C_VA + h * 64 + e), v3 = PR(3, C_VA + h * 64 + e);
        float o0 = 0.f, o1 = 0.f, o2 = 0.f, o3 = 0.f;
#pragma unroll 8
        for (int d = 0; d < 32; ++d) { float s = S0[d * 64 + e]; const int c = h * 32 + d;
            s = gam * s + ka[c] * v0; o0 += qa[c] * s; s = gam * s + ka[128 + c] * v1; o1 += qa[128 + c] * s;
            s = gam * s + ka[256 + c] * v2; o2 += qa[256 + c] * s; s = gam * s + ka[384 + c] * v3; o3 += qa[384 + c] * s; S1[d * 64 + e] = s; }
        const float r0 = rsqrtf(wave_sum(o0 * o0) * (1.f / 64.f) + EPS), r1 = rsqrtf(wave_sum(o1 * o1) * (1.f / 64.f) + EPS);
        const float r2 = rsqrtf(wave_sum(o2 * o2) * (1.f / 64.f) + EPS), r3 = rsqrtf(wave_sum(o3 * o3) * (1.f / 64.f) + EPS);
        const int c = h * 64 + e;
        C.y[(R0 + 0) * WMIX + Y_A + c] = f2bf(o0 * r0 * silu_(PR(0, C_ZA + c))); C.y[(R0 + 1) * WMIX + Y_A + c] = f2bf(o1 * r1 * silu_(PR(1, C_ZA + c)));
        C.y[(R0 + 2) * WMIX + Y_A + c] = f2bf(o2 * r2 * silu_(PR(2, C_ZA + c))); C.y[(R0 + 3) * WMIX + Y_A + c] = f2bf(o3 * r3 * silu_(PR(3, C_ZA + c)));
    } else { const int h = w - 4, e = lane;
        const float* S0 = P.state_hgrn + (((size_t)l * 128 + sb) * 4 + h) * 4096; float* S1 = P.out + O_HGRNS + (((size_t)l * 128 + sb) * 4 + h) * 4096;
        const float v0 = PR(0, C_ID + h * 64 + e), v1 = PR(1, C_ID + h * 64 + e), v2 = PR(2, C_ID + h * 64 + e), v3 = PR(3, C_ID + h * 64 + e);
        float o0 = 0.f, o1 = 0.f, o2 = 0.f, o3 = 0.f;
#pragma unroll 8
        for (int d = 0; d < 64; ++d) { float s = S0[d * 64 + e]; const int c = h * 64 + d;
            float f = fd[c]; s = f * s + (1.f - f) * v0; o0 += qd[c] * s; f = fd[256 + c]; s = f * s + (1.f - f) * v1; o1 += qd[256 + c] * s;
            f = fd[512 + c]; s = f * s + (1.f - f) * v2; o2 += qd[512 + c] * s; f = fd[768 + c]; s = f * s + (1.f - f) * v3; o3 += qd[768 + c] * s; S1[d * 64 + e] = s; }
        const float r0 = rsqrtf(wave_sum(o0 * o0) * (1.f / 64.f) + EPS), r1 = rsqrtf(wave_sum(o1 * o1) * (1.f / 64.f) + EPS);
        const float r2 = rsqrtf(wave_sum(o2 * o2) * (1.f / 64.f) + EPS), r3 = rsqrtf(wave_sum(o3 * o3) * (1.f / 64.f) + EPS);
        const int c = h * 64 + e; const float gs = P.g_hgrn[l * 256 + c];
        C.y[(R0 + 0) * WMIX + Y_D + c] = f2bf(o0 * r0 * gs * silu_(PR(0, C_ZD + c))); C.y[(R0 + 1) * WMIX + Y_D + c] = f2bf(o1 * r1 * gs * silu_(PR(1, C_ZD + c)));
        C.y[(R0 + 2) * WMIX + Y_D + c] = f2bf(o2 * r2 * gs * silu_(PR(2, C_ZD + c))); C.y[(R0 + 3) * WMIX + Y_D + c] = f2bf(o3 * r3 * gs * silu_(PR(3, C_ZD + c)));
    }
    { const int c = tid & 255, tp = tid >> 8, g = c >> 6, dout = c & 63;
      float a0 = 0.f, a1 = 0.f; const float* wp = P.w_pool + ((size_t)l * 4 + g) * 4096 + dout;
#pragma unroll 8
      for (int cin = 0; cin < 64; ++cin) { const float wv = wp[cin * 64]; a0 += pl[(2 * tp) * 256 + g * 64 + cin] * wv; a1 += pl[(2 * tp + 1) * 256 + g * 64 + cin] * wv; }
      const float sc = P.pool_scale[l * 256 + c];
      C.y[(R0 + 2 * tp) * WMIX + Y_C + c] = f2bf(a0 * sc * silu_(PR(2 * tp, C_ZC + c)));
      C.y[(R0 + 2 * tp + 1) * WMIX + Y_C + c] = f2bf(a1 * sc * silu_(PR(2 * tp + 1, C_ZC + c))); }
    for (int i = tid; i < 4224; i += NTHREADS) { const int kh = i / 2112, rem = i - kh * 2112, r16 = rem / 132, kk = rem - r16 * 132, g = r16 >> 2, t = r16 & 3, h = kh * 4 + g;
        const bool ok = kk < 128 ? (kk >= t) : (kk - 128 <= t);
        const float* kp = kk < 128 ? kv + (kk * 2 + kh) * 65 : kn + (kk - 128) * 128 + kh * 64;
        const float* qp = qbq + t * 512 + h * 64;
        float s = 0.f;
#pragma unroll 16
        for (int d = 0; d < 64; ++d) s += qp[d] * kp[d];
        ps[(h * 4 + t) * 136 + kk] = ok ? s : -1e30f; }
    __syncthreads();
    { const int h = w; const float sink = P.attn_sink[l * 8 + h];
      for (int t = 0; t < 4; ++t) { float* pr_ = ps + (h * 4 + t) * 136;
          const float s0 = pr_[lane], s1 = pr_[lane + 64], s2 = lane < 4 ? pr_[lane + 128] : -1e30f;
          float m = fmaxf(fmaxf(s0, s1), s2); m = fmaxf(m, __shfl_xor(m, 32)); m = fmaxf(m, __shfl_xor(m, 16)); m = fmaxf(m, __shfl_xor(m, 8)); m = fmaxf(m, __shfl_xor(m, 4)); m = fmaxf(m, __shfl_xor(m, 2)); m = fmaxf(m, __shfl_xor(m, 1));
          m = fmaxf(m, sink);
          const float p0 = __expf(s0 - m), p1 = __expf(s1 - m), p2 = lane < 4 ? __expf(s2 - m) : 0.f;
          const float inv = 1.f / (wave_sum(p0 + p1 + p2) + __expf(sink - m));
          pr_[lane] = p0 * inv; pr_[lane + 64] = p1 * inv; if (lane < 4) pr_[lane + 128] = p2 * inv; } }
    __syncthreads();
    { const float* vc = P.cache_v + ((size_t)l * 128 + sb) * 16384; float* vo = P.out + O_VS + ((size_t)l * 128 + sb) * 16384;
      for (int i = tid; i < 4096; i += NTHREADS) { const float4 v = ((const float4*)vc)[i]; const int e = i * 4, wq = e >> 7, r = e & 127, kh = r >> 6, d = r & 63;
          float* dst = kv + (wq * 2 + kh) * 65 + d; dst[0] = v.x; dst[1] = v.y; dst[2] = v.z; dst[3] = v.w;
          if (wq >= 4) ((float4*)vo)[i - 128] = v; } }
    __syncthreads();
    { const int h = w, kh = h >> 2, e = lane;
      float o0 = 0.f, o1 = 0.f, o2 = 0.f, o3 = 0.f; const float* p0 = ps + (h * 4) * 136;
      for (int kk = 0; kk < 128; ++kk) { const float v = kv[(kk * 2 + kh) * 65 + e]; o0 += p0[kk] * v; o1 += p0[136 + kk] * v; o2 += p0[272 + kk] * v; o3 += p0[408 + kk] * v; }
      for (int kk = 128; kk < 132; ++kk) { const float v = PR(kk - 128, C_VB + kh * 64 + e); o0 += p0[kk] * v; o1 += p0[136 + kk] * v; o2 += p0[272 + kk] * v; o3 += p0[408 + kk] * v; }
      const int c = h * 64 + e;
      C.y[(R0 + 0) * WMIX + Y_B + c] = f2bf(o0 * silu_(PR(0, C_ZB + c))); C.y[(R0 + 1) * WMIX + Y_B + c] = f2bf(o1 * silu_(PR(1, C_ZB + c)));
      C.y[(R0 + 2) * WMIX + Y_B + c] = f2bf(o2 * silu_(PR(2, C_ZB + c))); C.y[(R0 + 3) * WMIX + Y_B + c] = f2bf(o3 * silu_(PR(3, C_ZB + c))); }
#undef PR
    __syncthreads();
}


__device__ __forceinline__ void sample_branch_tile(Ctx& C, int l, int tile) {
    const int lane = C.lane, w = C.w, fr = lane & 15, fq = lane >> 4;
    const int r0 = M_P + (tile >> 4) * 32 + (w >> 2) * 16, c0 = (tile & 15) * 64 + (w & 3) * 16;
    const bf16_t* A = C.y + (size_t)(r0 + fr) * WMIX + fq * 8;
    const bf16_t* B = C.wb + (size_t)l * DM * WMIX + (size_t)(c0 + fr) * WMIX + fq * 8;
    f32x4 acc = {0.f, 0.f, 0.f, 0.f};
#pragma unroll
    for (int br = 0; br < 4; ++br) {
        const int k0 = br == 0 ? 0 : (br == 1 ? 256 : (br == 2 ? 768 : 1024)), k1 = br == 0 ? 256 : (br == 1 ? 768 : (br == 2 ? 1024 : 1280));
#pragma unroll 8
        for (int k = k0; k < k1; k += 32) acc = mfma16(*(const bf16x8*)(A + k), *(const bf16x8*)(B + k), acc);
#pragma unroll
        for (int j = 0; j < 4; ++j) { const bf16_t* gp = C.gates + (size_t)(r0 + fq * 4 + j) * NGATE + br * 1024 + c0 + fr;
            float sc = bf2f(gp[0]); if (br < 3) sc *= __builtin_amdgcn_rcpf(bf2f(gp[1024])); acc[j] *= sc; }
    }
#pragma unroll
    for (int j = 0; j < 4; ++j) C.mb[(size_t)(r0 + fq * 4 + j) * DM + c0 + fr] = f2bf(acc[j]);
}
__device__ __forceinline__ void sample_out_tile(Ctx& C, int l, int tile) {
    const int lane = C.lane, w = C.w, fr = lane & 15, fq = lane >> 4;
    const int r0 = M_P + (tile >> 4) * 32 + (w >> 2) * 16, c0 = (tile & 15) * 64 + (w & 3) * 16;
    const bf16_t* A = C.mb + (size_t)(r0 + fr) * DM + fq * 8;
    const bf16_t* B = C.wout + (size_t)l * DM * DM + (size_t)(c0 + fr) * DM + fq * 8;
    f32x4 acc = {0.f, 0.f, 0.f, 0.f};
#pragma unroll 8
    for (int k = 0; k < DM; k += 32) acc = mfma16(*(const bf16x8*)(A + k), *(const bf16x8*)(B + k), acc);
#pragma unroll
    for (int j = 0; j < 4; ++j) C.of[(size_t)(r0 + fq * 4 + j) * DM + c0 + fr] = acc[j];
}

__device__ __forceinline__ void phase_scan(const Params& P, Ctx& C, int l) {
    for (int g = C.bx * NTHREADS + C.tid; g < 49152; g += C.G * NTHREADS) {
        if (g < 16384) { const int b = g >> 13, r = g & 8191, h = r >> 11, de = r & 2047;
            float* base = C.kva + ((size_t)(b * 128) * 4 + h) * 2048 + de;
            const float dec = __expf(64.f * log1pf(-exp2f(-5.f - (float)h)));
            float S = 0.f;
            for (int n0 = 0; n0 < 128; n0 += 16) { float v[16];
#pragma unroll
                for (int i = 0; i < 16; ++i) v[i] = base[(size_t)(n0 + i) * 8192];
#pragma unroll
                for (int i = 0; i < 16; ++i) { base[(size_t)(n0 + i) * 8192] = S; S = dec * S + v[i]; } }
            P.out[O_RETP + (((size_t)l * 2 + b) * 4 + h) * 2048 + de] = S;
        } else { const int gg = g - 16384, b = gg >> 14, r = gg & 16383, h = r >> 12, de = r & 4095, d = de >> 6;
            float* base = C.kvd + ((size_t)(b * 128) * 4 + h) * 4096 + de;
            const float* dp = C.decd + (size_t)(b * 128) * 256 + h * 64 + d;
            float S = 0.f;
            for (int n0 = 0; n0 < 128; n0 += 16) { float v[16], dc[16];
#pragma unroll
                for (int i = 0; i < 16; ++i) { v[i] = base[(size_t)(n0 + i) * 16384]; dc[i] = dp[(n0 + i) * 256]; }
#pragma unroll
                for (int i = 0; i < 16; ++i) { base[(size_t)(n0 + i) * 16384] = S; S = dc[i] * S + v[i]; } }
            P.out[O_HGRNP + (((size_t)l * 2 + b) * 4 + h) * 4096 + de] = S;
        }
    }
}

__device__ __forceinline__ void phase_finalize(const Params& P, Ctx& C, int l) {
    const int lane = C.lane;
    for (int row = C.bx * 8 + C.w; row < M_TOT; row += C.G * 8) {
        const float4* o4 = (const float4*)(C.of + (size_t)row * DM); float4* x4 = (float4*)(P.out + (size_t)row * DM);
        float4 o[4], x[4]; float ss = 0.f;
#pragma unroll
        for (int i = 0; i < 4; ++i) { o[i] = o4[lane + 64 * i]; x[i] = x4[lane + 64 * i]; ss += o[i].x * o[i].x + o[i].y * o[i].y + o[i].z * o[i].z + o[i].w * o[i].w; }
        ss = wave_sum(ss); const float r = rsqrtf(ss * (1.f / DM) + EPS);
        float s2 = 0.f;
#pragma unroll
        for (int i = 0; i < 4; ++i) { const float4 g = ((const float4*)(P.g_post + l * DM))[lane + 64 * i];
            x[i].x += o[i].x * r * g.x; x[i].y += o[i].y * r * g.y; x[i].z += o[i].z * r * g.z; x[i].w += o[i].w * r * g.w;
            x4[lane + 64 * i] = x[i]; s2 += x[i].x * x[i].x + x[i].y * x[i].y + x[i].z * x[i].z + x[i].w * x[i].w; }
        if (l < 3) { s2 = wave_sum(s2); const float r2 = rsqrtf(s2 * (1.f / DM) + EPS);
#pragma unroll
            for (int i = 0; i < 4; ++i) { const float4 g = ((const float4*)(P.g_pre + (l + 1) * DM))[lane + 64 * i];
                uint2 ov; ov.x = pk2(x[i].x * r2 * g.x, x[i].y * r2 * g.y); ov.y = pk2(x[i].z * r2 * g.z, x[i].w * r2 * g.w);
                ((uint2*)(C.h + (size_t)row * DM))[lane + 64 * i] = ov; } }
    }
}

#ifndef PH_MASK
#define PH_MASK 2047
#endif
__global__ void __launch_bounds__(NTHREADS, 2) fwd_kernel(Params P) {
    extern __shared__ __attribute__((aligned(16))) unsigned char lds[];
    LAS unsigned char* ldsl = (LAS unsigned char*)lds;
    volatile LAS unsigned* bst = (volatile LAS unsigned*)(ldsl + LDS_BYTES - 16);
    if (threadIdx.x == 0) { bst[0] = 0u; bst[1] = 0u; if (P.coop) (void)xb_add((unsigned*)P.ws + XB_XCNT(xb_xcc_id()), 1u); }
    __syncthreads();

    for (int ph = P.ph_lo; ph < P.ph_hi; ++ph) {
        int nrep = 1;
#ifdef DUP_SP
        if (ph > 0 && ((ph - 1) % 7) == DUP_SP) nrep = 2;
#endif
        for (int rep = 0; rep < nrep; ++rep) {
        if (rep) xcd_barrier((unsigned*)P.ws, bst);
        int tid_ = threadIdx.x, bx = blockIdx.x, G_ = gridDim.x; __attribute__((address_space(1))) unsigned char* wsg = (__attribute__((address_space(1))) unsigned char*)P.ws;
        asm volatile("" : "+v"(tid_)); asm volatile("" : "+s"(bx)); asm volatile("" : "+s"(G_)); asm volatile("" : "+s"(wsg));
        unsigned char* ws = (unsigned char*)wsg;
        Ctx C;
        C.win = (bf16_t*)(ws + WS_WIN); C.wb = (bf16_t*)(ws + WS_WB); C.wout = (bf16_t*)(ws + WS_WOUT); C.h = (bf16_t*)(ws + WS_H); C.mb = (bf16_t*)(ws + WS_H);
        C.proj = (bf16_t*)(ws + WS_PROJ); C.mf = (float*)(ws + WS_PROJ); C.gates = (bf16_t*)(ws + WS_GATES); C.of = (float*)(ws + WS_GATES); C.y = (bf16_t*)(ws + WS_Y);
        C.kva = (float*)(ws + WS_KVA); C.kvd = (float*)(ws + WS_KVD); C.decd = (float*)(ws + WS_DECD);
        C.ropeAc = (float*)(ws + WS_ROPEA); C.ropeAs = C.ropeAc + NPOS * 16; C.ropeBc = (float*)(ws + WS_ROPEB); C.ropeBs = C.ropeBc + NPOS * 8; C.lbt = (float*)(ws + WS_LB);
        C.bx = bx; C.tid = tid_; C.lane = tid_ & 63; C.w = __builtin_amdgcn_readfirstlane(tid_ >> 6); C.G = G_;
        const int vcu = (C.G % 8 == 0) ? (bx % 8) * (C.G / 8) + bx / 8 : bx;
        if (ph == 0) { if (PH_MASK & 1) phase_prologue(P, C, lds); }
        else {
            const int l = (ph - 1) / 7, sp = (ph - 1) % 7;
            if (sp == 0) {
              if (PH_MASK & 2) {
                pg8::Gemm g{C.h, C.win + (size_t)l * DIN * DM, DM, DM}; pg8::StaticOrder S; S.init(M_TOT, DIN, DM, C.G, bx);
                pg8::EpiProj E{C.proj, C.gates};
                pg8::gemm_phase<pg8::EpiProj, pg8::StaticOrder>(ldsl, g, S, E, C.tid); }
            } else if (sp == 1) {
                for (int u = bx; u < 1280; u += C.G) {
                    if (u < 256) { if (PH_MASK & 4) attn_prompt_unit(P, C, l, u >> 7, (u & 127) >> 1, u & 1, lds); }
                    else if (u < 512) { if (PH_MASK & 32) lin_chunk<false, true>(P, C, l, (u - 256) >> 7, (u - 256) & 127, lds); }
                    else if (u < 768) { if (PH_MASK & 32) lin_chunk<true, true>(P, C, l, (u - 512) >> 7, (u - 512) & 127, lds); }
                    else { const int v = (u - 768) & 255, second = (u - 768) >> 8;
                        if (v < 128) { if (!second) { if (PH_MASK & 8) sample_unit(P, C, l, v, lds); } }
                        else { if (PH_MASK & 16) pool_prompt_unit(P, C, l, 2 * (v - 128) + second, lds); } }
                }
            } else if (sp == 2) { if (PH_MASK & 64) phase_scan(P, C, l); }
            else if (sp == 3) {
                for (int u = bx; u < 512; u += C.G) {
                    if (u < 256) { if (PH_MASK & 128) lin_chunk<false, false>(P, C, l, u >> 7, u & 127, lds); }
                    else { if (PH_MASK & 128) lin_chunk<true, false>(P, C, l, (u - 256) >> 7, (u - 256) & 127, lds); }
                }
            } else if (sp == 4) {
              if (PH_MASK & 256) {
                for (int t = bx; t < 256; t += C.G) sample_branch_tile(C, l, t);
                pg8::Gemm g{C.y, C.wb + (size_t)l * DM * WMIX, WMIX, WMIX}; pg8::BranchOrder S{256, C.G, vcu};
                pg8::EpiBranch E{C.gates, C.mb};
                pg8::gemm_phase<pg8::EpiBranch, pg8::BranchOrder>(ldsl, g, S, E, C.tid); }
            } else if (sp == 5) {
              if (PH_MASK & 512) {
                for (int t = bx; t < 256; t += C.G) sample_out_tile(C, l, t);
                pg8::Gemm g{C.mb, C.wout + (size_t)l * DM * DM, DM, DM}; pg8::TileOrder S{256, C.G, vcu, DM / 64};
                pg8::EpiF32 E{C.of};
                pg8::gemm_phase<pg8::EpiF32, pg8::TileOrder>(ldsl, g, S, E, C.tid); }
            } else { if (PH_MASK & 1024) phase_finalize(P, C, l); }
        }
        }
        if (ph + 1 < P.ph_hi && P.coop) { if (ph == 0) cg::this_grid().sync(); else xcd_barrier((unsigned*)P.ws, bst); }
    }
}

#ifndef N_LAUNCH_MODE
#define N_LAUNCH_MODE 1
#endif
extern "C" void kernel_launch(void* const* d_in, const int* in_sizes, int n_in, void* d_out, int out_size, void* d_ws, size_t ws_size, hipStream_t stream) {
    static int grid = 0;
    if (grid == 0) {
        if (n_in != 17 || (size_t)out_size != O_END || ws_size < WS_END) { fprintf(stderr, "kernel_launch: unexpected sizes n_in %d out %d ws %zu\n", n_in, out_size, ws_size); grid = -1; return; }
        int dev = 0, cus = 0, per_cu = 0;
        hipGetDevice(&dev); hipDeviceGetAttribute(&cus, hipDeviceAttributeMultiprocessorCount, dev);
        if (hipFuncSetAttribute((const void*)fwd_kernel, hipFuncAttributeMaxDynamicSharedMemorySize, LDS_BYTES) != hipSuccess) { fprintf(stderr, "hipFuncSetAttribute failed\n"); grid = -1; return; }
        if (hipOccupancyMaxActiveBlocksPerMultiprocessor(&per_cu, (const void*)fwd_kernel, NTHREADS, LDS_BYTES) != hipSuccess || per_cu < 1) { fprintf(stderr, "occupancy query: %d\n", per_cu); per_cu = 1; }
        (void)hipGetLastError();
        grid = cus * 1;
        if (per_cu < 1) grid = -1;
    }
    if (grid < 0) return;
    Params p{};
    const float* const* in = (const float* const*)d_in;
    p.x_prompt = in[0]; p.x_sample = in[1]; p.state_ret = in[2]; p.cache_k = in[3]; p.cache_v = in[4]; p.state_pool = in[5]; p.state_hgrn = in[6];
    p.w_in = in[7]; p.w_branch = in[8]; p.w_out = in[9]; p.g_pre = in[10]; p.g_post = in[11]; p.attn_sink = in[12]; p.w_pool = in[13];
    p.pool_scale = in[14]; p.g_hgrn = in[15]; p.lower_bounds = in[16];
    p.out = (float*)d_out; p.ws = (unsigned char*)d_ws;
    for (int i = 0; i < 16; ++i) p.invA[i] = pow(10000.0, -(double)i / 16.0);
    for (int i = 0; i < 8; ++i) p.invB[i] = pow(500000.0, -(double)i / 8.0);
    const int NPH = 29;
#if N_LAUNCH_MODE == 1
    (void)hipMemsetAsync(d_ws, 0, 16384, stream);
    p.ph_lo = 0; p.ph_hi = NPH; p.coop = 1; p.pad = 0;
    void* args[] = {&p};
    hipError_t e = hipLaunchCooperativeKernel((const void*)fwd_kernel, dim3(grid), dim3(NTHREADS), args, LDS_BYTES, stream);
    if (e != hipSuccess) fprintf(stderr, "cooperative launch failed: %s (grid %d)\n", hipGetErrorString(e), grid);
#else
    for (int ph = 0; ph < NPH; ++ph) {
        p.ph_lo = ph; p.ph_hi = ph + 1; p.coop = 0; p.pad = 0;
        hipLaunchKernelGGL(fwd_kernel, dim3(grid), dim3(NTHREADS), LDS_BYTES, stream, p);
    }
#endif
}
```

```cpp
#include <hip/hip_runtime.h>
#include <hip/hip_cooperative_groups.h>
#include <cstdio>
#include <cstdint>
#include <cmath>
namespace cg = cooperative_groups;

#define LAS __attribute__((address_space(3)))
typedef unsigned short bf16_t;
typedef short bf16x8 __attribute__((ext_vector_type(8)));
typedef float f32x4 __attribute__((ext_vector_type(4)));
typedef unsigned u32x4 __attribute__((ext_vector_type(4)));

constexpr int M_TOT = 16896, M_P = 16384, DM = 1024, DIN = 7680, NPROJ = 3584, NGATE = 4096, WMIX = 1280;
constexpr int C_QA = 0, C_KA = 128, C_VA = 256, C_ZA = 512, C_QB = 768, C_KB = 1280, C_VB = 1408, C_ZB = 1536, C_UC = 2048, C_ZC = 2304,
              C_QD = 2560, C_FD = 2816, C_ID = 3072, C_ZD = 3328;
constexpr int Y_A = 0, Y_B = 256, Y_C = 768, Y_D = 1024;
constexpr size_t O_YP = 0, O_YS = 16777216, O_RETP = 17301504, O_KP = 17367040, O_VP = 17498112, O_POOLP = 17629184, O_HGRNP = 17659904,
                 O_RETS = 17790976, O_KS = 21985280, O_VS = 30373888, O_POOLS = 38762496, O_HGRNS = 40728576, O_END = 49117184;
constexpr float EPS = 1e-6f;
constexpr int NPOS = 8196;

constexpr size_t MiB = 1u << 20;
constexpr size_t WS_ROPEA = 1 * MiB;
constexpr size_t WS_ROPEB = 3 * MiB;
constexpr size_t WS_LB = 3 * MiB + 768 * 1024;
constexpr size_t WS_WIN = 4 * MiB;
constexpr size_t WS_WB = 64 * MiB;
constexpr size_t WS_WOUT = 74 * MiB;
constexpr size_t WS_H = 82 * MiB;
constexpr size_t WS_PROJ = 115 * MiB;
constexpr size_t WS_GATES = 231 * MiB;
constexpr size_t WS_Y = 363 * MiB;
constexpr size_t WS_KVA = 405 * MiB;
constexpr size_t WS_KVD = 413 * MiB;
constexpr size_t WS_DECD = 429 * MiB;
constexpr size_t WS_END = 430 * MiB;

constexpr int LDS_BYTES = 147456;
constexpr int NTHREADS = 512;

struct Params {
    const float* x_prompt; const float* x_sample; const float* state_ret; const float* cache_k; const float* cache_v; const float* state_pool; const float* state_hgrn;
    const float* w_in; const float* w_branch; const float* w_out; const float* g_pre; const float* g_post; const float* attn_sink; const float* w_pool;
    const float* pool_scale; const float* g_hgrn; const float* lower_bounds;
    float* out; unsigned char* ws;
    double invA[16]; double invB[8];
    int ph_lo, ph_hi, coop, pad;
};

__device__ __forceinline__ float bf2f(bf16_t v) { return __uint_as_float(((unsigned)v) << 16); }
__device__ __forceinline__ bf16_t f2bf(float f) { unsigned u = __float_as_uint(f); return (bf16_t)((u + 0x7fffu + ((u >> 16) & 1u)) >> 16); }
__device__ __forceinline__ unsigned pk2(float lo, float hi) { return (unsigned)f2bf(lo) | ((unsigned)f2bf(hi) << 16); }
__device__ __forceinline__ float lo16(unsigned u) { return __uint_as_float(u << 16); }
__device__ __forceinline__ float hi16(unsigned u) { return __uint_as_float(u & 0xffff0000u); }
__device__ __forceinline__ float sigmoid_(float x) { return 1.f / (1.f + __expf(-x)); }
__device__ __forceinline__ float silu_(float x) { return x / (1.f + __expf(-x)); }
__device__ __forceinline__ float wave_sum(float v) {
    v += __shfl_xor(v, 32); v += __shfl_xor(v, 16); v += __shfl_xor(v, 8); v += __shfl_xor(v, 4); v += __shfl_xor(v, 2); v += __shfl_xor(v, 1); return v;
}
__device__ __forceinline__ float quad16_sum(float v) { v += __shfl_xor(v, 8); v += __shfl_xor(v, 4); v += __shfl_xor(v, 2); v += __shfl_xor(v, 1); return v; }
__device__ __forceinline__ float quad16_max(float v) { v = fmaxf(v, __shfl_xor(v, 8)); v = fmaxf(v, __shfl_xor(v, 4)); v = fmaxf(v, __shfl_xor(v, 2)); v = fmaxf(v, __shfl_xor(v, 1)); return v; }
__device__ __forceinline__ f32x4 mfma16(bf16x8 a, bf16x8 b, f32x4 c) { return __builtin_amdgcn_mfma_f32_16x16x32_bf16(a, b, c, 0, 0, 0); }
__device__ __forceinline__ f32x4 mma_tile(const bf16_t* As, int lda, const bf16_t* Bs, int ldb, int K, f32x4 acc, int lane) {
    const bf16_t* ap = As + (lane & 15) * lda + (lane >> 4) * 8;
    const bf16_t* bp = Bs + (lane & 15) * ldb + (lane >> 4) * 8;
    for (int k = 0; k < K; k += 32) acc = mfma16(*(const bf16x8*)(ap + k), *(const bf16x8*)(bp + k), acc);
    return acc;
}

namespace pg8 {
constexpr int BM = 256, BK = 64, HALF = 128, HTB = HALF * BK * 2, STAGE_BYTES = 8 * HTB, NXCD = 8, WGM = 8;
__host__ __device__ __forceinline__ int lds_byte(int r, int c) { const int st = (r >> 4) * 2 + (c >> 5), rr = r & 15, cc = c & 31, ob = rr * 64 + cc * 2; return st * 1024 + (ob ^ (((ob >> 9) & 1) << 5)); }
__host__ __device__ __forceinline__ void stage_rc(int b, int& R, int& C) { const int st = b / 1024, sb = b % 1024, swz = sb ^ (((sb >> 9) & 1) << 5); R = (st >> 1) * 16 + swz / 64; C = (st & 1) * 32 + (swz % 64) / 2; }
__host__ __device__ __forceinline__ int perm32(int rho) { const int n = rho >> 4, i = rho & 15; return 8 * (i >> 2) + 4 * n + (i & 3); }

struct Unit { int pm, pn, k0, nt, br; };
struct Gemm { const bf16_t* A; const bf16_t* Bt; int lda, ldb; };

struct StaticOrder {
    int nM, nN, nwg, G, c, nt;
    __device__ void init(int M, int N, int K, int G_, int c_) { nM = M / BM; nN = N / BM; nwg = nM * nN; G = G_; c = c_; nt = K / BK; }
    __device__ bool next(int i, Unit& u) const {
        const long L = (long)i * G + c; if (L >= nwg) return false;
        int wgid = (int)L; { const int q = nwg / NXCD, r = nwg % NXCD, xcd = wgid % NXCD, off = wgid / NXCD; wgid = (xcd < r ? xcd * (q + 1) : r * (q + 1) + (xcd - r) * q) + off; }
        const int nig = WGM * nN, gid = wgid / nig, fm = gid * WGM, gsz = (nM - fm) < WGM ? (nM - fm) : WGM;
        u.pm = fm + ((wgid % nig) % gsz); u.pn = (wgid % nig) / gsz; u.k0 = 0; u.nt = nt; u.br = 0; return true;
    }
};
struct TileOrder {
    int ntiles, G, c, nt;
    __device__ bool next(int i, Unit& u) const { const int t = i * G + c; if (t >= ntiles) return false; u.pm = t >> 2; u.pn = t & 3; u.k0 = 0; u.nt = nt; u.br = 0; return true; }
};
struct BranchOrder {
    int ntiles, G, c;
    __device__ bool next(int i, Unit& u) const {
        const int t = (i >> 2) * G + c; if (t >= ntiles) return false; const int br = i & 3;
        u.pm = t >> 2; u.pn = t & 3; u.br = br; u.k0 = br == 0 ? 0 : (br == 1 ? 256 : (br == 2 ? 768 : 1024)); u.nt = br == 1 ? 8 : 4; return true;
    }
};

struct EpiProj {
    static __device__ __forceinline__ bool reset(const Unit&) { return true; }
    bf16_t* proj; bf16_t* gates;
    __device__ __forceinline__ void operator()(f32x4 (&acc)[2][2][4][2], const Unit& u, int wr, int wc, int fr, int fq) const {
        const int row0 = u.pm * BM + wr * 64 + fr;
        const bool isg = u.pn >= 14;
        bf16_t* base = isg ? gates : proj; const int ld = isg ? NGATE : NPROJ;
        const int col0 = (isg ? (u.pn - 14) : u.pn) * BM + wc * 32 + 8 * fq;
#pragma unroll
        for (int ai = 0; ai < 2; ++ai)
#pragma unroll
            for (int m = 0; m < 4; ++m) { bf16_t* rowp = base + (size_t)(row0 + ai * HALF + m * 16) * ld + col0;
#pragma unroll
                for (int bj = 0; bj < 2; ++bj) { f32x4 v0 = acc[ai][bj][m][0], v1 = acc[ai][bj][m][1];
                    if (isg) {
#pragma unroll
                        for (int i = 0; i < 4; ++i) { v0[i] = fmaxf(sigmoid_(v0[i]), 1e-6f); v1[i] = fmaxf(sigmoid_(v1[i]), 1e-6f); } }
                    u32x4 w; w.x = pk2(v0[0], v0[1]); w.y = pk2(v0[2], v0[3]); w.z = pk2(v1[0], v1[1]); w.w = pk2(v1[2], v1[3]);
                    *(u32x4*)(rowp + bj * HALF) = w; } }
    }
};
struct EpiBranch {
    static __device__ __forceinline__ bool reset(const Unit& u) { return u.br == 3; }
    const bf16_t* gates; bf16_t* mb;
    __device__ __forceinline__ void operator()(f32x4 (&acc)[2][2][4][2], const Unit& u, int wr, int wc, int fr, int fq) const {
        const int row0 = u.pm * BM + wr * 64 + fr, col0 = u.pn * BM + wc * 32 + 8 * fq;
#pragma unroll
        for (int ai = 0; ai < 2; ++ai)
#pragma unroll
            for (int m = 0; m < 4; ++m) { const size_t row = (size_t)(row0 + ai * HALF + m * 16);
#pragma unroll
                for (int bj = 0; bj < 2; ++bj) { const int col = col0 + bj * HALF;
                    const u32x4 g = *(const u32x4*)(gates + row * NGATE + u.br * 1024 + col);
                    float s[8] = {lo16(g.x), hi16(g.x), lo16(g.y), hi16(g.y), lo16(g.z), hi16(g.z), lo16(g.w), hi16(g.w)};
                    if (u.br < 3) { const u32x4 gn = *(const u32x4*)(gates + row * NGATE + (u.br + 1) * 1024 + col);
                        s[0] *= __builtin_amdgcn_rcpf(lo16(gn.x)); s[1] *= __builtin_amdgcn_rcpf(hi16(gn.x)); s[2] *= __builtin_amdgcn_rcpf(lo16(gn.y)); s[3] *= __builtin_amdgcn_rcpf(hi16(gn.y));
                        s[4] *= __builtin_amdgcn_rcpf(lo16(gn.z)); s[5] *= __builtin_amdgcn_rcpf(hi16(gn.z)); s[6] *= __builtin_amdgcn_rcpf(lo16(gn.w)); s[7] *= __builtin_amdgcn_rcpf(hi16(gn.w)); }
                    f32x4 v0 = acc[ai][bj][m][0], v1 = acc[ai][bj][m][1];
                    v0[0] *= s[0]; v0[1] *= s[1]; v0[2] *= s[2]; v0[3] *= s[3]; v1[0] *= s[4]; v1[1] *= s[5]; v1[2] *= s[6]; v1[3] *= s[7];
                    if (u.br < 3) { acc[ai][bj][m][0] = v0; acc[ai][bj][m][1] = v1; }
                    else { u32x4 w; w.x = pk2(v0[0], v0[1]); w.y = pk2(v0[2], v0[3]); w.z = pk2(v1[0], v1[1]); w.w = pk2(v1[2], v1[3]); *(u32x4*)(mb + row * DM + col) = w; } } }
    }
};
struct EpiF32 {
    static __device__ __forceinline__ bool reset(const Unit&) { return true; }
    float* o;
    __device__ __forceinline__ void operator()(f32x4 (&acc)[2][2][4][2], const Unit& u, int wr, int wc, int fr, int fq) const {
        const int row0 = u.pm * BM + wr * 64 + fr, col0 = u.pn * BM + wc * 32 + 8 * fq;
#pragma unroll
        for (int ai = 0; ai < 2; ++ai)
#pragma unroll
            for (int m = 0; m < 4; ++m) { float* rowp = o + (size_t)(row0 + ai * HALF + m * 16) * DM + col0;
#pragma unroll
                for (int bj = 0; bj < 2; ++bj) { *(f32x4*)(rowp + bj * HALF) = acc[ai][bj][m][0]; *(f32x4*)(rowp + bj * HALF + 4) = acc[ai][bj][m][1]; } }
    }
};

template <class Epi, class Sched>
__device__ __forceinline__ void gemm_phase(LAS unsigned char* lds, const Gemm g, const Sched& S, const Epi& E, const int tid) {
    const int wid = __builtin_amdgcn_readfirstlane(tid >> 6), lane = tid & 63, wr = wid >> 2, wc = wid & 3, fr = lane & 15, fq = lane >> 4;
    unsigned voffA[2], voffB[2];
#pragma unroll
    for (int i = 0; i < 2; ++i) { int R, C; stage_rc(tid * 16 + i * 8192, R, C); const int Rb = (R & ~31) + perm32(R & 31);
        voffA[i] = (unsigned)(R * g.lda + C) * 2u; voffB[i] = (unsigned)(Rb * g.ldb + C) * 2u; }
    const size_t kstep = (size_t)(BK * 2);
    const size_t hstepA = (size_t)HALF * g.lda * 2, hstepB = (size_t)HALF * g.ldb * 2;
    const size_t tstepA = 2 * hstepA, tstepB = 2 * hstepB;
    const unsigned ldsw = (unsigned)wid * 1024u;
    const int aoff = lds_byte(wr * 64 + fr, fq * 8), boff = lds_byte(wc * 32 + fr, fq * 8);
#define PG8_SA(b, h) (((b) * 2 + (h)) * HTB)
#define PG8_SB(b, h) ((4 + (b) * 2 + (h)) * HTB)
#define PG8_STAGE(bufoff, gbase, voff) do { _Pragma("unroll") for (int _i = 0; _i < 2; ++_i) \
        __builtin_amdgcn_global_load_lds((const unsigned*)((const char*)(gbase) + (voff)[_i]), (LAS unsigned*)(lds + (bufoff) + ldsw + _i * 8192), 16, 0, 0); } while (0)
#define PG8_LDA(dst, b, h) do { _Pragma("unroll") for (int m = 0; m < 4; ++m) _Pragma("unroll") for (int k = 0; k < 2; ++k) dst[m][k] = *(const LAS bf16x8*)(lds + PG8_SA(b, h) + aoff + m * 2048 + k * 1024); } while (0)
#define PG8_LDB(dst, b, h) do { _Pragma("unroll") for (int n = 0; n < 2; ++n) _Pragma("unroll") for (int k = 0; k < 2; ++k) dst[n][k] = *(const LAS bf16x8*)(lds + PG8_SB(b, h) + boff + n * 2048 + k * 1024); } while (0)
#define PG8_MMA(ai, bj, At, Bt) do { __builtin_amdgcn_s_setprio(1); _Pragma("unroll") for (int m = 0; m < 4; ++m) _Pragma("unroll") for (int n = 0; n < 2; ++n) _Pragma("unroll") for (int k = 0; k < 2; ++k) \
        acc[ai][bj][m][n] = __builtin_amdgcn_mfma_f32_16x16x32_bf16(Bt[n][k], At[m][k], acc[ai][bj][m][n], 0, 0, 0); __builtin_amdgcn_s_setprio(0); } while (0)
#define PG8_WAIT_V(n) asm volatile("s_waitcnt vmcnt(" #n ")" ::: "memory")
#define PG8_WAIT_L(n) asm volatile("s_waitcnt lgkmcnt(" #n ")" ::: "memory")
#define PG8_BAR __builtin_amdgcn_s_barrier()
#define PG8_SCHED __builtin_amdgcn_sched_barrier(0)
    Unit cur, nxt; int ui = 0;
    if (!S.next(0, cur)) return;
    f32x4 acc[2][2][4][2];
#pragma unroll
    for (int a = 0; a < 2; ++a)
#pragma unroll
        for (int b = 0; b < 2; ++b)
#pragma unroll
            for (int m = 0; m < 4; ++m)
#pragma unroll
                for (int n = 0; n < 2; ++n) acc[a][b][m][n] = (f32x4){0.f, 0.f, 0.f, 0.f};
    bf16x8 At[4][2], B0[2][2], B1[2][2];
    const char* cA = (const char*)g.A + (size_t)cur.pm * tstepA + (size_t)cur.k0 * 2; const char* cB = (const char*)g.Bt + (size_t)cur.pn * tstepB + (size_t)cur.k0 * 2;
    PG8_STAGE(PG8_SB(0, 0), cB, voffB); PG8_STAGE(PG8_SB(0, 1), cB + hstepB, voffB); PG8_STAGE(PG8_SA(0, 0), cA, voffA); PG8_STAGE(PG8_SA(0, 1), cA + hstepA, voffA);
    if (wr == 1) PG8_BAR;
    PG8_WAIT_V(2); PG8_BAR;
    PG8_STAGE(PG8_SB(1, 0), cB + kstep, voffB); PG8_STAGE(PG8_SA(1, 0), cA + kstep, voffA); PG8_STAGE(PG8_SB(1, 1), cB + hstepB + kstep, voffB);
    PG8_WAIT_V(6); PG8_BAR;
    for (;;) {
        const bool has_next = S.next(ui + 1, nxt);
        const char* nA = has_next ? (const char*)g.A + (size_t)nxt.pm * tstepA + (size_t)nxt.k0 * 2 : cA;
        const char* nB = has_next ? (const char*)g.Bt + (size_t)nxt.pn * tstepB + (size_t)nxt.k0 * 2 : cB;
        const int nt = cur.nt;
        for (int t = 0; t < nt; t += 2) {
            const bool last = (t == nt - 2);
            const char* a1 = cA + (size_t)(t + 1) * kstep;
            const char* a2 = last ? nA : cA + (size_t)(t + 2) * kstep; const char* b2 = last ? nB : cB + (size_t)(t + 2) * kstep;
            const char* a3 = a2 + kstep; const char* b3 = b2 + kstep;
            PG8_LDB(B0, 0, 0); PG8_LDB(B1, 0, 1); PG8_SCHED; PG8_LDA(At, 0, 0); PG8_STAGE(PG8_SA(1, 1), a1 + hstepA, voffA);
            PG8_WAIT_V(8); PG8_WAIT_L(0); PG8_BAR; PG8_MMA(0, 0, At, B0); PG8_MMA(0, 1, At, B1); PG8_BAR; PG8_SCHED;
            PG8_LDA(At, 0, 1); PG8_STAGE(PG8_SB(0, 0), b2, voffB); PG8_STAGE(PG8_SB(0, 1), b2 + hstepB, voffB); PG8_STAGE(PG8_SA(0, 0), a2, voffA);
            PG8_WAIT_V(8); PG8_WAIT_L(0); PG8_BAR; PG8_MMA(1, 0, At, B0); PG8_MMA(1, 1, At, B1); PG8_BAR; PG8_SCHED;
            PG8_LDB(B0, 1, 0); PG8_LDB(B1, 1, 1); PG8_SCHED; PG8_LDA(At, 1, 0); PG8_STAGE(PG8_SA(0, 1), a2 + hstepA, voffA);
            PG8_WAIT_V(8); PG8_WAIT_L(0); PG8_BAR; PG8_MMA(0, 0, At, B0); PG8_MMA(0, 1, At, B1); PG8_BAR; PG8_SCHED;
            PG8_LDA(At, 1, 1); PG8_STAGE(PG8_SB(1, 0), b3, voffB); PG8_STAGE(PG8_SB(1, 1), b3 + hstepB, voffB); PG8_STAGE(PG8_SA(1, 0), a3, voffA);
            PG8_WAIT_V(8); PG8_WAIT_L(0); PG8_BAR; PG8_MMA(1, 0, At, B0); PG8_MMA(1, 1, At, B1); PG8_BAR; PG8_SCHED;
        }
        if (wr == 0) PG8_BAR;
        E(acc, cur, wr, wc, fr, fq);
        if (!has_next) break;
        if (Epi::reset(cur))
#pragma unroll
        for (int a = 0; a < 2; ++a)
#pragma unroll
            for (int b = 0; b < 2; ++b)
#pragma unroll
                for (int m = 0; m < 4; ++m)
#pragma unroll
                    for (int n = 0; n < 2; ++n) acc[a][b][m][n] = (f32x4){0.f, 0.f, 0.f, 0.f};
        cur = nxt; cA = nA; cB = nB; ++ui;
        if (wr == 1) PG8_BAR;
    }
    PG8_WAIT_V(0);
    PG8_BAR;
#undef PG8_SA
#undef PG8_SB
#undef PG8_STAGE
#undef PG8_LDA
#undef PG8_LDB
#undef PG8_MMA
#undef PG8_WAIT_V
#undef PG8_WAIT_L
#undef PG8_BAR
#undef PG8_SCHED
}
}


#define XB_TMO      128
#define XB_XCNT(j)  (256  + 64 * (j))
#define XB_XSUB(j)  (1280 + 64 * (j))
#define XB_XGEN(j)  (2304 + 64 * (j))
#define XB_TOP      3328
#define XB_TOPGEN   3392
#define XCD_BAR_WORDS 3456
#define XB_SPIN_CAP (1u << 18)
__device__ __forceinline__ unsigned xb_ld(unsigned* p)              { return __hip_atomic_load(p, __ATOMIC_RELAXED, __HIP_MEMORY_SCOPE_AGENT); }
__device__ __forceinline__ unsigned xb_add(unsigned* p, unsigned v) { return __hip_atomic_fetch_add(p, v, __ATOMIC_RELAXED, __HIP_MEMORY_SCOPE_AGENT); }
__device__ __forceinline__ unsigned xb_xcc_id() { return (unsigned)__builtin_amdgcn_s_getreg((3 << 11) | 20) & 0xFu; }
#define XB_SPIN(cond, bar) do { unsigned _sp = 0; while (cond) { __builtin_amdgcn_s_sleep(1); \
    if ((++_sp & 255u) == 0u) { if (xb_ld(&(bar)[XB_TMO])) break; if (_sp > XB_SPIN_CAP) { atomicAdd(&(bar)[XB_TMO], 1u); break; } } } } while (0)
__device__ __forceinline__ void xcd_barrier_complete(unsigned* bar, unsigned x, unsigned& nloc, unsigned& nx) {
    const unsigned G = gridDim.x * gridDim.y * gridDim.z;
    unsigned sum, cnt, mine, sp = 0u;
    for (;;) {
        sum = 0u; cnt = 0u; mine = 0u;
#pragma unroll
        for (unsigned j = 0; j < 16; ++j) { const unsigned c = xb_ld(&bar[XB_XCNT(j)]); sum += c; cnt += (c > 0u) ? 1u : 0u; mine = (j == x) ? c : mine; }
        if (sum == G) break;
        __builtin_amdgcn_s_sleep(1);
        if ((++sp & 255u) == 0u) { if (xb_ld(&bar[XB_TMO])) break; if (sp > XB_SPIN_CAP) { atomicAdd(&bar[XB_TMO], 1u); break; } }
    }
    nloc = mine > 0u ? mine : 1u; nx = cnt > 0u ? cnt : 1u;
}
__device__ __forceinline__ void xcd_barrier(unsigned* bar, volatile LAS unsigned* st) {
    asm volatile("s_waitcnt vmcnt(0)" ::: "memory");
    __syncthreads();
    if (threadIdx.x == 0) {
        const unsigned x = xb_xcc_id();
        __builtin_amdgcn_s_waitcnt(0);
        unsigned nloc = st[0], nx = st[1];
        if (nloc == 0u) { xcd_barrier_complete(bar, x, nloc, nx); st[0] = nloc; st[1] = nx; }
        const unsigned old = xb_add(&bar[XB_XSUB(x)], 1u);
        const unsigned gen = old / nloc;
        if (old + 1u == (gen + 1u) * nloc) {
            __builtin_amdgcn_fence(__ATOMIC_RELEASE, "agent");
            asm volatile("s_waitcnt vmcnt(0)" ::: "memory");
            const unsigned og = xb_add(&bar[XB_TOP], 1u);
            const unsigned tg = og / nx;
            if (og + 1u == (tg + 1u) * nx) xb_add(&bar[XB_TOPGEN], 1u);
            else XB_SPIN(xb_ld(&bar[XB_TOPGEN]) == tg, bar);
            __builtin_amdgcn_fence(__ATOMIC_ACQUIRE, "agent");
            xb_add(&bar[XB_XGEN(x)], 1u);
            asm volatile("s_waitcnt vmcnt(0)" ::: "memory");
        } else {
            XB_SPIN(xb_ld(&bar[XB_XGEN(x)]) == gen, bar);
            __builtin_amdgcn_fence(__ATOMIC_ACQUIRE, "agent");
            asm volatile("s_waitcnt vmcnt(0)" ::: "memory");
        }
    }
    __syncthreads();
}

struct Ctx {
    int bx;
    bf16_t *win, *wb, *wout, *h, *proj, *gates, *y, *mb;
    float *mf, *of, *kva, *kvd, *decd, *ropeAc, *ropeAs, *ropeBc, *ropeBs, *lbt;
    int tid, lane, w, G;
};

__device__ __forceinline__ void transpose_tile(const float* src, int N, bf16_t* dst, int Kp, int k0, int n0, float* scr, int tid) {
    const int kk = tid >> 3, c8 = (tid & 7) * 8;
    const float4* s = (const float4*)(src + (size_t)(k0 + kk) * N + n0 + c8);
    const float4 a = s[0], b = s[1];
    float* r = scr + kk * 65 + c8;
    r[0] = a.x; r[1] = a.y; r[2] = a.z; r[3] = a.w; r[4] = b.x; r[5] = b.y; r[6] = b.z; r[7] = b.w;
    __syncthreads();
    const int n = tid >> 3, k8 = (tid & 7) * 8;
    const float* q = scr + k8 * 65 + n;
    u32x4 wv; wv.x = pk2(q[0], q[65]); wv.y = pk2(q[130], q[195]); wv.z = pk2(q[260], q[325]); wv.w = pk2(q[390], q[455]);
    *(u32x4*)(dst + (size_t)(n0 + n) * Kp + k0 + k8) = wv;
    __syncthreads();
}

__device__ __forceinline__ void phase_prologue(const Params& P, Ctx& C, unsigned char* lds) {
    const int tid = C.tid;
    float* scr = (float*)lds;
    for (int job = C.bx; job < 4 * 2496; job += C.G) {
        const int l = job / 2496, j = job % 2496;
        if (j < 1920) { const int kt = j / 120, nt = j % 120; transpose_tile(P.w_in + (size_t)l * DM * DIN, DIN, C.win + (size_t)l * DIN * DM, DM, kt * 64, nt * 64, scr, tid); }
        else if (j < 2240) { const int jj = j - 1920, kt = jj / 16, nt = jj % 16; transpose_tile(P.w_branch + (size_t)l * WMIX * DM, DM, C.wb + (size_t)l * DM * WMIX, WMIX, kt * 64, nt * 64, scr, tid); }
        else { const int jj = j - 2240, kt = jj / 16, nt = jj % 16; transpose_tile(P.w_out + (size_t)l * DM * DM, DM, C.wout + (size_t)l * DM * DM, DM, kt * 64, nt * 64, scr, tid); }
    }
    for (int row = C.bx * 8 + C.w; row < M_TOT; row += C.G * 8) {
        const float* xs = row < M_P ? P.x_prompt + (size_t)row * DM : P.x_sample + (size_t)(row - M_P) * DM;
        float4 x[4]; float ss = 0.f;
#pragma unroll
        for (int i = 0; i < 4; ++i) { x[i] = ((const float4*)xs)[C.lane + 64 * i]; ss += x[i].x * x[i].x + x[i].y * x[i].y + x[i].z * x[i].z + x[i].w * x[i].w; }
        ss = wave_sum(ss); const float r = rsqrtf(ss * (1.f / DM) + EPS);
#pragma unroll
        for (int i = 0; i < 4; ++i) { ((float4*)(P.out + (size_t)row * DM))[C.lane + 64 * i] = x[i];
            const float4 g = ((const float4*)P.g_pre)[C.lane + 64 * i];
            uint2 o; o.x = pk2(x[i].x * r * g.x, x[i].y * r * g.y); o.y = pk2(x[i].z * r * g.z, x[i].w * r * g.w);
            ((uint2*)(C.h + (size_t)row * DM))[C.lane + 64 * i] = o; }
    }
    const int gt = C.bx * NTHREADS + tid, gn = C.G * NTHREADS;
    const double TWO_PI = 6.283185307179586476925286766559, INV_2PI = 0.15915494309189533576888376337251;
    for (int i = gt; i < NPOS * 24; i += gn) {
        int pos, f; double inv;
        if (i < NPOS * 16) { pos = i >> 4; f = i & 15; inv = P.invA[f]; } else { const int k = i - NPOS * 16; pos = k >> 3; f = k & 7; inv = P.invB[f]; }
        double r = (double)pos * inv * INV_2PI; r -= floor(r);
        const float a = (float)(r * TWO_PI);
        const float cs = cosf(a), sn = sinf(a);
        if (i < NPOS * 16) { C.ropeAc[i] = cs; C.ropeAs[i] = sn; } else { C.ropeBc[i - NPOS * 16] = cs; C.ropeBs[i - NPOS * 16] = sn; }
    }
    for (int c = gt; c < 256; c += gn) {
        const float v0 = P.lower_bounds[c], v1 = P.lower_bounds[256 + c], v2 = P.lower_bounds[512 + c], v3 = P.lower_bounds[768 + c];
        const float m = fmaxf(fmaxf(v0, v1), fmaxf(v2, v3));
        const float e0 = expf(v0 - m), e1 = expf(v1 - m), e2 = expf(v2 - m), e3 = expf(v3 - m), inv = 1.f / (e0 + e1 + e2 + e3);
        C.lbt[c] = 0.f; C.lbt[256 + c] = e1 * inv; C.lbt[512 + c] = (e1 + e2) * inv; C.lbt[768 + c] = (e1 + e2 + e3) * inv;
    }
}

__device__ __forceinline__ void attn_prompt_unit(const Params& P, Ctx& C, int l, int b, int qb, int kvh, unsigned char* lds) {
    const int tid = C.tid, lane = C.lane, w = C.w, fr = lane & 15, fq = lane >> 4;
    bf16_t* Ks = (bf16_t*)lds;
    bf16_t* Vt = (bf16_t*)(lds + 36864);
    bf16_t* Ps = (bf16_t*)(lds + 36864 + 35840) + w * (16 * 168);
    const int t0 = qb * 128; const size_t R0 = (size_t)b * 8192 + t0;
    const bool last = (qb == 63);
    for (int i = tid; i < 256 * 7; i += NTHREADS) {
        const int kk = i / 7, task = i - kk * 7, tk = t0 - 128 + kk;
        bf16_t* dst = Ks + kk * 72;
        if (tk < 0) { const u32x4 z = {0u, 0u, 0u, 0u}; if (task == 0) { *(u32x4*)dst = z; *(u32x4*)(dst + 8) = z; } else *(u32x4*)(dst + (task + 1) * 8) = z; }
        else {
            const bf16_t* src = C.proj + (size_t)(b * 8192 + tk) * NPROJ + C_KB + kvh * 64;
            float* kp = P.out + O_KP + ((((size_t)l * 2 + b) * 128 + (kk - 128)) * 2 + kvh) * 64;
            if (task == 0) {
                const u32x4 a = *(const u32x4*)src, bb = *(const u32x4*)(src + 8);
                const float4 c0 = *(const float4*)(C.ropeBc + tk * 8), c1 = *(const float4*)(C.ropeBc + tk * 8 + 4), s0 = *(const float4*)(C.ropeBs + tk * 8), s1 = *(const float4*)(C.ropeBs + tk * 8 + 4);
                const float x1[8] = {lo16(a.x), hi16(a.x), lo16(a.y), hi16(a.y), lo16(a.z), hi16(a.z), lo16(a.w), hi16(a.w)};
                const float x2[8] = {lo16(bb.x), hi16(bb.x), lo16(bb.y), hi16(bb.y), lo16(bb.z), hi16(bb.z), lo16(bb.w), hi16(bb.w)};
                const float cs[8] = {c0.x, c0.y, c0.z, c0.w, c1.x, c1.y, c1.z, c1.w}, sn[8] = {s0.x, s0.y, s0.z, s0.w, s1.x, s1.y, s1.z, s1.w};
                float r1[8], r2[8];
#pragma unroll
                for (int j = 0; j < 8; ++j) { r1[j] = x1[j] * cs[j] - x2[j] * sn[j]; r2[j] = x2[j] * cs[j] + x1[j] * sn[j]; }
                u32x4 o1, o2; o1.x = pk2(r1[0], r1[1]); o1.y = pk2(r1[2], r1[3]); o1.z = pk2(r1[4], r1[5]); o1.w = pk2(r1[6], r1[7]);
                o2.x = pk2(r2[0], r2[1]); o2.y = pk2(r2[2], r2[3]); o2.z = pk2(r2[4], r2[5]); o2.w = pk2(r2[6], r2[7]);
                *(u32x4*)dst = o1; *(u32x4*)(dst + 8) = o2;
                if (last && kk >= 128) {
#pragma unroll
                    for (int j = 0; j < 8; ++j) { kp[j] = r1[j]; kp[8 + j] = r2[j]; } }
            } else {
                const int c = task + 1; const u32x4 a = *(const u32x4*)(src + c * 8); *(u32x4*)(dst + c * 8) = a;
                if (last && kk >= 128) { float* o = kp + c * 8; o[0] = lo16(a.x); o[1] = hi16(a.x); o[2] = lo16(a.y); o[3] = hi16(a.y); o[4] = lo16(a.z); o[5] = hi16(a.z); o[6] = lo16(a.w); o[7] = hi16(a.w); }
            }
        }
    }
    for (int i = tid; i < 256 * 8; i += NTHREADS) {
        const int kk = i & 255, c = i >> 8, tk = t0 - 128 + kk;
        u32x4 a = {0u, 0u, 0u, 0u};
        if (tk >= 0) a = *(const u32x4*)(C.proj + (size_t)(b * 8192 + tk) * NPROJ + C_VB + kvh * 64 + c * 8);
        bf16_t* d = Vt + (c * 8) * 280 + kk;
        d[0] = (bf16_t)(a.x & 0xffff); d[280] = (bf16_t)(a.x >> 16); d[560] = (bf16_t)(a.y & 0xffff); d[840] = (bf16_t)(a.y >> 16);
        d[1120] = (bf16_t)(a.z & 0xffff); d[1400] = (bf16_t)(a.z >> 16); d[1680] = (bf16_t)(a.w & 0xffff); d[1960] = (bf16_t)(a.w >> 16);
        if (last && kk >= 128) { float* o = P.out + O_VP + ((((size_t)l * 2 + b) * 128 + (kk - 128)) * 2 + kvh) * 64 + c * 8;
            o[0] = lo16(a.x); o[1] = hi16(a.x); o[2] = lo16(a.y); o[3] = hi16(a.y); o[4] = lo16(a.z); o[5] = hi16(a.z); o[6] = lo16(a.w); o[7] = hi16(a.w); }
    }
    for (int i = tid; i < 64 * 24; i += NTHREADS) Vt[(i / 24) * 280 + 256 + (i % 24)] = 0;
    for (int i = lane; i < 16 * 16; i += 64) Ps[(i >> 4) * 168 + 144 + (i & 15)] = 0;
    __syncthreads();
    const int tq = t0 + w * 16 + fr;
    for (int g = 0; g < 4; ++g) {
        const int h = kvh * 4 + g;
        const bf16_t* qsrc = C.proj + (R0 + w * 16 + fr) * NPROJ + C_QB + h * 64;
        u32x4 q0 = *(const u32x4*)(qsrc + fq * 8); const u32x4 q1 = *(const u32x4*)(qsrc + 32 + fq * 8);
        if (fq < 2) {
            const u32x4 qp = *(const u32x4*)(qsrc + (fq ^ 1) * 8);
            const float4 c0 = *(const float4*)(C.ropeBc + tq * 8), c1 = *(const float4*)(C.ropeBc + tq * 8 + 4), s0 = *(const float4*)(C.ropeBs + tq * 8), s1 = *(const float4*)(C.ropeBs + tq * 8 + 4);
            const float sg = fq == 0 ? -1.f : 1.f;
            const float own[8] = {lo16(q0.x), hi16(q0.x), lo16(q0.y), hi16(q0.y), lo16(q0.z), hi16(q0.z), lo16(q0.w), hi16(q0.w)};
            const float par[8] = {lo16(qp.x), hi16(qp.x), lo16(qp.y), hi16(qp.y), lo16(qp.z), hi16(qp.z), lo16(qp.w), hi16(qp.w)};
            const float cs[8] = {c0.x, c0.y, c0.z, c0.w, c1.x, c1.y, c1.z, c1.w}, sn[8] = {s0.x, s0.y, s0.z, s0.w, s1.x, s1.y, s1.z, s1.w};
            float r[8];
#pragma unroll
            for (int j = 0; j < 8; ++j) r[j] = own[j] * cs[j] + sg * par[j] * sn[j];
            q0.x = pk2(r[0], r[1]); q0.y = pk2(r[2], r[3]); q0.z = pk2(r[4], r[5]); q0.w = pk2(r[6], r[7]);
        }
        const bf16x8 qa0 = __builtin_bit_cast(bf16x8, q0), qa1 = __builtin_bit_cast(bf16x8, q1);
        f32x4 S[9];
#pragma unroll
        for (int jt = 0; jt < 9; ++jt) {
            const bf16_t* kp = Ks + ((w + jt) * 16 + fr) * 72 + fq * 8;
            f32x4 a = {0.f, 0.f, 0.f, 0.f};
            a = mfma16(qa0, *(const bf16x8*)kp, a); a = mfma16(qa1, *(const bf16x8*)(kp + 32), a);
            S[jt] = a;
        }
        const float sink = P.attn_sink[l * 8 + h];
        float mx[4], sm[4];
#pragma unroll
        for (int j = 0; j < 4; ++j) {
            const int r = w * 16 + fq * 4 + j;
            float m = -1e30f;
#pragma unroll
            for (int jt = 0; jt < 9; ++jt) { const int kk = (w + jt) * 16 + fr; const bool ok = (kk >= r) && (kk <= r + 128) && (t0 - 128 + kk >= 0);
                const float s = ok ? S[jt][j] * 0.125f : -1e30f; S[jt][j] = s; m = fmaxf(m, s); }
            m = fmaxf(quad16_max(m), sink); mx[j] = m;
            float su = 0.f;
#pragma unroll
            for (int jt = 0; jt < 9; ++jt) { const float p = __expf(S[jt][j] - m); su += p; Ps[(fq * 4 + j) * 168 + jt * 16 + fr] = f2bf(p); }
            su = quad16_sum(su) + __expf(sink - m); sm[j] = 1.f / su;
        }
        __syncthreads();
        f32x4 O[4];
#pragma unroll
        for (int nt = 0; nt < 4; ++nt) O[nt] = (f32x4){0.f, 0.f, 0.f, 0.f};
#pragma unroll
        for (int kx = 0; kx < 5; ++kx) {
            const bf16x8 a = *(const bf16x8*)(Ps + fr * 168 + kx * 32 + fq * 8);
#pragma unroll
            for (int nt = 0; nt < 4; ++nt) O[nt] = mfma16(a, *(const bf16x8*)(Vt + (nt * 16 + fr) * 280 + w * 16 + kx * 32 + fq * 8), O[nt]);
        }
#pragma unroll
        for (int j = 0; j < 4; ++j) {
            const size_t row = R0 + w * 16 + fq * 4 + j;
#pragma unroll
            for (int nt = 0; nt < 4; ++nt) { const int e = nt * 16 + fr;
                const float z = bf2f(C.proj[row * NPROJ + C_ZB + h * 64 + e]);
                C.y[row * WMIX + Y_B + h * 64 + e] = f2bf(O[nt][j] * sm[j] * silu_(z)); }
        }
        __syncthreads();
    }
}

__device__ __forceinline__ void pool_prompt_unit(const Params& P, Ctx& C, int l, int tile, unsigned char* lds) {
    const int tid = C.tid, lane = C.lane, w = C.w, fr = lane & 15, fq = lane >> 4;
    bf16_t* U = (bf16_t*)lds;
    bf16_t* A = (bf16_t*)(lds + 40448);
    bf16_t* Wt = (bf16_t*)(lds + 40448 + 33792);
    const int b = tile >> 7, t0 = (tile & 127) * 64; const size_t R0 = (size_t)b * 8192 + t0;
    for (int i = tid; i < 79 * 32; i += NTHREADS) { const int r = i >> 5, c = i & 31, t = t0 - 15 + r;
        u32x4 a = {0u, 0u, 0u, 0u}; if (t >= 0) a = *(const u32x4*)(C.proj + (size_t)(b * 8192 + t) * NPROJ + C_UC + c * 8);
        *(u32x4*)(U + r * 256 + c * 8) = a; }
    for (int i = tid; i < 4 * 64 * 64; i += NTHREADS) { const int g = i >> 12, cin = (i >> 6) & 63, dout = i & 63;
        Wt[(g * 64 + dout) * 72 + cin] = f2bf(P.w_pool[(size_t)l * 16384 + i]); }
    __syncthreads();
    { const int c = tid & 255, rh = tid >> 8, g = c >> 6, wn = 2 << g;
      for (int r = rh * 32; r < rh * 32 + 32; ++r) {
          float s = 0.f; for (int j = 0; j < wn; ++j) s += bf2f(U[(r + 15 - j) * 256 + c]);
          const int pos = t0 + r; const float cnt = (float)(pos + 1 < wn ? pos + 1 : wn);
          const float u = bf2f(U[(r + 15) * 256 + c]);
          A[r * 264 + c] = f2bf(s / cnt - u);
          if (t0 == 8128 && r >= 49) P.out[O_POOLP + (((size_t)l * 2 + b) * 15 + (r - 49)) * 256 + c] = u;
      } }
    __syncthreads();
    for (int tl = w; tl < 64; tl += 8) { const int rt = tl >> 4, ct = tl & 15, g = ct >> 2;
        f32x4 acc = {0.f, 0.f, 0.f, 0.f};
        acc = mma_tile(A + rt * 16 * 264 + g * 64, 264, Wt + (g * 64 + (ct & 3) * 16) * 72, 72, 64, acc, lane);
        const int c = ct * 16 + fr; const float sc = P.pool_scale[l * 256 + c];
#pragma unroll
        for (int j = 0; j < 4; ++j) { const size_t row = R0 + rt * 16 + fq * 4 + j;
            const float z = bf2f(C.proj[row * NPROJ + C_ZC + c]);
            C.y[row * WMIX + Y_C + c] = f2bf(acc[j] * sc * silu_(z)); }
    }
    __syncthreads();
}

__device__ __forceinline__ void unpack8(const u32x4 a, float (&x)[8]) { x[0] = lo16(a.x); x[1] = hi16(a.x); x[2] = lo16(a.y); x[3] = hi16(a.y); x[4] = lo16(a.z); x[5] = hi16(a.z); x[6] = lo16(a.w); x[7] = hi16(a.w); }
__device__ __forceinline__ u32x4 pack8(const float (&x)[8]) { u32x4 w; w.x = pk2(x[0], x[1]); w.y = pk2(x[2], x[3]); w.z = pk2(x[4], x[5]); w.w = pk2(x[6], x[7]); return w; }
template <bool IS_D, bool KV>
__device__ __forceinline__ void lin_chunk(const Params& P, Ctx& C, int l, int b, int n, unsigned char* lds) {
    const int lane = C.lane, w = C.w, fr = lane & 15, fq = lane >> 4;
    constexpr int DK = IS_D ? 64 : 32, NCG = DK / 8, HPR = KV ? 4 : 2;
    constexpr int SLOT = KV ? 18432 : 53248, VP = KV ? 72 : 136;
    const size_t R0 = (size_t)b * 8192 + n * 64;
    const bf16_t* prow = C.proj + (R0 + lane) * NPROJ;
    for (int h0 = 0; h0 < 4; h0 += HPR) {
        for (int task = w; task < HPR * NCG; task += 8) {
            const int hh = task / NCG, cg = task % NCG, h = h0 + hh, d0 = cg * 8;
            unsigned char* slot = lds + hh * SLOT;
            float q[8], k[8], Bt[8], Bm[8], Bl[8];
            if (IS_D) {
                float qv[8], fv[8]; unpack8(*(const u32x4*)(prow + C_QD + h * 64 + d0), qv); unpack8(*(const u32x4*)(prow + C_FD + h * 64 + d0), fv);
                const float4 l0 = *(const float4*)(C.lbt + l * 256 + h * 64 + d0), l1 = *(const float4*)(C.lbt + l * 256 + h * 64 + d0 + 4);
                const float lb[8] = {l0.x, l0.y, l0.z, l0.w, l1.x, l1.y, l1.z, l1.w};
#pragma unroll
                for (int j = 0; j < 8; ++j) { const float f = lb[j] + (1.f - lb[j]) * sigmoid_(fv[j]); q[j] = silu_(qv[j]); k[j] = 1.f - f;
                    float v = __logf(f);
#pragma unroll
                    for (int off = 1; off < 64; off <<= 1) { const float u = __shfl_up(v, off); if (lane >= off) v += u; }
                    Bt[j] = v; Bm[j] = __shfl(v, 31); Bl[j] = __shfl(v, 63); }
                if (KV && lane == 63) {
#pragma unroll
                    for (int j = 0; j < 8; ++j) C.decd[(size_t)(b * 128 + n) * 256 + h * 64 + d0 + j] = __expf(Bl[j]); }
            } else {
                const float lg = log1pf(-exp2f(-5.f - (float)h));
                const int i0 = d0 & 15, pos = n * 64 + lane;
                float q1[8], q2[8], k1[8], k2[8];
                unpack8(*(const u32x4*)(prow + C_QA + h * 32 + i0), q1); unpack8(*(const u32x4*)(prow + C_QA + h * 32 + 16 + i0), q2);
                unpack8(*(const u32x4*)(prow + C_KA + h * 32 + i0), k1); unpack8(*(const u32x4*)(prow + C_KA + h * 32 + 16 + i0), k2);
                const float4 c0 = *(const float4*)(C.ropeAc + pos * 16 + i0), c1 = *(const float4*)(C.ropeAc + pos * 16 + i0 + 4), s0 = *(const float4*)(C.ropeAs + pos * 16 + i0), s1 = *(const float4*)(C.ropeAs + pos * 16 + i0 + 4);
                const float cs[8] = {c0.x, c0.y, c0.z, c0.w, c1.x, c1.y, c1.z, c1.w}, sn[8] = {s0.x, s0.y, s0.z, s0.w, s1.x, s1.y, s1.z, s1.w};
#pragma unroll
                for (int j = 0; j < 8; ++j) {
                    q[j] = d0 < 16 ? q1[j] * cs[j] - q2[j] * sn[j] : q2[j] * cs[j] + q1[j] * sn[j];
                    k[j] = (d0 < 16 ? k1[j] * cs[j] - k2[j] * sn[j] : k2[j] * cs[j] + k1[j] * sn[j]) * 0.17677669529663687f;
                    Bt[j] = (float)(lane + 1) * lg; Bm[j] = 32.f * lg; Bl[j] = 64.f * lg; }
            }
            if (!KV) {
                bf16_t* Qh = (bf16_t*)slot; bf16_t* Kh = (bf16_t*)(slot + 9216); bf16_t* PQ = (bf16_t*)(slot + 18432);
                float a[8], c[8], e[8];
#pragma unroll
                for (int j = 0; j < 8; ++j) { a[j] = q[j] * __expf(Bt[j] - Bm[j]); c[j] = k[j] * __expf(Bm[j] - Bt[j]); e[j] = q[j] * __expf(Bt[j]); }
                *(u32x4*)(Qh + lane * 72 + d0) = pack8(a); *(u32x4*)(Kh + lane * 72 + d0) = pack8(c); *(u32x4*)(PQ + lane * 136 + 64 + d0) = pack8(e);
            } else {
                bf16_t* KdT = (bf16_t*)slot;
#pragma unroll
                for (int j = 0; j < 8; ++j) KdT[(d0 + j) * 72 + lane] = f2bf(k[j] * __expf(Bl[j] - Bt[j]));
            }
        }
        for (int task = w; task < HPR * 8; task += 8) {
            const int hh = task >> 3, e0 = (task & 7) * 8, h = h0 + hh;
            bf16_t* VS = (bf16_t*)(lds + hh * SLOT + (KV ? 9216 : 35840));
            const u32x4 v = *(const u32x4*)(prow + (IS_D ? C_ID : C_VA) + h * 64 + e0);
            bf16_t* d = VS + e0 * VP + lane;
            d[0] = (bf16_t)(v.x & 0xffff); d[VP] = (bf16_t)(v.x >> 16); d[2 * VP] = (bf16_t)(v.y & 0xffff); d[3 * VP] = (bf16_t)(v.y >> 16);
            d[4 * VP] = (bf16_t)(v.z & 0xffff); d[5 * VP] = (bf16_t)(v.z >> 16); d[6 * VP] = (bf16_t)(v.w & 0xffff); d[7 * VP] = (bf16_t)(v.w >> 16);
            if (!KV && lane < DK) {
                const float* sp = (IS_D ? C.kvd : C.kva) + ((size_t)(b * 128 + n) * 4 + h) * (DK * 64) + lane * 64 + e0;
                const float4 s0 = *(const float4*)sp, s1 = *(const float4*)(sp + 4);
                bf16_t* ds = VS + e0 * VP + 64 + lane;
                ds[0] = f2bf(s0.x); ds[VP] = f2bf(s0.y); ds[2 * VP] = f2bf(s0.z); ds[3 * VP] = f2bf(s0.w); ds[4 * VP] = f2bf(s1.x); ds[5 * VP] = f2bf(s1.y); ds[6 * VP] = f2bf(s1.z); ds[7 * VP] = f2bf(s1.w);
            }
        }
        __syncthreads();
        if (KV) {
            constexpr int TPH = (DK / 16) * 4;
            for (int tl = w; tl < 4 * TPH; tl += 8) { const int hh = tl / TPH, r = tl % TPH, dt = r >> 2, et = r & 3, h = h0 + hh;
                const bf16_t* KdT = (const bf16_t*)(lds + hh * SLOT); const bf16_t* VT = (const bf16_t*)(lds + hh * SLOT + 9216);
                f32x4 acc = {0.f, 0.f, 0.f, 0.f};
                acc = mma_tile(KdT + dt * 16 * 72, 72, VT + et * 16 * 72, 72, 64, acc, lane);
                float* kvbase = (IS_D ? C.kvd : C.kva) + ((size_t)(b * 128 + n) * 4 + h) * (DK * 64);
#pragma unroll
                for (int j = 0; j < 4; ++j) kvbase[(dt * 16 + fq * 4 + j) * 64 + et * 16 + fr] = acc[j]; }
        } else {
            for (int tl = w; tl < 32; tl += 8) { const int hh = tl >> 4, rt = (tl >> 2) & 3, ct = tl & 3;
                const bf16_t* Qh = (const bf16_t*)(lds + hh * SLOT); const bf16_t* Kh = (const bf16_t*)(lds + hh * SLOT + 9216); bf16_t* PQ = (bf16_t*)(lds + hh * SLOT + 18432);
                f32x4 acc = {0.f, 0.f, 0.f, 0.f};
                if (ct <= rt) acc = mma_tile(Qh + rt * 16 * 72, 72, Kh + ct * 16 * 72, 72, DK, acc, lane);
#pragma unroll
                for (int j = 0; j < 4; ++j) { const int t = rt * 16 + fq * 4 + j, sidx = ct * 16 + fr; PQ[t * 136 + sidx] = f2bf(sidx <= t ? acc[j] : 0.f); } }
            __syncthreads();
            { const int hh = w >> 2, rt = w & 3, h = h0 + hh;
                const bf16_t* PQ = (const bf16_t*)(lds + hh * SLOT + 18432); const bf16_t* VS = (const bf16_t*)(lds + hh * SLOT + 35840);
                f32x4 O[4];
#pragma unroll
                for (int et = 0; et < 4; ++et) { O[et] = (f32x4){0.f, 0.f, 0.f, 0.f}; O[et] = mma_tile(PQ + rt * 16 * 136, 136, VS + et * 16 * 136, 136, 64 + DK, O[et], lane); }
#pragma unroll
                for (int j = 0; j < 4; ++j) {
                    float ss = O[0][j] * O[0][j] + O[1][j] * O[1][j] + O[2][j] * O[2][j] + O[3][j] * O[3][j];
                    ss = quad16_sum(ss); const float r = rsqrtf(ss * (1.f / 64.f) + EPS);
                    const size_t row = R0 + rt * 16 + fq * 4 + j;
#pragma unroll
                    for (int et = 0; et < 4; ++et) { const int e = et * 16 + fr;
                        const float z = bf2f(C.proj[row * NPROJ + (IS_D ? C_ZD : C_ZA) + h * 64 + e]);
                        const float gsc = IS_D ? P.g_hgrn[l * 256 + h * 64 + e] : 1.f;
                        C.y[row * WMIX + (IS_D ? Y_D : Y_A) + h * 64 + e] = f2bf(O[et][j] * r * gsc * silu_(z)); }
                }
            }
        }
        __syncthreads();
    }
}

__device__ __forceinline__ void sample_unit(const Params& P, Ctx& C, int l, int sb, unsigned char* lds) {
    const int tid = C.tid, lane = C.lane, w = C.w;
    bf16_t* prb = (bf16_t*)lds;
    float* qa = (float*)(lds + 28672);
    float* ka = qa + 512;
    float* qd = ka + 512;
    float* fd = qd + 1024;
    float* qbq = fd + 1024;
    float* kn = qbq + 2048;
    float* pl = kn + 512;
    float* ps = pl + 1024;
    float* kv = ps + 32 * 136;
    const size_t R0 = (size_t)M_P + sb * 4;
    for (int i = tid; i < 4 * 448; i += NTHREADS) { const int t = i / 448, c = i % 448;
        *(u32x4*)(prb + t * NPROJ + c * 8) = *(const u32x4*)(C.proj + (R0 + t) * NPROJ + c * 8); }
    __syncthreads();
#define PR(t, c) bf2f(prb[(t) * NPROJ + (c)])
    {
        const int t = tid >> 7, c = tid & 127, h = c >> 5, d = c & 31, ii = d & 15, pos = 8192 + t;
        const float cs = C.ropeAc[pos * 16 + ii], sn = C.ropeAs[pos * 16 + ii];
        const float q1 = PR(t, C_QA + h * 32 + ii), q2 = PR(t, C_QA + h * 32 + 16 + ii), k1 = PR(t, C_KA + h * 32 + ii), k2 = PR(t, C_KA + h * 32 + 16 + ii);
        qa[tid] = d < 16 ? q1 * cs - q2 * sn : q2 * cs + q1 * sn;
        ka[tid] = (d < 16 ? k1 * cs - k2 * sn : k2 * cs + k1 * sn) * 0.17677669529663687f;
    }
    for (int i = tid; i < 1024; i += NTHREADS) { const int t = i >> 8, c = i & 255;
        qd[i] = silu_(PR(t, C_QD + c)); const float lb = C.lbt[l * 256 + c]; fd[i] = lb + (1.f - lb) * sigmoid_(PR(t, C_FD + c));
        const int g = c >> 6, wn = 2 << g; float s = 0.f;
        for (int j = 0; j < wn; ++j) { const int e = 15 + t - j; s += e >= 15 ? PR(e - 15, C_UC + c) : P.state_pool[(((size_t)l * 128 + sb) * 15 + e) * 256 + c]; }
        pl[i] = s / (float)wn - PR(t, C_UC + c); }
    for (int i = tid; i < 2048; i += NTHREADS) { const int t = i >> 9, c = i & 511, h = c >> 6, d = c & 63; const int pos = 8192 + t;
        float v;
        if (d < 16) { const int ii = d & 7; const float cs = C.ropeBc[pos * 8 + ii], sn = C.ropeBs[pos * 8 + ii];
            const float x1 = PR(t, C_QB + h * 64 + ii), x2 = PR(t, C_QB + h * 64 + 8 + ii); v = d < 8 ? x1 * cs - x2 * sn : x2 * cs + x1 * sn; }
        else v = PR(t, C_QB + c);
        qbq[i] = v * 0.125f; }
    { const int t = tid >> 7, c = tid & 127, kh = c >> 6, d = c & 63, pos = 8192 + t;
        float v;
        if (d < 16) { const int ii = d & 7; const float cs = C.ropeBc[pos * 8 + ii], sn = C.ropeBs[pos * 8 + ii];
            const float x1 = PR(t, C_KB + kh * 64 + ii), x2 = PR(t, C_KB + kh * 64 + 8 + ii); v = d < 8 ? x1 * cs - x2 * sn : x2 * cs + x1 * sn; }
        else v = PR(t, C_KB + c);
        kn[tid] = v;
        P.out[O_KS + (((size_t)l * 128 + sb) * 128 + 124 + t) * 128 + c] = v;
        P.out[O_VS + (((size_t)l * 128 + sb) * 128 + 124 + t) * 128 + c] = PR(t, C_VB + c); }
    for (int i = tid; i < 15 * 256; i += NTHREADS) { const int r = i >> 8, c = i & 255;
        P.out[O_POOLS + (((size_t)l * 128 + sb) * 15 + r) * 256 + c] = r < 11 ? P.state_pool[(((size_t)l * 128 + sb) * 15 + r + 4) * 256 + c] : PR(r - 11, C_UC + c); }
    { const float* kc = P.cache_k + ((size_t)l * 128 + sb) * 16384; float* ko = P.out + O_KS + ((size_t)l * 128 + sb) * 16384;
      for (int i = tid; i < 4096; i += NTHREADS) { const float4 v = ((const float4*)kc)[i]; const int e = i * 4, wq = e >> 7, r = e & 127, kh = r >> 6, d = r & 63;
          float* dst = kv + (wq * 2 + kh) * 65 + d; dst[0] = v.x; dst[1] = v.y; dst[2] = v.z; dst[3] = v.w;
          if (wq >= 4) ((float4*)ko)[i - 128] = v; } }
    __syncthreads();
    if (w < 4) { const int h = w, e = lane;
        const float gam = 1.f - exp2f(-5.f - (float)h);
        const float* S0 = P.state_ret + (((size_t)l * 128 + sb) * 4 + h) * 2048; float* S1 = P.out + O_RETS + (((size_t)l * 128 + sb) * 4 + h) * 2048;
        const float v0 = PR(0, C_VA + h * 64 + e), v1 = PR(1, C_VA + h * 64 + e), v2 = PR(2, C_VA + h * 64 + e), v3 = PR(3, C_VA + h * 64 + e);
        float o0 = 0.f, o1 = 0.f, o2 = 0.f, o3 = 0.f;
#pragma unroll 8
        for (int d = 0; d < 32; ++d) { float s = S0[d * 64 + e]; const int c = h * 32 + d;
            s = gam * s + ka[c] * v0; o0 += qa[c] * s; s = gam * s + ka[128 + c] * v1; o1 += qa[128 + c] * s;
            s = gam * s + ka[256 + c] * v2; o2 += qa[256 + c] * s; s = gam * s + ka[384 + c] * v3; o3 += qa[384 + c] * s; S1[d * 64 + e] = s; }
        const float r0 = rsqrtf(wave_sum(o0 * o0) * (1.f / 64.f) + EPS), r1 = rsqrtf(wave_sum(o1 * o1) * (1.f / 64.f) + EPS);
        const float r2 = rsqrtf(wave_sum(o2 * o2) * (1.f / 64.f) + EPS), r3 = rsqrtf(wave_sum(o3 * o3) * (1.f / 64.f) + EPS);
        const int c = h * 64 + e;
        C.y[(R0 + 0) * WMIX + Y_A + c] = f2bf(o0 * r0 * silu_(PR(0, C_ZA + c))); C.y[(R0 + 1) * WMIX + Y_A + c] = f2bf(o1 * r1 * silu_(PR(1, C_ZA + c)));
        C.y[(R0 + 2) * WMIX + Y_A + c] = f2bf(o2 * r2 * silu_(PR(2, C_ZA + c))); C.y[(R0 + 3) * WMIX + Y_A + c] = f2bf(o3 * r3 * silu_(PR(3, C_ZA + c)));
    } else { const int h = w - 4, e = lane;
        const float* S0 = P.state_hgrn + (((size_t)l * 128 + sb) * 4 + h) * 4096; float* S1 = P.out + O_HGRNS + (((size_t)l * 128 + sb) * 4 + h) * 4096;
        const float v0 = PR(0, C_ID + h * 64 + e), v1 = PR(1, C_ID + h * 64 + e), v2 = PR(2, C_ID + h * 64 + e), v3 = PR(3, C_ID + h * 64 + e);
        float o0 = 0.f, o1 = 0.f, o2 = 0.f, o3 = 0.f;
#pragma unroll 8
        for (int d = 0; d < 64; ++d) { float s = S0[d * 64 + e]; const int c = h * 64 + d;
            float f = fd[c]; s = f * s + (1.f - f) * v0; o0 += qd[c] * s; f = fd[256 + c]; s = f * s + (1.f - f) * v1; o1 += qd[256 + c] * s;
            f = fd[512 + c]; s = f * s + (1.f - f) * v2; o2 += qd[512 + c] * s; f = fd[768 + c]; s = f * s + (1.f - f) * v3; o3 += qd[768 + c] * s; S1[d * 64 + e] = s; }
        const float r0 = rsqrtf(wave_sum(o0 * o0) * (1.f / 64.f) + EPS), r1 = rsqrtf(wave_sum(o1 * o1) * (1.f / 64.f) + EPS);
        const float r2 = rsqrtf(wave_sum(o2 * o2) * (1.f / 64.f) + EPS), r3 = rsqrtf(wave_sum(o3 * o3) * (1.f / 64.f) + EPS);
        const int c = h * 64 + e; const float gs = P.g_hgrn[l * 256 + c];
        C.y[(R0 + 0) * WMIX + Y_D + c] = f2bf(o0 * r0 * gs * silu_(PR(0, C_ZD + c))); C.y[(R0 + 1) * WMIX + Y_D + c] = f2bf(o1 * r1 * gs * silu_(PR(1, C_ZD + c)));
        C.y[(R0 + 2) * WMIX + Y_D + c] = f2bf(o2 * r2 * gs * silu_(PR(2, C_ZD + c))); C.y[(R0 + 3) * WMIX + Y_D + c] = f2bf(o3 * r3 * gs * silu_(PR(3, C_ZD + c)));
    }
    { const int c = tid & 255, tp = tid >> 8, g = c >> 6, dout = c & 63;
      float a0 = 0.f, a1 = 0.f; const float* wp = P.w_pool + ((size_t)l * 4 + g) * 4096 + dout;
#pragma unroll 8
      for (int cin = 0; cin < 64; ++cin) { const float wv = wp[cin * 64]; a0 += pl[(2 * tp) * 256 + g * 64 + cin] * wv; a1 += pl[(2 * tp + 1) * 256 + g * 64 + cin] * wv; }
      const float sc = P.pool_scale[l * 256 + c];
      C.y[(R0 + 2 * tp) * WMIX + Y_C + c] = f2bf(a0 * sc * silu_(PR(2 * tp, C_ZC + c)));
      C.y[(R0 + 2 * tp + 1) * WMIX + Y_C + c] = f2bf(a1 * sc * silu_(PR(2 * tp + 1, C_ZC + c))); }
    for (int i = tid; i < 4224; i += NTHREADS) { const int kh = i / 2112, rem = i - kh * 2112, r16 = rem / 132, kk = rem - r16 * 132, g = r16 >> 2, t = r16 & 3, h = kh * 4 + g;
        const bool ok = kk < 128 ? (kk >= t) : (kk - 128 <= t);
        const float* kp = kk < 128 ? kv + (kk * 2 + kh) * 65 : kn + (kk - 128) * 128 + kh * 64;
        const float* qp = qbq + t * 512 + h * 64;
        float s = 0.f;
#pragma unroll 16
        for (int d = 0; d < 64; ++d) s += qp[d] * kp[d];
        ps[(h * 4 + t) * 136 + kk] = ok ? s : -1e30f; }
    __syncthreads();
    { const int h = w; const float sink = P.attn_sink[l * 8 + h];
      for (int t = 0; t < 4; ++t) { float* pr_ = ps + (h * 4 + t) * 136;
          const float s0 = pr_[lane], s1 = pr_[lane + 64], s2 = lane < 4 ? pr_[lane + 128] : -1e30f;
          float m = fmaxf(fmaxf(s0, s1), s2); m = fmaxf(m, __shfl_xor(m, 32)); m = fmaxf(m, __shfl_xor(m, 16)); m = fmaxf(m, __shfl_xor(m, 8)); m = fmaxf(m, __shfl_xor(m, 4)); m = fmaxf(m, __shfl_xor(m, 2)); m = fmaxf(m, __shfl_xor(m, 1));
          m = fmaxf(m, sink);
          const float p0 = __expf(s0 - m), p1 = __expf(s1 - m), p2 = lane < 4 ? __expf(s2 - m) : 0.f;
          const float inv = 1.f / (wave_sum(p0 + p1 + p2) + __expf(sink - m));
          pr_[lane] = p0 * inv; pr_[lane + 64] = p1 * inv; if (lane < 4) pr_[lane + 128] = p2 * inv; } }
    __syncthreads();
    { const float* vc = P.cache_v + ((size_t)l * 128 + sb) * 16384; float* vo = P.out + O_VS + ((size_t)l * 128 + sb) * 16384;
      for (int i = tid; i < 4096; i += NTHREADS) { const float4 v = ((const float4*)vc)[i]; const int e = i * 4, wq = e >> 7, r = e & 127, kh = r >> 6, d = r & 63;
          float* dst = kv + (wq * 2 + kh) * 65 + d; dst[0] = v.x; dst[1] = v.y; dst[2] = v.z; dst[3] = v.w;
          if (wq >= 4) ((float4*)vo)[i - 128] = v; } }
    __syncthreads();
    { const int h = w, kh = h >> 2, e = lane;
      float o0 = 0.f, o1 = 0.f, o2 = 0.f, o3 = 0.f; const float* p0 = ps + (h * 4) * 136;
      for (int kk = 0; kk < 128; ++kk) { const float v = kv[(kk * 2 + kh) * 65 + e]; o0 += p0[kk] * v; o1 += p0[136 + kk] * v; o2 += p0[272 + kk] * v; o3 += p0[408 + kk] * v; }
      for (int kk = 128; kk < 132; ++kk) { const float v = PR(kk - 128, C_VB + kh * 64 + e); o0 += p0[kk] * v; o1 += p0[136 + kk] * v; o2 += p0[272 + kk] * v; o3 += p0[408 + kk] * v; }
      const int c = h * 64 + e;
      C.y[(R0 + 0) * WMIX + Y_B + c] = f2bf(o0 * silu_(PR(0, C_ZB + c))); C.y[(R0 + 1) * WMIX + Y_B + c] = f2bf(o1 * silu_(PR(1, C_ZB + c)));
      C.y[(R0 + 2) * WMIX + Y_B + c] = f2bf(o2 * silu_(PR(2, C_ZB + c))); C.y[(R0 + 3) * WMIX + Y_B + c] = f2bf(o3 * silu_(PR(3, C_ZB + c))); }
#undef PR
    __syncthreads();
}


__device__ __forceinline__ void sample_branch_tile(Ctx& C, int l, int tile) {
    const int lane = C.lane, w = C.w, fr = lane & 15, fq = lane >> 4;
    const int r0 = M_P + (tile >> 4) * 32 + (w >> 2) * 16, c0 = (tile & 15) * 64 + (w & 3) * 16;
    const bf16_t* A = C.y + (size_t)(r0 + fr) * WMIX + fq * 8;
    const bf16_t* B = C.wb + (size_t)l * DM * WMIX + (size_t)(c0 + fr) * WMIX + fq * 8;
    f32x4 acc = {0.f, 0.f, 0.f, 0.f};
#pragma unroll
    for (int br = 0; br < 4; ++br) {
        const int k0 = br == 0 ? 0 : (br == 1 ? 256 : (br == 2 ? 768 : 1024)), k1 = br == 0 ? 256 : (br == 1 ? 768 : (br == 2 ? 1024 : 1280));
#pragma unroll 8
        for (int k = k0; k < k1; k += 32) acc = mfma16(*(const bf16x8*)(A + k), *(const bf16x8*)(B + k), acc);
#pragma unroll
        for (int j = 0; j < 4; ++j) { const bf16_t* gp = C.gates + (size_t)(r0 + fq * 4 + j) * NGATE + br * 1024 + c0 + fr;
            float sc = bf2f(gp[0]); if (br < 3) sc *= __builtin_amdgcn_rcpf(bf2f(gp[1024])); acc[j] *= sc; }
    }
#pragma unroll
    for (int j = 0; j < 4; ++j) C.mb[(size_t)(r0 + fq * 4 + j) * DM + c0 + fr] = f2bf(acc[j]);
}
__device__ __forceinline__ void sample_out_tile(Ctx& C, int l, int tile) {
    const int lane = C.lane, w = C.w, fr = lane & 15, fq = lane >> 4;
    const int r0 = M_P + (tile >> 4) * 32 + (w >> 2) * 16, c0 = (tile & 15) * 64 + (w & 3) * 16;
    const bf16_t* A = C.mb + (size_t)(r0 + fr) * DM + fq * 8;
    const bf16_t* B = C.wout + (size_t)l * DM * DM + (size_t)(c0 + fr) * DM + fq * 8;
    f32x4 acc = {0.f, 0.f, 0.f, 0.f};
#pragma unroll 8
    for (int k = 0; k < DM; k += 32) acc = mfma16(*(const bf16x8*)(A + k), *(const bf16x8*)(B + k), acc);
#pragma unroll
    for (int j = 0; j < 4; ++j) C.of[(size_t)(r0 + fq * 4 + j) * DM + c0 + fr] = acc[j];
}

__device__ __forceinline__ void phase_scan(const Params& P, Ctx& C, int l) {
    for (int g = C.bx * NTHREADS + C.tid; g < 49152; g += C.G * NTHREADS) {
        if (g < 16384) { const int b = g >> 13, r = g & 8191, h = r >> 11, de = r & 2047;
            float* base = C.kva + ((size_t)(b * 128) * 4 + h) * 2048 + de;
            const float dec = __expf(64.f * log1pf(-exp2f(-5.f - (float)h)));
            float S = 0.f;
            for (int n0 = 0; n0 < 128; n0 += 16) { float v[16];
#pragma unroll
                for (int i = 0; i < 16; ++i) v[i] = base[(size_t)(n0 + i) * 8192];
#pragma unroll
                for (int i = 0; i < 16; ++i) { base[(size_t)(n0 + i) * 8192] = S; S = dec * S + v[i]; } }
            P.out[O_RETP + (((size_t)l * 2 + b) * 4 + h) * 2048 + de] = S;
        } else { const int gg = g - 16384, b = gg >> 14, r = gg & 16383, h = r >> 12, de = r & 4095, d = de >> 6;
            float* base = C.kvd + ((size_t)(b * 128) * 4 + h) * 4096 + de;
            const float* dp = C.decd + (size_t)(b * 128) * 256 + h * 64 + d;
            float S = 0.f;
            for (int n0 = 0; n0 < 128; n0 += 16) { float v[16], dc[16];
#pragma unroll
                for (int i = 0; i < 16; ++i) { v[i] = base[(size_t)(n0 + i) * 16384]; dc[i] = dp[(n0 + i) * 256]; }
#pragma unroll
                for (int i = 0; i < 16; ++i) { base[(size_t)(n0 + i) * 16384] = S; S = dc[i] * S + v[i]; } }
            P.out[O_HGRNP + (((size_t)l * 2 + b) * 4 + h) * 4096 + de] = S;
        }
    }
}

__device__ __forceinline__ void phase_finalize(const Params& P, Ctx& C, int l) {
    const int lane = C.lane;
    for (int row = C.bx * 8 + C.w; row < M_TOT; row += C.G * 8) {
        const float4* o4 = (const float4*)(C.of + (size_t)row * DM); float4* x4 = (float4*)(P.out + (size_t)row * DM);
        float4 o[4], x[4]; float ss = 0.f;
#pragma unroll
        for (int i = 0; i < 4; ++i) { o[i] = o4[lane + 64 * i]; x[i] = x4[lane + 64 * i]; ss += o[i].x * o[i].x + o[i].y * o[i].y + o[i].z * o[i].z + o[i].w * o[i].w; }
        ss = wave_sum(ss); const float r = rsqrtf(ss * (1.f / DM) + EPS);
        float s2 = 0.f;
#pragma unroll
        for (int i = 0; i < 4; ++i) { const float4 g = ((const float4*)(P.g_post + l * DM))[lane + 64 * i];
            x[i].x += o[i].x * r * g.x; x[i].y += o[i].y * r * g.y; x[i].z += o[i].z * r * g.z; x[i].w += o[i].w * r * g.w;
            x4[lane + 64 * i] = x[i]; s2 += x[i].x * x[i].x + x[i].y * x[i].y + x[i].z * x[i].z + x[i].w * x[i].w; }
        if (l < 3) { s2 = wave_sum(s2); const float r2 = rsqrtf(s2 * (1.f / DM) + EPS);
#pragma unroll
            for (int i = 0; i < 4; ++i) { const float4 g = ((const float4*)(P.g_pre + (l + 1) * DM))[lane + 64 * i];
                uint2 ov; ov.x = pk2(x[i].x * r2 * g.x, x[i].y * r2 * g.y); ov.y = pk2(x[i].z * r2 * g.z, x[i].w * r2 * g.w);
                ((uint2*)(C.h + (size_t)row * DM))[lane + 64 * i] = ov; } }
    }
}

#ifndef PH_MASK
#define PH_MASK 2047
#endif
__global__ void __launch_bounds__(NTHREADS, 2) fwd_kernel(Params P) {
    extern __shared__ __attribute__((aligned(16))) unsigned char lds[];
    LAS unsigned char* ldsl = (LAS unsigned char*)lds;
    volatile LAS unsigned* bst = (volatile LAS unsigned*)(ldsl + LDS_BYTES - 16);
    if (threadIdx.x == 0) { bst[0] = 0u; bst[1] = 0u; if (P.coop) (void)xb_add((unsigned*)P.ws + XB_XCNT(xb_xcc_id()), 1u); }
    __syncthreads();

    for (int ph = P.ph_lo; ph < P.ph_hi; ++ph) {
        int nrep = 1;
#ifdef DUP_SP
        if (ph > 0 && ((ph - 1) % 7) == DUP_SP) nrep = 2;
#endif
        for (int rep = 0; rep < nrep; ++rep) {
        if (rep) xcd_barrier((unsigned*)P.ws, bst);
        int tid_ = threadIdx.x, bx = blockIdx.x, G_ = gridDim.x; __attribute__((address_space(1))) unsigned char* wsg = (__attribute__((address_space(1))) unsigned char*)P.ws;
        asm volatile("" : "+v"(tid_)); asm volatile("" : "+s"(bx)); asm volatile("" : "+s"(G_)); asm volatile("" : "+s"(wsg));
        unsigned char* ws = (unsigned char*)wsg;
        Ctx C;
        C.win = (bf16_t*)(ws + WS_WIN); C.wb = (bf16_t*)(ws + WS_WB); C.wout = (bf16_t*)(ws + WS_WOUT); C.h = (bf16_t*)(ws + WS_H); C.mb = (bf16_t*)(ws + WS_H);
        C.proj = (bf16_t*)(ws + WS_PROJ); C.mf = (float*)(ws + WS_PROJ); C.gates = (bf16_t*)(ws + WS_GATES); C.of = (float*)(ws + WS_GATES); C.y = (bf16_t*)(ws + WS_Y);
        C.kva = (float*)(ws + WS_KVA); C.kvd = (float*)(ws + WS_KVD); C.decd = (float*)(ws + WS_DECD);
        C.ropeAc = (float*)(ws + WS_ROPEA); C.ropeAs = C.ropeAc + NPOS * 16; C.ropeBc = (float*)(ws + WS_ROPEB); C.ropeBs = C.ropeBc + NPOS * 8; C.lbt = (float*)(ws + WS_LB);
        C.bx = bx; C.tid = tid_; C.lane = tid_ & 63; C.w = __builtin_amdgcn_readfirstlane(tid_ >> 6); C.G = G_;
        const int vcu = (C.G % 8 == 0) ? (bx % 8) * (C.G / 8) + bx / 8 : bx;
        if (ph == 0) { if (PH_MASK & 1) phase_prologue(P, C, lds); }
        else {
            const int l = (ph - 1) / 7, sp = (ph - 1) % 7;
            if (sp == 0) {
              if (PH_MASK & 2) {
                pg8::Gemm g{C.h, C.win + (size_t)l * DIN * DM, DM, DM}; pg8::StaticOrder S; S.init(M_TOT, DIN, DM, C.G, bx);
                pg8::EpiProj E{C.proj, C.gates};
                pg8::gemm_phase<pg8::EpiProj, pg8::StaticOrder>(ldsl, g, S, E, C.tid); }
            } else if (sp == 1) {
                for (int u = bx; u < 1280; u += C.G) {
                    if (u < 256) { if (PH_MASK & 4) attn_prompt_unit(P, C, l, u >> 7, (u & 127) >> 1, u & 1, lds); }
                    else if (u < 512) { if (PH_MASK & 32) lin_chunk<false, true>(P, C, l, (u - 256) >> 7, (u - 256) & 127, lds); }
                    else if (u < 768) { if (PH_MASK & 32) lin_chunk<true, true>(P, C, l, (u - 512) >> 7, (u - 512) & 127, lds); }
                    else { const int v = (u - 768) & 255, second = (u - 768) >> 8;
                        if (v < 128) { if (!second) { if (PH_MASK & 8) sample_unit(P, C, l, v, lds); } }
                        else { if (PH_MASK & 16) pool_prompt_unit(P, C, l, 2 * (v - 128) + second, lds); } }
                }
            } else if (sp == 2) { if (PH_MASK & 64) phase_scan(P, C, l); }
            else if (sp == 3) {
                for (int u = bx; u < 512; u += C.G) {
                    if (u < 256) { if (PH_MASK & 128) lin_chunk<false, false>(P, C, l, u >> 7, u & 127, lds); }
                    else { if (PH_MASK & 128) lin_chunk<true, false>(P, C, l, (u - 256) >> 7, (u - 256) & 127, lds); }
                }
            } else if (sp == 4) {
              if (PH_MASK & 256) {
                for (int t = bx; t < 256; t += C.G) sample_branch_tile(C, l, t);
                pg8::Gemm g{C.y, C.wb + (size_t)l * DM * WMIX, WMIX, WMIX}; pg8::BranchOrder S{256, C.G, vcu};
                pg8::EpiBranch E{C.gates, C.mb};
                pg8::gemm_phase<pg8::EpiBranch, pg8::BranchOrder>(ldsl, g, S, E, C.tid); }
            } else if (sp == 5) {
              if (PH_MASK & 512) {
                for (int t = bx; t < 256; t += C.G) sample_out_tile(C, l, t);
                pg8::Gemm g{C.mb, C.wout + (size_t)l * DM * DM, DM, DM}; pg8::TileOrder S{256, C.G, vcu, DM / 64};
                pg8::EpiF32 E{C.of};
                pg8::gemm_phase<pg8::EpiF32, pg8::TileOrder>(ldsl, g, S, E, C.tid); }
            } else { if (PH_MASK & 1024) phase_finalize(P, C, l); }
        }
        }
        if (ph + 1 < P.ph_hi && P.coop) { if (ph == 0) cg::this_grid().sync(); else xcd_barrier((unsigned*)P.ws, bst); }
    }
}

#ifndef N_LAUNCH_MODE
#define N_LAUNCH_MODE 1
#endif
extern "C" void kernel_launch(void* const* d_in, const int* in_sizes, int n_in, void* d_out, int out_size, void* d_ws, size_t ws_size, hipStream_t stream) {
    static int grid = 0;
    if (grid == 0) {
        if (n_in != 17 || (size_t)out_size != O_END || ws_size < WS_END) { fprintf(stderr, "kernel_launch: unexpected sizes n_in %d out %d ws %zu\n", n_in, out_size, ws_size); grid = -1; return; }
        int dev = 0, cus = 0, per_cu = 0;
        hipGetDevice(&dev); hipDeviceGetAttribute(&cus, hipDeviceAttributeMultiprocessorCount, dev);
        if (hipFuncSetAttribute((const void*)fwd_kernel, hipFuncAttributeMaxDynamicSharedMemorySize, LDS_BYTES) != hipSuccess) { fprintf(stderr, "hipFuncSetAttribute failed\n"); grid = -1; return; }
        if (hipOccupancyMaxActiveBlocksPerMultiprocessor(&per_cu, (const void*)fwd_kernel, NTHREADS, LDS_BYTES) != hipSuccess || per_cu < 1) { fprintf(stderr, "occupancy query: %d\n", per_cu); per_cu = 1; }
        (void)hipGetLastError();
        grid = cus * 1;
        if (per_cu < 1) grid = -1;
    }
    if (grid < 0) return;
    Params p{};
    const float* const* in = (const float* const*)d_in;
    p.x_prompt = in[0]; p.x_sample = in[1]; p.state_ret = in[2]; p.cache_k = in[3]; p.cache_v = in[4]; p.state_pool = in[5]; p.state_hgrn = in[6];
    p.w_in = in[7]; p.w_branch = in[8]; p.w_out = in[9]; p.g_pre = in[10]; p.g_post = in[11]; p.attn_sink = in[12]; p.w_pool = in[13];
    p.pool_scale = in[14]; p.g_hgrn = in[15]; p.lower_bounds = in[16];
    p.out = (float*)d_out; p.ws = (unsigned char*)d_ws;
    for (int i = 0; i < 16; ++i) p.invA[i] = pow(10000.0, -(double)i / 16.0);
    for (int i = 0; i < 8; ++i) p.invB[i] = pow(500000.0, -(double)i / 8.0);
    const int NPH = 29;
#if N_LAUNCH_MODE == 1
    (void)hipMemsetAsync(d_ws, 0, 16384, stream);
    p.ph_lo = 0; p.ph_hi = NPH; p.coop = 1; p.pad = 0;
    void* args[] = {&p};
    hipError_t e = hipLaunchCooperativeKernel((const void*)fwd_kernel, dim3(grid), dim3(NTHREADS), args, LDS_BYTES, stream);
    if (e != hipSuccess) fprintf(stderr, "cooperative launch failed: %s (grid %d)\n", hipGetErrorString(e), grid);
#else
    for (int ph = 0; ph < NPH; ++ph) {
        p.ph_lo = ph; p.ph_hi = ph + 1; p.coop = 0; p.pad = 0;
        hipLaunchKernelGGL(fwd_kernel, dim3(grid), dim3(NTHREADS), LDS_BYTES, stream, p);
    }
#endif
}
```

```cpp
#include <hip/hip_runtime.h>
#include <hip/hip_cooperative_groups.h>
#include <cstdio>
#include <cstdint>
#include <cmath>
namespace cg = cooperative_groups;

#define LAS __attribute__((address_space(3)))
typedef unsigned short bf16_t;
typedef short bf16x8 __attribute__((ext_vector_type(8)));
typedef float f32x4 __attribute__((ext_vector_type(4)));
typedef unsigned u32x4 __attribute__((ext_vector_type(4)));

constexpr int M_TOT = 16896, M_P = 16384, DM = 1024, DIN = 7680, NPROJ = 3584, NGATE = 4096, WMIX = 1280;
constexpr int C_QA = 0, C_KA = 128, C_VA = 256, C_ZA = 512, C_QB = 768, C_KB = 1280, C_VB = 1408, C_ZB = 1536, C_UC = 2048, C_ZC = 2304,
              C_QD = 2560, C_FD = 2816, C_ID = 3072, C_ZD = 3328;
constexpr int Y_A = 0, Y_B = 256, Y_C = 768, Y_D = 1024;
constexpr size_t O_YP = 0, O_YS = 16777216, O_RETP = 17301504, O_KP = 17367040, O_VP = 17498112, O_POOLP = 17629184, O_HGRNP = 17659904,
                 O_RETS = 17790976, O_KS = 21985280, O_VS = 30373888, O_POOLS = 38762496, O_HGRNS = 40728576, O_END = 49117184;
constexpr float EPS = 1e-6f;
constexpr int NPOS = 8196;

constexpr size_t MiB = 1u << 20;
constexpr size_t WS_ROPEA = 1 * MiB;
constexpr size_t WS_ROPEB = 3 * MiB;
constexpr size_t WS_LB = 3 * MiB + 768 * 1024;
constexpr size_t WS_WIN = 4 * MiB;
constexpr size_t WS_WB = 64 * MiB;
constexpr size_t WS_WOUT = 74 * MiB;
constexpr size_t WS_H = 82 * MiB;
constexpr size_t WS_PROJ = 115 * MiB;
constexpr size_t WS_GATES = 231 * MiB;
constexpr size_t WS_Y = 363 * MiB;
constexpr size_t WS_KVA = 405 * MiB;
constexpr size_t WS_KVD = 413 * MiB;
constexpr size_t WS_DECD = 429 * MiB;
constexpr size_t WS_END = 430 * MiB;

constexpr int LDS_BYTES = 147456;
constexpr int NTHREADS = 512;

struct Params {
    const float* x_prompt; const float* x_sample; const float* state_ret; const float* cache_k; const float* cache_v; const float* state_pool; const float* state_hgrn;
    const float* w_in; const float* w_branch; const float* w_out; const float* g_pre; const float* g_post; const float* attn_sink; const float* w_pool;
    const float* pool_scale; const float* g_hgrn; const float* lower_bounds;
    float* out; unsigned char* ws;
    double invA[16]; double invB[8];
    int ph_lo, ph_hi, coop, pad;
};

__device__ __forceinline__ float bf2f(bf16_t v) { return __uint_as_float(((unsigned)v) << 16); }
__device__ __forceinline__ bf16_t f2bf(float f) { unsigned u = __float_as_uint(f); return (bf16_t)((u + 0x7fffu + ((u >> 16) & 1u)) >> 16); }
__device__ __forceinline__ unsigned pk2(float lo, float hi) { return (unsigned)f2bf(lo) | ((unsigned)f2bf(hi) << 16); }
__device__ __forceinline__ float lo16(unsigned u) { return __uint_as_float(u << 16); }
__device__ __forceinline__ float hi16(unsigned u) { return __uint_as_float(u & 0xffff0000u); }
__device__ __forceinline__ float sigmoid_(float x) { return 1.f / (1.f + __expf(-x)); }
__device__ __forceinline__ float silu_(float x) { return x / (1.f + __expf(-x)); }
__device__ __forceinline__ float wave_sum(float v) {
    v += __shfl_xor(v, 32); v += __shfl_xor(v, 16); v += __shfl_xor(v, 8); v += __shfl_xor(v, 4); v += __shfl_xor(v, 2); v += __shfl_xor(v, 1); return v;
}
__device__ __forceinline__ float quad16_sum(float v) { v += __shfl_xor(v, 8); v += __shfl_xor(v, 4); v += __shfl_xor(v, 2); v += __shfl_xor(v, 1); return v; }
__device__ __forceinline__ float quad16_max(float v) { v = fmaxf(v, __shfl_xor(v, 8)); v = fmaxf(v, __shfl_xor(v, 4)); v = fmaxf(v, __shfl_xor(v, 2)); v = fmaxf(v, __shfl_xor(v, 1)); return v; }
__device__ __forceinline__ f32x4 mfma16(bf16x8 a, bf16x8 b, f32x4 c) { return __builtin_amdgcn_mfma_f32_16x16x32_bf16(a, b, c, 0, 0, 0); }
__device__ __forceinline__ f32x4 mma_tile(const bf16_t* As, int lda, const bf16_t* Bs, int ldb, int K, f32x4 acc, int lane) {
    const bf16_t* ap = As + (lane & 15) * lda + (lane >> 4) * 8;
    const bf16_t* bp = Bs + (lane & 15) * ldb + (lane >> 4) * 8;
    for (int k = 0; k < K; k += 32) acc = mfma16(*(const bf16x8*)(ap + k), *(const bf16x8*)(bp + k), acc);
    return acc;
}

namespace pg8 {
constexpr int BM = 256, BK = 64, HALF = 128, HTB = HALF * BK * 2, STAGE_BYTES = 8 * HTB, NXCD = 8, WGM = 8;
__host__ __device__ __forceinline__ int lds_byte(int r, int c) { const int st = (r >> 4) * 2 + (c >> 5), rr = r & 15, cc = c & 31, ob = rr * 64 + cc * 2; return st * 1024 + (ob ^ (((ob >> 9) & 1) << 5)); }
__host__ __device__ __forceinline__ void stage_rc(int b, int& R, int& C) { const int st = b / 1024, sb = b % 1024, swz = sb ^ (((sb >> 9) & 1) << 5); R = (st >> 1) * 16 + swz / 64; C = (st & 1) * 32 + (swz % 64) / 2; }
__host__ __device__ __forceinline__ int perm32(int rho) { const int n = rho >> 4, i = rho & 15; return 8 * (i >> 2) + 4 * n + (i & 3); }

struct Unit { int pm, pn, k0, nt, br; };
struct Gemm { const bf16_t* A; const bf16_t* Bt; int lda, ldb; };

struct StaticOrder {
    int nM, nN, nwg, G, c, nt;
    __device__ void init(int M, int N, int K, int G_, int c_) { nM = M / BM; nN = N / BM; nwg = nM * nN; G = G_; c = c_; nt = K / BK; }
    __device__ bool next(int i, Unit& u) const {
        const long L = (long)i * G + c; if (L >= nwg) return false;
        int wgid = (int)L; { const int q = nwg / NXCD, r = nwg % NXCD, xcd = wgid % NXCD, off = wgid / NXCD; wgid = (xcd < r ? xcd * (q + 1) : r * (q + 1) + (xcd - r) * q) + off; }
        const int nig = WGM * nN, gid = wgid / nig, fm = gid * WGM, gsz = (nM - fm) < WGM ? (nM - fm) : WGM;
        u.pm = fm + ((wgid % nig) % gsz); u.pn = (wgid % nig) / gsz; u.k0 = 0; u.nt = nt; u.br = 0; return true;
    }
};
struct TileOrder {
    int ntiles, G, c, nt;
    __device__ bool next(int i, Unit& u) const { const int t = i * G + c; if (t >= ntiles) return false; u.pm = t >> 2; u.pn = t & 3; u.k0 = 0; u.nt = nt; u.br = 0; return true; }
};
struct BranchOrder {
    int ntiles, G, c;
    __device__ bool next(int i, Unit& u) const {
        const int t = (i >> 2) * G + c; if (t >= ntiles) return false; const int br = i & 3;
        u.pm = t >> 2; u.pn = t & 3; u.br = br; u.k0 = br == 0 ? 0 : (br == 1 ? 256 : (br == 2 ? 768 : 1024)); u.nt = br == 1 ? 8 : 4; return true;
    }
};

struct EpiProj {
    static __device__ __forceinline__ bool reset(const Unit&) { return true; }
    bf16_t* proj; bf16_t* gates;
    template <bool ISG> __device__ __forceinline__ void body(f32x4 (&acc)[2][2][4][2], bf16_t* base, int ld) const {
#pragma unroll
        for (int ai = 0; ai < 2; ++ai)
#pragma unroll
            for (int m = 0; m < 4; ++m) { bf16_t* rowp = base + (size_t)(ai * HALF + m * 16) * ld;
#pragma unroll
                for (int bj = 0; bj < 2; ++bj) { f32x4 v0 = acc[ai][bj][m][0], v1 = acc[ai][bj][m][1];
                    if (ISG) {
#pragma unroll
                        for (int i = 0; i < 4; ++i) { v0[i] = fmaxf(sigmoid_(v0[i]), 1e-6f); v1[i] = fmaxf(sigmoid_(v1[i]), 1e-6f); } }
                    u32x4 w; w.x = pk2(v0[0], v0[1]); w.y = pk2(v0[2], v0[3]); w.z = pk2(v1[0], v1[1]); w.w = pk2(v1[2], v1[3]);
                    *(u32x4*)(rowp + bj * HALF) = w; } }
    }
    __device__ __forceinline__ void operator()(f32x4 (&acc)[2][2][4][2], const Unit& u, int wr, int wc, int fr, int fq) const {
        const int row0 = u.pm * BM + wr * 64 + fr;
        if (u.pn >= 14) body<true>(acc, gates + (size_t)row0 * NGATE + (u.pn - 14) * BM + wc * 32 + 8 * fq, NGATE);
        else body<false>(acc, proj + (size_t)row0 * NPROJ + u.pn * BM + wc * 32 + 8 * fq, NPROJ);
    }
};
struct EpiBranch {
    static __device__ __forceinline__ bool reset(const Unit& u) { return u.br == 3; }
    const bf16_t* gates; bf16_t* mb;
    static __device__ __forceinline__ void scale8(f32x4& v0, f32x4& v1, const u32x4 g) {
        v0[0] *= lo16(g.x); v0[1] *= hi16(g.x); v0[2] *= lo16(g.y); v0[3] *= hi16(g.y); v1[0] *= lo16(g.z); v1[1] *= hi16(g.z); v1[2] *= lo16(g.w); v1[3] *= hi16(g.w); }
    static __device__ __forceinline__ void rscale8(f32x4& v0, f32x4& v1, const u32x4 g) {
        v0[0] *= __builtin_amdgcn_rcpf(lo16(g.x)); v0[1] *= __builtin_amdgcn_rcpf(hi16(g.x)); v0[2] *= __builtin_amdgcn_rcpf(lo16(g.y)); v0[3] *= __builtin_amdgcn_rcpf(hi16(g.y));
        v1[0] *= __builtin_amdgcn_rcpf(lo16(g.z)); v1[1] *= __builtin_amdgcn_rcpf(hi16(g.z)); v1[2] *= __builtin_amdgcn_rcpf(lo16(g.w)); v1[3] *= __builtin_amdgcn_rcpf(hi16(g.w)); }
    __device__ __forceinline__ void operator()(f32x4 (&acc)[2][2][4][2], const Unit& u, int wr, int wc, int fr, int fq) const {
        const int row0 = u.pm * BM + wr * 64 + fr, col0 = u.pn * BM + wc * 32 + 8 * fq;
        const bf16_t* gbase = gates + (size_t)row0 * NGATE + u.br * 1024 + col0;
        if (u.br < 3) {
#pragma unroll
            for (int ai = 0; ai < 2; ++ai)
#pragma unroll
                for (int mp = 0; mp < 2; ++mp) {
                    u32x4 g[2][2], gn[2][2];
#pragma unroll
                    for (int mm = 0; mm < 2; ++mm)
#pragma unroll
                        for (int bj = 0; bj < 2; ++bj) { const bf16_t* p = gbase + (size_t)(ai * HALF + (mp * 2 + mm) * 16) * NGATE + bj * HALF;
                            g[mm][bj] = *(const u32x4*)p; gn[mm][bj] = *(const u32x4*)(p + 1024); }
#pragma unroll
                    for (int mm = 0; mm < 2; ++mm)
#pragma unroll
                        for (int bj = 0; bj < 2; ++bj) { const int m = mp * 2 + mm;
                            scale8(acc[ai][bj][m][0], acc[ai][bj][m][1], g[mm][bj]); rscale8(acc[ai][bj][m][0], acc[ai][bj][m][1], gn[mm][bj]); }
                }
        } else {
#pragma unroll
            for (int ai = 0; ai < 2; ++ai)
#pragma unroll
                for (int mp = 0; mp < 2; ++mp) {
                    u32x4 g[2][2];
#pragma unroll
                    for (int mm = 0; mm < 2; ++mm)
#pragma unroll
                        for (int bj = 0; bj < 2; ++bj) g[mm][bj] = *(const u32x4*)(gbase + (size_t)(ai * HALF + (mp * 2 + mm) * 16) * NGATE + bj * HALF);
#pragma unroll
                    for (int mm = 0; mm < 2; ++mm)
#pragma unroll
                        for (int bj = 0; bj < 2; ++bj) { const int m = mp * 2 + mm;
                            f32x4 v0 = acc[ai][bj][m][0], v1 = acc[ai][bj][m][1]; scale8(v0, v1, g[mm][bj]);
                            u32x4 w; w.x = pk2(v0[0], v0[1]); w.y = pk2(v0[2], v0[3]); w.z = pk2(v1[0], v1[1]); w.w = pk2(v1[2], v1[3]);
                            *(u32x4*)(mb + (size_t)(row0 + ai * HALF + m * 16) * DM + col0 + bj * HALF) = w; }
                }
        }
    }
};
struct EpiF32 {
    static __device__ __forceinline__ bool reset(const Unit&) { return true; }
    float* o;
    __device__ __forceinline__ void operator()(f32x4 (&acc)[2][2][4][2], const Unit& u, int wr, int wc, int fr, int fq) const {
        const int row0 = u.pm * BM + wr * 64 + fr, col0 = u.pn * BM + wc * 32 + 8 * fq;
#pragma unroll
        for (int ai = 0; ai < 2; ++ai)
#pragma unroll
            for (int m = 0; m < 4; ++m) { float* rowp = o + (size_t)(row0 + ai * HALF + m * 16) * DM + col0;
#pragma unroll
                for (int bj = 0; bj < 2; ++bj) { *(f32x4*)(rowp + bj * HALF) = acc[ai][bj][m][0]; *(f32x4*)(rowp + bj * HALF + 4) = acc[ai][bj][m][1]; } }
    }
};

template <class Epi, class Sched>
__device__ __forceinline__ void gemm_phase(LAS unsigned char* lds, const Gemm g, const Sched& S, const Epi& E, const int tid) {
    const int wid = __builtin_amdgcn_readfirstlane(tid >> 6), lane = tid & 63, wr = wid >> 2, wc = wid & 3, fr = lane & 15, fq = lane >> 4;
    unsigned voffA[2], voffB[2];
#pragma unroll
    for (int i = 0; i < 2; ++i) { int R, C; stage_rc(tid * 16 + i * 8192, R, C); const int Rb = (R & ~31) + perm32(R & 31);
        voffA[i] = (unsigned)(R * g.lda + C) * 2u; voffB[i] = (unsigned)(Rb * g.ldb + C) * 2u; }
    const size_t kstep = (size_t)(BK * 2);
    const size_t hstepA = (size_t)HALF * g.lda * 2, hstepB = (size_t)HALF * g.ldb * 2;
    const size_t tstepA = 2 * hstepA, tstepB = 2 * hstepB;
    const unsigned ldsw = (unsigned)wid * 1024u;
    const int aoff = lds_byte(wr * 64 + fr, fq * 8), boff = lds_byte(wc * 32 + fr, fq * 8);
#define PG8_SA(b, h) (((b) * 2 + (h)) * HTB)
#define PG8_SB(b, h) ((4 + (b) * 2 + (h)) * HTB)
#define PG8_STAGE(bufoff, gbase, voff) do { _Pragma("unroll") for (int _i = 0; _i < 2; ++_i) \
        __builtin_amdgcn_global_load_lds((const unsigned*)((const char*)(gbase) + (voff)[_i]), (LAS unsigned*)(lds + (bufoff) + ldsw + _i * 8192), 16, 0, 0); } while (0)
#define PG8_LDA(dst, b, h) do { _Pragma("unroll") for (int m = 0; m < 4; ++m) _Pragma("unroll") for (int k = 0; k < 2; ++k) dst[m][k] = *(const LAS bf16x8*)(lds + PG8_SA(b, h) + aoff + m * 2048 + k * 1024); } while (0)
#define PG8_LDB(dst, b, h) do { _Pragma("unroll") for (int n = 0; n < 2; ++n) _Pragma("unroll") for (int k = 0; k < 2; ++k) dst[n][k] = *(const LAS bf16x8*)(lds + PG8_SB(b, h) + boff + n * 2048 + k * 1024); } while (0)
#define PG8_MMA(ai, bj, At, Bt) do { __builtin_amdgcn_s_setprio(1); _Pragma("unroll") for (int m = 0; m < 4; ++m) _Pragma("unroll") for (int n = 0; n < 2; ++n) _Pragma("unroll") for (int k = 0; k < 2; ++k) \
        acc[ai][bj][m][n] = __builtin_amdgcn_mfma_f32_16x16x32_bf16(Bt[n][k], At[m][k], acc[ai][bj][m][n], 0, 0, 0); __builtin_amdgcn_s_setprio(0); } while (0)
#define PG8_WAIT_V(n) asm volatile("s_waitcnt vmcnt(" #n ")" ::: "memory")
#define PG8_WAIT_L(n) asm volatile("s_waitcnt lgkmcnt(" #n ")" ::: "memory")
#define PG8_BAR __builtin_amdgcn_s_barrier()
#define PG8_SCHED __builtin_amdgcn_sched_barrier(0)
    Unit cur, nxt; int ui = 0;
    if (!S.next(0, cur)) return;
    f32x4 acc[2][2][4][2];
#pragma unroll
    for (int a = 0; a < 2; ++a)
#pragma unroll
        for (int b = 0; b < 2; ++b)
#pragma unroll
            for (int m = 0; m < 4; ++m)
#pragma unroll
                for (int n = 0; n < 2; ++n) acc[a][b][m][n] = (f32x4){0.f, 0.f, 0.f, 0.f};
    bf16x8 At[4][2], B0[2][2], B1[2][2];
    const char* cA = (const char*)g.A + (size_t)cur.pm * tstepA + (size_t)cur.k0 * 2; const char* cB = (const char*)g.Bt + (size_t)cur.pn * tstepB + (size_t)cur.k0 * 2;
    PG8_STAGE(PG8_SB(0, 0), cB, voffB); PG8_STAGE(PG8_SB(0, 1), cB + hstepB, voffB); PG8_STAGE(PG8_SA(0, 0), cA, voffA); PG8_STAGE(PG8_SA(0, 1), cA + hstepA, voffA);
    if (wr == 1) PG8_BAR;
    PG8_WAIT_V(2); PG8_BAR;
    PG8_STAGE(PG8_SB(1, 0), cB + kstep, voffB); PG8_STAGE(PG8_SA(1, 0), cA + kstep, voffA); PG8_STAGE(PG8_SB(1, 1), cB + hstepB + kstep, voffB);
    PG8_WAIT_V(6); PG8_BAR;
    for (;;) {
        const bool has_next = S.next(ui + 1, nxt);
        const char* nA = has_next ? (const char*)g.A + (size_t)nxt.pm * tstepA + (size_t)nxt.k0 * 2 : cA;
        const char* nB = has_next ? (const char*)g.Bt + (size_t)nxt.pn * tstepB + (size_t)nxt.k0 * 2 : cB;
        const int nt = cur.nt;
        for (int t = 0; t < nt; t += 2) {
            const bool last = (t == nt - 2);
            const char* a1 = cA + (size_t)(t + 1) * kstep;
            const char* a2 = last ? nA : cA + (size_t)(t + 2) * kstep; const char* b2 = last ? nB : cB + (size_t)(t + 2) * kstep;
            const char* a3 = a2 + kstep; const char* b3 = b2 + kstep;
            PG8_LDB(B0, 0, 0); PG8_LDB(B1, 0, 1); PG8_SCHED; PG8_LDA(At, 0, 0); PG8_STAGE(PG8_SA(1, 1), a1 + hstepA, voffA);
            PG8_WAIT_V(8); PG8_WAIT_L(0); PG8_BAR; PG8_MMA(0, 0, At, B0); PG8_MMA(0, 1, At, B1); PG8_BAR; PG8_SCHED;
            PG8_LDA(At, 0, 1); PG8_STAGE(PG8_SB(0, 0), b2, voffB); PG8_STAGE(PG8_SB(0, 1), b2 + hstepB, voffB); PG8_STAGE(PG8_SA(0, 0), a2, voffA);
            PG8_WAIT_V(8); PG8_WAIT_L(0); PG8_BAR; PG8_MMA(1, 0, At, B0); PG8_MMA(1, 1, At, B1); PG8_BAR; PG8_SCHED;
            PG8_LDB(B0, 1, 0); PG8_LDB(B1, 1, 1); PG8_SCHED; PG8_LDA(At, 1, 0); PG8_STAGE(PG8_SA(0, 1), a2 + hstepA, voffA);
            PG8_WAIT_V(8); PG8_WAIT_L(0); PG8_BAR; PG8_MMA(0, 0, At, B0); PG8_MMA(0, 1, At, B1); PG8_BAR; PG8_SCHED;
            PG8_LDA(At, 1, 1); PG8_STAGE(PG8_SB(1, 0), b3, voffB); PG8_STAGE(PG8_SB(1, 1), b3 + hstepB, voffB); PG8_STAGE(PG8_SA(1, 0), a3, voffA);
            PG8_WAIT_V(8); PG8_WAIT_L(0); PG8_BAR; PG8_MMA(1, 0, At, B0); PG8_MMA(1, 1, At, B1); PG8_BAR; PG8_SCHED;
        }
        if (wr == 0) PG8_BAR;
        E(acc, cur, wr, wc, fr, fq);
        if (!has_next) break;
        if (Epi::reset(cur))
#pragma unroll
        for (int a = 0; a < 2; ++a)
#pragma unroll
            for (int b = 0; b < 2; ++b)
#pragma unroll
                for (int m = 0; m < 4; ++m)
#pragma unroll
                    for (int n = 0; n < 2; ++n) acc[a][b][m][n] = (f32x4){0.f, 0.f, 0.f, 0.f};
        cur = nxt; cA = nA; cB = nB; ++ui;
        if (wr == 1) PG8_BAR;
    }
    PG8_WAIT_V(0);
    PG8_BAR;
#undef PG8_SA
#undef PG8_SB
#undef PG8_STAGE
#undef PG8_LDA
#undef PG8_LDB
#undef PG8_MMA
#undef PG8_WAIT_V
#undef PG8_WAIT_L
#undef PG8_BAR
#undef PG8_SCHED
}
}


#define XB_TMO      128
#define XB_XCNT(j)  (256  + 64 * (j))
#define XB_XSUB(j)  (1280 + 64 * (j))
#define XB_XGEN(j)  (2304 + 64 * (j))
#define XB_TOP      3328
#define XB_TOPGEN   3392
#define XCD_BAR_WORDS 3456
#define XB_SPIN_CAP (1u << 18)
__device__ __forceinline__ unsigned xb_ld(unsigned* p)              { return __hip_atomic_load(p, __ATOMIC_RELAXED, __HIP_MEMORY_SCOPE_AGENT); }
__device__ __forceinline__ unsigned xb_add(unsigned* p, unsigned v) { return __hip_atomic_fetch_add(p, v, __ATOMIC_RELAXED, __HIP_MEMORY_SCOPE_AGENT); }
__device__ __forceinline__ unsigned xb_xcc_id() { return (unsigned)__builtin_amdgcn_s_getreg((3 << 11) | 20) & 0xFu; }
#define XB_SPIN(cond, bar) do { unsigned _sp = 0; while (cond) { __builtin_amdgcn_s_sleep(1); \
    if ((++_sp & 255u) == 0u) { if (xb_ld(&(bar)[XB_TMO])) break; if (_sp > XB_SPIN_CAP) { atomicAdd(&(bar)[XB_TMO], 1u); break; } } } } while (0)
__device__ __forceinline__ void xcd_barrier_complete(unsigned* bar, unsigned x, unsigned& nloc, unsigned& nx) {
    const unsigned G = gridDim.x * gridDim.y * gridDim.z;
    unsigned sum, cnt, mine, sp = 0u;
    for (;;) {
        sum = 0u; cnt = 0u; mine = 0u;
#pragma unroll
        for (unsigned j = 0; j < 16; ++j) { const unsigned c = xb_ld(&bar[XB_XCNT(j)]); sum += c; cnt += (c > 0u) ? 1u : 0u; mine = (j == x) ? c : mine; }
        if (sum == G) break;
        __builtin_amdgcn_s_sleep(1);
        if ((++sp & 255u) == 0u) { if (xb_ld(&bar[XB_TMO])) break; if (sp > XB_SPIN_CAP) { atomicAdd(&bar[XB_TMO], 1u); break; } }
    }
    nloc = mine > 0u ? mine : 1u; nx = cnt > 0u ? cnt : 1u;
}
__device__ __forceinline__ void xcd_barrier(unsigned* bar, volatile LAS unsigned* st) {
    asm volatile("s_waitcnt vmcnt(0)" ::: "memory");
    __syncthreads();
    if (threadIdx.x == 0) {
        const unsigned x = xb_xcc_id();
        __builtin_amdgcn_s_waitcnt(0);
        unsigned nloc = st[0], nx = st[1];
        if (nloc == 0u) { xcd_barrier_complete(bar, x, nloc, nx); st[0] = nloc; st[1] = nx; }
        const unsigned old = xb_add(&bar[XB_XSUB(x)], 1u);
        const unsigned gen = old / nloc;
        if (old + 1u == (gen + 1u) * nloc) {
            __builtin_amdgcn_fence(__ATOMIC_RELEASE, "agent");
            asm volatile("s_waitcnt vmcnt(0)" ::: "memory");
            const unsigned og = xb_add(&bar[XB_TOP], 1u);
            const unsigned tg = og / nx;
            if (og + 1u == (tg + 1u) * nx) xb_add(&bar[XB_TOPGEN], 1u);
            else XB_SPIN(xb_ld(&bar[XB_TOPGEN]) == tg, bar);
            __builtin_amdgcn_fence(__ATOMIC_ACQUIRE, "agent");
            xb_add(&bar[XB_XGEN(x)], 1u);
            asm volatile("s_waitcnt vmcnt(0)" ::: "memory");
        } else {
            XB_SPIN(xb_ld(&bar[XB_XGEN(x)]) == gen, bar);
            __builtin_amdgcn_fence(__ATOMIC_ACQUIRE, "agent");
            asm volatile("s_waitcnt vmcnt(0)" ::: "memory");
        }
    }
    __syncthreads();
}

struct Ctx {
    int bx;
    bf16_t *win, *wb, *wout, *h, *proj, *gates, *y, *mb;
    float *mf, *of, *kva, *kvd, *decd, *ropeAc, *ropeAs, *ropeBc, *ropeBs, *lbt;
    int tid, lane, w, G;
};

struct TJob { const float* src; bf16_t* dst; int N, Kp; };
__device__ __forceinline__ TJob tjob_decode(const Params& P, Ctx& C, int job) {
    const int l = job / 2496, j = job % 2496; TJob t; int kt, nt;
    if (j < 1920) { kt = j / 120; nt = j % 120; t.N = DIN; t.Kp = DM; t.src = P.w_in + (size_t)l * DM * DIN; t.dst = C.win + (size_t)l * DIN * DM; }
    else if (j < 2240) { const int jj = j - 1920; kt = jj / 16; nt = jj % 16; t.N = DM; t.Kp = WMIX; t.src = P.w_branch + (size_t)l * WMIX * DM; t.dst = C.wb + (size_t)l * DM * WMIX; }
    else { const int jj = j - 2240; kt = jj / 16; nt = jj % 16; t.N = DM; t.Kp = DM; t.src = P.w_out + (size_t)l * DM * DM; t.dst = C.wout + (size_t)l * DM * DM; }
    t.src += (size_t)(kt * 64) * t.N + nt * 64; t.dst += (size_t)(nt * 64) * t.Kp + kt * 64; return t;
}

__device__ __forceinline__ void phase_prologue(const Params& P, Ctx& C, unsigned char* lds) {
    const int tid = C.tid;
    float* scr = (float*)lds;
    {
        const int kk = tid >> 3, c8 = (tid & 7) * 8, n = tid >> 3, k8 = (tid & 7) * 8;
        int job = C.bx, par = 0; float4 a, b; TJob cur;
        if (job < 4 * 2496) { cur = tjob_decode(P, C, job); const float4* sp = (const float4*)(cur.src + (size_t)kk * cur.N + c8); a = sp[0]; b = sp[1]; }
        while (job < 4 * 2496) {
            float* r = scr + par * (64 * 65) + kk * 65 + c8;
            r[0] = a.x; r[1] = a.y; r[2] = a.z; r[3] = a.w; r[4] = b.x; r[5] = b.y; r[6] = b.z; r[7] = b.w;
            const int nxt = job + C.G; TJob nj;
            if (nxt < 4 * 2496) { nj = tjob_decode(P, C, nxt); const float4* sp = (const float4*)(nj.src + (size_t)kk * nj.N + c8); a = sp[0]; b = sp[1]; }
            __syncthreads();
            const float* q = scr + par * (64 * 65) + k8 * 65 + n;
            u32x4 wv; wv.x = pk2(q[0], q[65]); wv.y = pk2(q[130], q[195]); wv.z = pk2(q[260], q[325]); wv.w = pk2(q[390], q[455]);
            *(u32x4*)(cur.dst + (size_t)n * cur.Kp + k8) = wv;
            cur = nj; job = nxt; par ^= 1;
        }
        __syncthreads();
    }
    for (int row = C.bx * 8 + C.w; row < M_TOT; row += C.G * 8) {
        const float* xs = row < M_P ? P.x_prompt + (size_t)row * DM : P.x_sample + (size_t)(row - M_P) * DM;
        float4 x[4]; float ss = 0.f;
#pragma unroll
        for (int i = 0; i < 4; ++i) { x[i] = ((const float4*)xs)[C.lane + 64 * i]; ss += x[i].x * x[i].x + x[i].y * x[i].y + x[i].z * x[i].z + x[i].w * x[i].w; }
        ss = wave_sum(ss); const float r = rsqrtf(ss * (1.f / DM) + EPS);
#pragma unroll
        for (int i = 0; i < 4; ++i) { ((float4*)(P.out + (size_t)row * DM))[C.lane + 64 * i] = x[i];
            const float4 g = ((const float4*)P.g_pre)[C.lane + 64 * i];
            uint2 o; o.x = pk2(x[i].x * r * g.x, x[i].y * r * g.y); o.y = pk2(x[i].z * r * g.z, x[i].w * r * g.w);
            ((uint2*)(C.h + (size_t)row * DM))[C.lane + 64 * i] = o; }
    }
    const int gt = C.bx * NTHREADS + tid, gn = C.G * NTHREADS;
    const double TWO_PI = 6.283185307179586476925286766559, INV_2PI = 0.15915494309189533576888376337251;
    for (int i = gt; i < NPOS * 24; i += gn) {
        int pos, f; double inv;
        if (i < NPOS * 16) { pos = i >> 4; f = i & 15; inv = P.invA[f]; } else { const int k = i - NPOS * 16; pos = k >> 3; f = k & 7; inv = P.invB[f]; }
        double r = (double)pos * inv * INV_2PI; r -= floor(r);
        const float a = (float)(r * TWO_PI);
        const float cs = cosf(a), sn = sinf(a);
        if (i < NPOS * 16) { C.ropeAc[i] = cs; C.ropeAs[i] = sn; } else { C.ropeBc[i - NPOS * 16] = cs; C.ropeBs[i - NPOS * 16] = sn; }
    }
    for (int c = gt; c < 256; c += gn) {
        const float v0 = P.lower_bounds[c], v1 = P.lower_bounds[256 + c], v2 = P.lower_bounds[512 + c], v3 = P.lower_bounds[768 + c];
        const float m = fmaxf(fmaxf(v0, v1), fmaxf(v2, v3));
        const float e0 = expf(v0 - m), e1 = expf(v1 - m), e2 = expf(v2 - m), e3 = expf(v3 - m), inv = 1.f / (e0 + e1 + e2 + e3);
        C.lbt[c] = 0.f; C.lbt[256 + c] = e1 * inv; C.lbt[512 + c] = (e1 + e2) * inv; C.lbt[768 + c] = (e1 + e2 + e3) * inv;
    }
}

__device__ __forceinline__ void attn_prompt_unit(const Params& P, Ctx& C, int l, int b, int qb, int kvh, unsigned char* lds) {
    const int tid = C.tid, lane = C.lane, w = C.w, fr = lane & 15, fq = lane >> 4;
    bf16_t* Ks = (bf16_t*)lds;
    bf16_t* Vt = (bf16_t*)(lds + 36864);
    bf16_t* Ps = (bf16_t*)(lds + 36864 + 35840) + w * (16 * 168);
    const int t0 = qb * 128; const size_t R0 = (size_t)b * 8192 + t0;
    const bool last = (qb == 63);
    for (int i = tid; i < 256 * 7; i += NTHREADS) {
        const int kk = i / 7, task = i - kk * 7, tk = t0 - 128 + kk;
        bf16_t* dst = Ks + kk * 72;
        if (tk < 0) { const u32x4 z = {0u, 0u, 0u, 0u}; if (task == 0) { *(u32x4*)dst = z; *(u32x4*)(dst + 8) = z; } else *(u32x4*)(dst + (task + 1) * 8) = z; }
        else {
            const bf16_t* src = C.proj + (size_t)(b * 8192 + tk) * NPROJ + C_KB + kvh * 64;
            float* kp = P.out + O_KP + ((((size_t)l * 2 + b) * 128 + (kk - 128)) * 2 + kvh) * 64;
            if (task == 0) {
                const u32x4 a = *(const u32x4*)src, bb = *(const u32x4*)(src + 8);
                const float4 c0 = *(const float4*)(C.ropeBc + tk * 8), c1 = *(const float4*)(C.ropeBc + tk * 8 + 4), s0 = *(const float4*)(C.ropeBs + tk * 8), s1 = *(const float4*)(C.ropeBs + tk * 8 + 4);
                const float x1[8] = {lo16(a.x), hi16(a.x), lo16(a.y), hi16(a.y), lo16(a.z), hi16(a.z), lo16(a.w), hi16(a.w)};
                const float x2[8] = {lo16(bb.x), hi16(bb.x), lo16(bb.y), hi16(bb.y), lo16(bb.z), hi16(bb.z), lo16(bb.w), hi16(bb.w)};
                const float cs[8] = {c0.x, c0.y, c0.z, c0.w, c1.x, c1.y, c1.z, c1.w}, sn[8] = {s0.x, s0.y, s0.z, s0.w, s1.x, s1.y, s1.z, s1.w};
                float r1[8], r2[8];
#pragma unroll
                for (int j = 0; j < 8; ++j) { r1[j] = x1[j] * cs[j] - x2[j] * sn[j]; r2[j] = x2[j] * cs[j] + x1[j] * sn[j]; }
                u32x4 o1, o2; o1.x = pk2(r1[0], r1[1]); o1.y = pk2(r1[2], r1[3]); o1.z = pk2(r1[4], r1[5]); o1.w = pk2(r1[6], r1[7]);
                o2.x = pk2(r2[0], r2[1]); o2.y = pk2(r2[2], r2[3]); o2.z = pk2(r2[4], r2[5]); o2.w = pk2(r2[6], r2[7]);
                *(u32x4*)dst = o1; *(u32x4*)(dst + 8) = o2;
                if (last && kk >= 128) {
#pragma unroll
                    for (int j = 0; j < 8; ++j) { kp[j] = r1[j]; kp[8 + j] = r2[j]; } }
            } else {
                const int c = task + 1; const u32x4 a = *(const u32x4*)(src + c * 8); *(u32x4*)(dst + c * 8) = a;
                if (last && kk >= 128) { float* o = kp + c * 8; o[0] = lo16(a.x); o[1] = hi16(a.x); o[2] = lo16(a.y); o[3] = hi16(a.y); o[4] = lo16(a.z); o[5] = hi16(a.z); o[6] = lo16(a.w); o[7] = hi16(a.w); }
            }
        }
    }
    for (int i = tid; i < 256 * 8; i += NTHREADS) {
        const int kk = i & 255, c = i >> 8, tk = t0 - 128 + kk;
        u32x4 a = {0u, 0u, 0u, 0u};
        if (tk >= 0) a = *(const u32x4*)(C.proj + (size_t)(b * 8192 + tk) * NPROJ + C_VB + kvh * 64 + c * 8);
        bf16_t* d = Vt + (c * 8) * 280 + kk;
        d[0] = (bf16_t)(a.x & 0xffff); d[280] = (bf16_t)(a.x >> 16); d[560] = (bf16_t)(a.y & 0xffff); d[840] = (bf16_t)(a.y >> 16);
        d[1120] = (bf16_t)(a.z & 0xffff); d[1400] = (bf16_t)(a.z >> 16); d[1680] = (bf16_t)(a.w & 0xffff); d[1960] = (bf16_t)(a.w >> 16);
        if (last && kk >= 128) { float* o = P.out + O_VP + ((((size_t)l * 2 + b) * 128 + (kk - 128)) * 2 + kvh) * 64 + c * 8;
            o[0] = lo16(a.x); o[1] = hi16(a.x); o[2] = lo16(a.y); o[3] = hi16(a.y); o[4] = lo16(a.z); o[5] = hi16(a.z); o[6] = lo16(a.w); o[7] = hi16(a.w); }
    }
    for (int i = tid; i < 64 * 24; i += NTHREADS) Vt[(i / 24) * 280 + 256 + (i % 24)] = 0;
    for (int i = lane; i < 16 * 16; i += 64) Ps[(i >> 4) * 168 + 144 + (i & 15)] = 0;
    __syncthreads();
    const int tq = t0 + w * 16 + fr;
    for (int g = 0; g < 4; ++g) {
        const int h = kvh * 4 + g;
        const bf16_t* qsrc = C.proj + (R0 + w * 16 + fr) * NPROJ + C_QB + h * 64;
        u32x4 q0 = *(const u32x4*)(qsrc + fq * 8); const u32x4 q1 = *(const u32x4*)(qsrc + 32 + fq * 8);
        if (fq < 2) {
            const u32x4 qp = *(const u32x4*)(qsrc + (fq ^ 1) * 8);
            const float4 c0 = *(const float4*)(C.ropeBc + tq * 8), c1 = *(const float4*)(C.ropeBc + tq * 8 + 4), s0 = *(const float4*)(C.ropeBs + tq * 8), s1 = *(const float4*)(C.ropeBs + tq * 8 + 4);
            const float sg = fq == 0 ? -1.f : 1.f;
            const float own[8] = {lo16(q0.x), hi16(q0.x), lo16(q0.y), hi16(q0.y), lo16(q0.z), hi16(q0.z), lo16(q0.w), hi16(q0.w)};
            const float par[8] = {lo16(qp.x), hi16(qp.x), lo16(qp.y), hi16(qp.y), lo16(qp.z), hi16(qp.z), lo16(qp.w), hi16(qp.w)};
            const float cs[8] = {c0.x, c0.y, c0.z, c0.w, c1.x, c1.y, c1.z, c1.w}, sn[8] = {s0.x, s0.y, s0.z, s0.w, s1.x, s1.y, s1.z, s1.w};
            float r[8];
#pragma unroll
            for (int j = 0; j < 8; ++j) r[j] = own[j] * cs[j] + sg * par[j] * sn[j];
            q0.x = pk2(r[0], r[1]); q0.y = pk2(r[2], r[3]); q0.z = pk2(r[4], r[5]); q0.w = pk2(r[6], r[7]);
        }
        const bf16x8 qa0 = __builtin_bit_cast(bf16x8, q0), qa1 = __builtin_bit_cast(bf16x8, q1);
        f32x4 S[9];
#pragma unroll
        for (int jt = 0; jt < 9; ++jt) {
            const bf16_t* kp = Ks + ((w + jt) * 16 + fr) * 72 + fq * 8;
            f32x4 a = {0.f, 0.f, 0.f, 0.f};
            a = mfma16(qa0, *(const bf16x8*)kp, a); a = mfma16(qa1, *(const bf16x8*)(kp + 32), a);
            S[jt] = a;
        }
        const float sink = P.attn_sink[l * 8 + h];
        float mx[4], sm[4];
#pragma unroll
        for (int j = 0; j < 4; ++j) {
            const int r = w * 16 + fq * 4 + j;
            float m = -1e30f;
#pragma unroll
            for (int jt = 0; jt < 9; ++jt) { const int kk = (w + jt) * 16 + fr; const bool ok = (kk >= r) && (kk <= r + 128) && (t0 - 128 + kk >= 0);
                const float s = ok ? S[jt][j] * 0.125f : -1e30f; S[jt][j] = s; m = fmaxf(m, s); }
            m = fmaxf(quad16_max(m), sink); mx[j] = m;
            float su = 0.f;
#pragma unroll
            for (int jt = 0; jt < 9; ++jt) { const float p = __expf(S[jt][j] - m); su += p; Ps[(fq * 4 + j) * 168 + jt * 16 + fr] = f2bf(p); }
            su = quad16_sum(su) + __expf(sink - m); sm[j] = 1.f / su;
        }
        __syncthreads();
        float zz[4][4];
#pragma unroll
        for (int j = 0; j < 4; ++j)
#pragma unroll
            for (int nt = 0; nt < 4; ++nt) zz[j][nt] = bf2f(C.proj[(R0 + w * 16 + fq * 4 + j) * NPROJ + C_ZB + h * 64 + nt * 16 + fr]);
        f32x4 O[4];
#pragma unroll
        for (int nt = 0; nt < 4; ++nt) O[nt] = (f32x4){0.f, 0.f, 0.f, 0.f};
#pragma unroll
        for (int kx = 0; kx < 5; ++kx) {
            const bf16x8 a = *(const bf16x8*)(Ps + fr * 168 + kx * 32 + fq * 8);
#pragma unroll
            for (int nt = 0; nt < 4; ++nt) O[nt] = mfma16(a, *(const bf16x8*)(Vt + (nt * 16 + fr) * 280 + w * 16 + kx * 32 + fq * 8), O[nt]);
        }
#pragma unroll
        for (int j = 0; j < 4; ++j) {
            const size_t row = R0 + w * 16 + fq * 4 + j;
#pragma unroll
            for (int nt = 0; nt < 4; ++nt) { const int e = nt * 16 + fr;
                C.y[row * WMIX + Y_B + h * 64 + e] = f2bf(O[nt][j] * sm[j] * silu_(zz[j][nt])); }
        }
        __syncthreads();
    }
}

__device__ __forceinline__ void pool_prompt_unit(const Params& P, Ctx& C, int l, int tile, unsigned char* lds) {
    const int tid = C.tid, lane = C.lane, w = C.w, fr = lane & 15, fq = lane >> 4;
    bf16_t* U = (bf16_t*)lds;
    bf16_t* A = (bf16_t*)(lds + 40448);
    bf16_t* Wt = (bf16_t*)(lds + 40448 + 33792);
    const int b = tile >> 7, t0 = (tile & 127) * 64; const size_t R0 = (size_t)b * 8192 + t0;
    for (int i = tid; i < 79 * 32; i += NTHREADS) { const int r = i >> 5, c = i & 31, t = t0 - 15 + r;
        u32x4 a = {0u, 0u, 0u, 0u}; if (t >= 0) a = *(const u32x4*)(C.proj + (size_t)(b * 8192 + t) * NPROJ + C_UC + c * 8);
        *(u32x4*)(U + r * 256 + c * 8) = a; }
    for (int i = tid; i < 4 * 64 * 64; i += NTHREADS) { const int g = i >> 12, cin = (i >> 6) & 63, dout = i & 63;
        Wt[(g * 64 + dout) * 72 + cin] = f2bf(P.w_pool[(size_t)l * 16384 + i]); }
    __syncthreads();
    { const int c = tid & 255, rh = tid >> 8, g = c >> 6, wn = 2 << g;
      for (int r = rh * 32; r < rh * 32 + 32; ++r) {
          float s = 0.f; for (int j = 0; j < wn; ++j) s += bf2f(U[(r + 15 - j) * 256 + c]);
          const int pos = t0 + r; const float cnt = (float)(pos + 1 < wn ? pos + 1 : wn);
          const float u = bf2f(U[(r + 15) * 256 + c]);
          A[r * 264 + c] = f2bf(s / cnt - u);
          if (t0 == 8128 && r >= 49) P.out[O_POOLP + (((size_t)l * 2 + b) * 15 + (r - 49)) * 256 + c] = u;
      } }
    __syncthreads();
    for (int tl = w; tl < 64; tl += 8) { const int rt = tl >> 4, ct = tl & 15, g = ct >> 2;
        f32x4 acc = {0.f, 0.f, 0.f, 0.f};
        acc = mma_tile(A + rt * 16 * 264 + g * 64, 264, Wt + (g * 64 + (ct & 3) * 16) * 72, 72, 64, acc, lane);
        const int c = ct * 16 + fr; const float sc = P.pool_scale[l * 256 + c];
        float zz[4];
#pragma unroll
        for (int j = 0; j < 4; ++j) zz[j] = bf2f(C.proj[(R0 + rt * 16 + fq * 4 + j) * NPROJ + C_ZC + c]);
#pragma unroll
        for (int j = 0; j < 4; ++j) { const size_t row = R0 + rt * 16 + fq * 4 + j;
            C.y[row * WMIX + Y_C + c] = f2bf(acc[j] * sc * silu_(zz[j])); }
    }
    __syncthreads();
}

__device__ __forceinline__ void unpack8(const u32x4 a, float (&x)[8]) { x[0] = lo16(a.x); x[1] = hi16(a.x); x[2] = lo16(a.y); x[3] = hi16(a.y); x[4] = lo16(a.z); x[5] = hi16(a.z); x[6] = lo16(a.w); x[7] = hi16(a.w); }
__device__ __forceinline__ u32x4 pack8(const float (&x)[8]) { u32x4 w; w.x = pk2(x[0], x[1]); w.y = pk2(x[2], x[3]); w.z = pk2(x[4], x[5]); w.w = pk2(x[6], x[7]); return w; }
template <bool IS_D, bool KV>
__device__ __forceinline__ void lin_chunk(const Params& P, Ctx& C, int l, int b, int n, unsigned char* lds) {
    const int lane = C.lane, w = C.w, fr = lane & 15, fq = lane >> 4;
    constexpr int DK = IS_D ? 64 : 32, NCG = DK / 8, HPR = KV ? 4 : 2;
    constexpr int SLOT = KV ? 18432 : 53248, VP = KV ? 72 : 136;
    const size_t R0 = (size_t)b * 8192 + n * 64;
    const bf16_t* prow = C.proj + (R0 + lane) * NPROJ;
    for (int h0 = 0; h0 < 4; h0 += HPR) {
        for (int task = w; task < HPR * NCG; task += 8) {
            const int hh = task / NCG, cg = task % NCG, h = h0 + hh, d0 = cg * 8;
            unsigned char* slot = lds + hh * SLOT;
            float q[8], k[8], Bt[8], Bm[8], Bl[8];
            if (IS_D) {
                float qv[8], fv[8]; unpack8(*(const u32x4*)(prow + C_QD + h * 64 + d0), qv); unpack8(*(const u32x4*)(prow + C_FD + h * 64 + d0), fv);
                const float4 l0 = *(const float4*)(C.lbt + l * 256 + h * 64 + d0), l1 = *(const float4*)(C.lbt + l * 256 + h * 64 + d0 + 4);
                const float lb[8] = {l0.x, l0.y, l0.z, l0.w, l1.x, l1.y, l1.z, l1.w};
#pragma unroll
                for (int j = 0; j < 8; ++j) { const float f = lb[j] + (1.f - lb[j]) * sigmoid_(fv[j]); q[j] = silu_(qv[j]); k[j] = 1.f - f;
                    float v = __logf(f);
#pragma unroll
                    for (int off = 1; off < 64; off <<= 1) { const float u = __shfl_up(v, off); if (lane >= off) v += u; }
                    Bt[j] = v; Bm[j] = __shfl(v, 31); Bl[j] = __shfl(v, 63); }
                if (KV && lane == 63) {
#pragma unroll
                    for (int j = 0; j < 8; ++j) C.decd[(size_t)(b * 128 + n) * 256 + h * 64 + d0 + j] = __expf(Bl[j]); }
            } else {
                const float lg = log1pf(-exp2f(-5.f - (float)h));
                const int i0 = d0 & 15, pos = n * 64 + lane;
                float q1[8], q2[8], k1[8], k2[8];
                unpack8(*(const u32x4*)(prow + C_QA + h * 32 + i0), q1); unpack8(*(const u32x4*)(prow + C_QA + h * 32 + 16 + i0), q2);
                unpack8(*(const u32x4*)(prow + C_KA + h * 32 + i0), k1); unpack8(*(const u32x4*)(prow + C_KA + h * 32 + 16 + i0), k2);
                const float4 c0 = *(const float4*)(C.ropeAc + pos * 16 + i0), c1 = *(const float4*)(C.ropeAc + pos * 16 + i0 + 4), s0 = *(const float4*)(C.ropeAs + pos * 16 + i0), s1 = *(const float4*)(C.ropeAs + pos * 16 + i0 + 4);
                const float cs[8] = {c0.x, c0.y, c0.z, c0.w, c1.x, c1.y, c1.z, c1.w}, sn[8] = {s0.x, s0.y, s0.z, s0.w, s1.x, s1.y, s1.z, s1.w};
#pragma unroll
                for (int j = 0; j < 8; ++j) {
                    q[j] = d0 < 16 ? q1[j] * cs[j] - q2[j] * sn[j] : q2[j] * cs[j] + q1[j] * sn[j];
                    k[j] = (d0 < 16 ? k1[j] * cs[j] - k2[j] * sn[j] : k2[j] * cs[j] + k1[j] * sn[j]) * 0.17677669529663687f;
                    Bt[j] = (float)(lane + 1) * lg; Bm[j] = 32.f * lg; Bl[j] = 64.f * lg; }
            }
            if (!KV) {
                bf16_t* Qh = (bf16_t*)slot; bf16_t* Kh = (bf16_t*)(slot + 9216); bf16_t* PQ = (bf16_t*)(slot + 18432);
                float a[8], c[8], e[8];
#pragma unroll
                for (int j = 0; j < 8; ++j) { a[j] = q[j] * __expf(Bt[j] - Bm[j]); c[j] = k[j] * __expf(Bm[j] - Bt[j]); e[j] = q[j] * __expf(Bt[j]); }
                *(u32x4*)(Qh + lane * 72 + d0) = pack8(a); *(u32x4*)(Kh + lane * 72 + d0) = pack8(c); *(u32x4*)(PQ + lane * 136 + 64 + d0) = pack8(e);
            } else {
                bf16_t* KdT = (bf16_t*)slot;
#pragma unroll
                for (int j = 0; j < 8; ++j) KdT[(d0 + j) * 72 + lane] = f2bf(k[j] * __expf(Bl[j] - Bt[j]));
            }
        }
        for (int task = w; task < HPR * 8; task += 8) {
            const int hh = task >> 3, e0 = (task & 7) * 8, h = h0 + hh;
            bf16_t* VS = (bf16_t*)(lds + hh * SLOT + (KV ? 9216 : 35840));
            const u32x4 v = *(const u32x4*)(prow + (IS_D ? C_ID : C_VA) + h * 64 + e0);
            bf16_t* d = VS + e0 * VP + lane;
            d[0] = (bf16_t)(v.x & 0xffff); d[VP] = (bf16_t)(v.x >> 16); d[2 * VP] = (bf16_t)(v.y & 0xffff); d[3 * VP] = (bf16_t)(v.y >> 16);
            d[4 * VP] = (bf16_t)(v.z & 0xffff); d[5 * VP] = (bf16_t)(v.z >> 16); d[6 * VP] = (bf16_t)(v.w & 0xffff); d[7 * VP] = (bf16_t)(v.w >> 16);
            if (!KV && lane < DK) {
                const float* sp = (IS_D ? C.kvd : C.kva) + ((size_t)(b * 128 + n) * 4 + h) * (DK * 64) + lane * 64 + e0;
                const float4 s0 = *(const float4*)sp, s1 = *(const float4*)(sp + 4);
                bf16_t* ds = VS + e0 * VP + 64 + lane;
                ds[0] = f2bf(s0.x); ds[VP] = f2bf(s0.y); ds[2 * VP] = f2bf(s0.z); ds[3 * VP] = f2bf(s0.w); ds[4 * VP] = f2bf(s1.x); ds[5 * VP] = f2bf(s1.y); ds[6 * VP] = f2bf(s1.z); ds[7 * VP] = f2bf(s1.w);
            }
        }
        __syncthreads();
        if (KV) {
            constexpr int TPH = (DK / 16) * 4;
            for (int tl = w; tl < 4 * TPH; tl += 8) { const int hh = tl / TPH, r = tl % TPH, dt = r >> 2, et = r & 3, h = h0 + hh;
                const bf16_t* KdT = (const bf16_t*)(lds + hh * SLOT); const bf16_t* VT = (const bf16_t*)(lds + hh * SLOT + 9216);
                f32x4 acc = {0.f, 0.f, 0.f, 0.f};
                acc = mma_tile(KdT + dt * 16 * 72, 72, VT + et * 16 * 72, 72, 64, acc, lane);
                float* kvbase = (IS_D ? C.kvd : C.kva) + ((size_t)(b * 128 + n) * 4 + h) * (DK * 64);
#pragma unroll
                for (int j = 0; j < 4; ++j) kvbase[(dt * 16 + fq * 4 + j) * 64 + et * 16 + fr] = acc[j]; }
        } else {
            for (int tl = w; tl < 32; tl += 8) { const int hh = tl >> 4, rt = (tl >> 2) & 3, ct = tl & 3;
                const bf16_t* Qh = (const bf16_t*)(lds + hh * SLOT); const bf16_t* Kh = (const bf16_t*)(lds + hh * SLOT + 9216); bf16_t* PQ = (bf16_t*)(lds + hh * SLOT + 18432);
                f32x4 acc = {0.f, 0.f, 0.f, 0.f};
                if (ct <= rt) acc = mma_tile(Qh + rt * 16 * 72, 72, Kh + ct * 16 * 72, 72, DK, acc, lane);
#pragma unroll
                for (int j = 0; j < 4; ++j) { const int t = rt * 16 + fq * 4 + j, sidx = ct * 16 + fr; PQ[t * 136 + sidx] = f2bf(sidx <= t ? acc[j] : 0.f); } }
            __syncthreads();
            { const int hh = w >> 2, rt = w & 3, h = h0 + hh;
                const bf16_t* PQ = (const bf16_t*)(lds + hh * SLOT + 18432); const bf16_t* VS = (const bf16_t*)(lds + hh * SLOT + 35840);
                float zz[4][4], gg[4];
#pragma unroll
                for (int et = 0; et < 4; ++et) { gg[et] = IS_D ? P.g_hgrn[l * 256 + h * 64 + et * 16 + fr] : 1.f;
#pragma unroll
                    for (int j = 0; j < 4; ++j) zz[j][et] = bf2f(C.proj[(R0 + rt * 16 + fq * 4 + j) * NPROJ + (IS_D ? C_ZD : C_ZA) + h * 64 + et * 16 + fr]); }
                f32x4 O[4];
#pragma unroll
                for (int et = 0; et < 4; ++et) { O[et] = (f32x4){0.f, 0.f, 0.f, 0.f}; O[et] = mma_tile(PQ + rt * 16 * 136, 136, VS + et * 16 * 136, 136, 64 + DK, O[et], lane); }
#pragma unroll
                for (int j = 0; j < 4; ++j) {
                    float ss = O[0][j] * O[0][j] + O[1][j] * O[1][j] + O[2][j] * O[2][j] + O[3][j] * O[3][j];
                    ss = quad16_sum(ss); const float r = rsqrtf(ss * (1.f / 64.f) + EPS);
                    const size_t row = R0 + rt * 16 + fq * 4 + j;
#pragma unroll
                    for (int et = 0; et < 4; ++et) { const int e = et * 16 + fr;
                        C.y[row * WMIX + (IS_D ? Y_D : Y_A) + h * 64 + e] = f2bf(O[et][j] * r * gg[et] * silu_(zz[j][et])); }
                }
            }
        }
        __syncthreads();
    }
}

#define PR(t, c) bf2f(prb[(t) * NPROJ + (c)])
__device__ __forceinline__ void sample_b_unit(const Params& P, Ctx& C, int l, int sb, unsigned char* lds) {
    const int tid = C.tid, lane = C.lane, w = C.w;
    bf16_t* prb = (bf16_t*)lds;
    float* qbq = (float*)(lds + 28672);
    float* kn = qbq + 2048;
    float* ps = kn + 512;
    float* kv = ps + 32 * 136;
    const size_t R0 = (size_t)M_P + sb * 4;
    const float4* kc4 = (const float4*)(P.cache_k + ((size_t)l * 128 + sb) * 16384);
    const float4* vc4 = (const float4*)(P.cache_v + ((size_t)l * 128 + sb) * 16384);
    for (int i = tid; i < 4 * 448; i += NTHREADS) { const int t = i / 448, c = i % 448;
        *(u32x4*)(prb + t * NPROJ + c * 8) = *(const u32x4*)(C.proj + (R0 + t) * NPROJ + c * 8); }
    { float4* ko = (float4*)(P.out + O_KS + ((size_t)l * 128 + sb) * 16384);
#pragma unroll
      for (int j = 0; j < 8; ++j) { const int i = tid + NTHREADS * j, e = i * 4, wq = e >> 7, r = e & 127; const float4 v = kc4[i];
          *(float4*)(kv + (wq * 2 + (r >> 6)) * 68 + (r & 63)) = v;
          if (wq >= 4) ko[i - 128] = v; } }
    __syncthreads();
    for (int i = tid; i < 2048; i += NTHREADS) { const int t = i >> 9, c = i & 511, h = c >> 6, d = c & 63; const int pos = 8192 + t;
        float v;
        if (d < 16) { const int ii = d & 7; const float cs = C.ropeBc[pos * 8 + ii], sn = C.ropeBs[pos * 8 + ii];
            const float x1 = PR(t, C_QB + h * 64 + ii), x2 = PR(t, C_QB + h * 64 + 8 + ii); v = d < 8 ? x1 * cs - x2 * sn : x2 * cs + x1 * sn; }
        else v = PR(t, C_QB + c);
        qbq[i] = v * 0.125f; }
    { const int t = tid >> 7, c = tid & 127, kh = c >> 6, d = c & 63, pos = 8192 + t;
        float v;
        if (d < 16) { const int ii = d & 7; const float cs = C.ropeBc[pos * 8 + ii], sn = C.ropeBs[pos * 8 + ii];
            const float x1 = PR(t, C_KB + kh * 64 + ii), x2 = PR(t, C_KB + kh * 64 + 8 + ii); v = d < 8 ? x1 * cs - x2 * sn : x2 * cs + x1 * sn; }
        else v = PR(t, C_KB + c);
        kn[tid] = v;
        P.out[O_KS + (((size_t)l * 128 + sb) * 128 + 124 + t) * 128 + c] = v;
        P.out[O_VS + (((size_t)l * 128 + sb) * 128 + 124 + t) * 128 + c] = PR(t, C_VB + c); }
    __syncthreads();
    for (int i = tid; i < 4224; i += NTHREADS) { const int kh = i / 2112, rem = i - kh * 2112, r16 = rem / 132, kk = rem - r16 * 132, g = r16 >> 2, t = r16 & 3, h = kh * 4 + g;
        const bool ok = kk < 128 ? (kk >= t) : (kk - 128 <= t);
        const float4* kp = (const float4*)(kk < 128 ? kv + (kk * 2 + kh) * 68 : kn + (kk - 128) * 128 + kh * 64);
        const float4* qp = (const float4*)(qbq + t * 512 + h * 64);
        float s = 0.f;
#pragma unroll 4
        for (int d = 0; d < 16; ++d) { const float4 a = qp[d], bq = kp[d]; s += a.x * bq.x + a.y * bq.y + a.z * bq.z + a.w * bq.w; }
        ps[(h * 4 + t) * 136 + kk] = ok ? s : -1e30f; }
    __syncthreads();
    { float4* vo = (float4*)(P.out + O_VS + ((size_t)l * 128 + sb) * 16384);
#pragma unroll
      for (int j = 0; j < 8; ++j) { const int i = tid + NTHREADS * j, e = i * 4, wq = e >> 7, r = e & 127; const float4 v = vc4[i];
          *(float4*)(kv + (wq * 2 + (r >> 6)) * 68 + (r & 63)) = v;
          if (wq >= 4) vo[i - 128] = v; } }
    { const int h = w; const float sink = P.attn_sink[l * 8 + h];
      for (int t = 0; t < 4; ++t) { float* pr_ = ps + (h * 4 + t) * 136;
          const float s0 = pr_[lane], s1 = pr_[lane + 64], s2 = lane < 4 ? pr_[lane + 128] : -1e30f;
          float m = fmaxf(fmaxf(s0, s1), s2); m = fmaxf(m, __shfl_xor(m, 32)); m = fmaxf(m, __shfl_xor(m, 16)); m = fmaxf(m, __shfl_xor(m, 8)); m = fmaxf(m, __shfl_xor(m, 4)); m = fmaxf(m, __shfl_xor(m, 2)); m = fmaxf(m, __shfl_xor(m, 1));
          m = fmaxf(m, sink);
          const float p0 = __expf(s0 - m), p1 = __expf(s1 - m), p2 = lane < 4 ? __expf(s2 - m) : 0.f;
          const float inv = 1.f / (wave_sum(p0 + p1 + p2) + __expf(sink - m));
          pr_[lane] = p0 * inv; pr_[lane + 64] = p1 * inv; if (lane < 4) pr_[lane + 128] = p2 * inv; } }
    __syncthreads();
    { const int h = w, kh = h >> 2, e = lane;
      float o0 = 0.f, o1 = 0.f, o2 = 0.f, o3 = 0.f; const float* p0 = ps + (h * 4) * 136;
#pragma unroll 8
      for (int kk = 0; kk < 128; ++kk) { const float v = kv[(kk * 2 + kh) * 68 + e]; o0 += p0[kk] * v; o1 += p0[136 + kk] * v; o2 += p0[272 + kk] * v; o3 += p0[408 + kk] * v; }
#pragma unroll
      for (int kk = 128; kk < 132; ++kk) { const float v = PR(kk - 128, C_VB + kh * 64 + e); o0 += p0[kk] * v; o1 += p0[136 + kk] * v; o2 += p0[272 + kk] * v; o3 += p0[408 + kk] * v; }
      const int c = h * 64 + e;
      C.y[(R0 + 0) * WMIX + Y_B + c] = f2bf(o0 * silu_(PR(0, C_ZB + c))); C.y[(R0 + 1) * WMIX + Y_B + c] = f2bf(o1 * silu_(PR(1, C_ZB + c)));
      C.y[(R0 + 2) * WMIX + Y_B + c] = f2bf(o2 * silu_(PR(2, C_ZB + c))); C.y[(R0 + 3) * WMIX + Y_B + c] = f2bf(o3 * silu_(PR(3, C_ZB + c))); }
    __syncthreads();
}

__device__ __forceinline__ void sample_adc_unit(const Params& P, Ctx& C, int l, int sb, unsigned char* lds) {
    const int tid = C.tid, lane = C.lane, w = C.w;
    bf16_t* prb = (bf16_t*)lds;
    float* qa = (float*)(lds + 28672);
    float* ka = qa + 512;
    float* qd = ka + 512;
    float* fd = qd + 1024;
    float* pl = fd + 1024;
    float* part = pl + 1024;
    const size_t R0 = (size_t)M_P + sb * 4;
    const int h = w >> 1, half = w & 1, e = lane;
    const float* SD0 = P.state_hgrn + (((size_t)l * 128 + sb) * 4 + h) * 4096 + (half * 32) * 64 + e;
    const float* SA0 = P.state_ret + (((size_t)l * 128 + sb) * 4 + h) * 2048 + (half * 16) * 64 + e;
    float sd[32], sa[16];
#pragma unroll
    for (int i = 0; i < 32; ++i) sd[i] = SD0[i * 64];
#pragma unroll
    for (int i = 0; i < 16; ++i) sa[i] = SA0[i * 64];
    for (int i = tid; i < 4 * 448; i += NTHREADS) { const int t = i / 448, c = i % 448;
        *(u32x4*)(prb + t * NPROJ + c * 8) = *(const u32x4*)(C.proj + (R0 + t) * NPROJ + c * 8); }
    __syncthreads();
    { const int t = tid >> 7, c = tid & 127, hh = c >> 5, d = c & 31, ii = d & 15, pos = 8192 + t;
        const float cs = C.ropeAc[pos * 16 + ii], sn = C.ropeAs[pos * 16 + ii];
        const float q1 = PR(t, C_QA + hh * 32 + ii), q2 = PR(t, C_QA + hh * 32 + 16 + ii), k1 = PR(t, C_KA + hh * 32 + ii), k2 = PR(t, C_KA + hh * 32 + 16 + ii);
        qa[tid] = d < 16 ? q1 * cs - q2 * sn : q2 * cs + q1 * sn;
        ka[tid] = (d < 16 ? k1 * cs - k2 * sn : k2 * cs + k1 * sn) * 0.17677669529663687f; }
    for (int i = tid; i < 1024; i += NTHREADS) { const int t = i >> 8, c = i & 255;
        qd[i] = silu_(PR(t, C_QD + c)); const float lb = C.lbt[l * 256 + c]; fd[i] = lb + (1.f - lb) * sigmoid_(PR(t, C_FD + c));
        const int g = c >> 6, wn = 2 << g; float s = 0.f;
        for (int j = 0; j < wn; ++j) { const int ee = 15 + t - j; s += ee >= 15 ? PR(ee - 15, C_UC + c) : P.state_pool[(((size_t)l * 128 + sb) * 15 + ee) * 256 + c]; }
        pl[i] = s / (float)wn - PR(t, C_UC + c); }
    for (int i = tid; i < 15 * 256; i += NTHREADS) { const int r = i >> 8, c = i & 255;
        P.out[O_POOLS + (((size_t)l * 128 + sb) * 15 + r) * 256 + c] = r < 11 ? P.state_pool[(((size_t)l * 128 + sb) * 15 + r + 4) * 256 + c] : PR(r - 11, C_UC + c); }
    const int pc = tid & 255, tp = tid >> 8, pg = pc >> 6;
    const float* wp = P.w_pool + ((size_t)l * 4 + pg) * 4096 + (pc & 63);
    __syncthreads();
    {
        float* S1 = P.out + O_HGRNS + (((size_t)l * 128 + sb) * 4 + h) * 4096 + (half * 32) * 64 + e;
        const float v0 = PR(0, C_ID + h * 64 + e), v1 = PR(1, C_ID + h * 64 + e), v2 = PR(2, C_ID + h * 64 + e), v3 = PR(3, C_ID + h * 64 + e);
        float o0 = 0.f, o1 = 0.f, o2 = 0.f, o3 = 0.f;
#pragma unroll
        for (int i = 0; i < 32; ++i) { float s = sd[i]; const int c = h * 64 + half * 32 + i;
            float f = fd[c]; s = f * s + (1.f - f) * v0; o0 += qd[c] * s; f = fd[256 + c]; s = f * s + (1.f - f) * v1; o1 += qd[256 + c] * s;
            f = fd[512 + c]; s = f * s + (1.f - f) * v2; o2 += qd[512 + c] * s; f = fd[768 + c]; s = f * s + (1.f - f) * v3; o3 += qd[768 + c] * s; S1[i * 64] = s; __builtin_amdgcn_sched_barrier(0); }
        float* pp = part + (w * 2 + 1) * 256 + e; pp[0] = o0; pp[64] = o1; pp[128] = o2; pp[192] = o3;
    }
    {
        const float gam = 1.f - exp2f(-5.f - (float)h);
        float* S1 = P.out + O_RETS + (((size_t)l * 128 + sb) * 4 + h) * 2048 + (half * 16) * 64 + e;
        const float v0 = PR(0, C_VA + h * 64 + e), v1 = PR(1, C_VA + h * 64 + e), v2 = PR(2, C_VA + h * 64 + e), v3 = PR(3, C_VA + h * 64 + e);
        float o0 = 0.f, o1 = 0.f, o2 = 0.f, o3 = 0.f;
#pragma unroll
        for (int i = 0; i < 16; ++i) { float s = sa[i]; const int c = h * 32 + half * 16 + i;
            s = gam * s + ka[c] * v0; o0 += qa[c] * s; s = gam * s + ka[128 + c] * v1; o1 += qa[128 + c] * s;
            s = gam * s + ka[256 + c] * v2; o2 += qa[256 + c] * s; s = gam * s + ka[384 + c] * v3; o3 += qa[384 + c] * s; S1[i * 64] = s; __builtin_amdgcn_sched_barrier(0); }
        float* pp = part + (w * 2) * 256 + e; pp[0] = o0; pp[64] = o1; pp[128] = o2; pp[192] = o3;
    }
    { float a0 = 0.f, a1 = 0.f;
      for (int c0 = 0; c0 < 64; c0 += 16) { float wv[16];
#pragma unroll
          for (int i = 0; i < 16; ++i) wv[i] = wp[(c0 + i) * 64];
#pragma unroll
          for (int i = 0; i < 16; ++i) { a0 += pl[(2 * tp) * 256 + pg * 64 + c0 + i] * wv[i]; a1 += pl[(2 * tp + 1) * 256 + pg * 64 + c0 + i] * wv[i]; } }
      const float sc = P.pool_scale[l * 256 + pc];
      C.y[(R0 + 2 * tp) * WMIX + Y_C + pc] = f2bf(a0 * sc * silu_(PR(2 * tp, C_ZC + pc)));
      C.y[(R0 + 2 * tp + 1) * WMIX + Y_C + pc] = f2bf(a1 * sc * silu_(PR(2 * tp + 1, C_ZC + pc))); }
    __syncthreads();
    { const bool isd = w >= 4; const int hh = w & 3, c = hh * 64 + e;
      const float* p0 = part + ((2 * hh) * 2 + (isd ? 1 : 0)) * 256 + e; const float* p1 = p0 + 512;
      const float gs = isd ? P.g_hgrn[l * 256 + c] : 1.f; const int zc = isd ? C_ZD : C_ZA, yc = isd ? Y_D : Y_A;
#pragma unroll
      for (int t = 0; t < 4; ++t) { const float o = p0[t * 64] + p1[t * 64];
          const float r = rsqrtf(wave_sum(o * o) * (1.f / 64.f) + EPS);
          C.y[(R0 + t) * WMIX + yc + c] = f2bf(o * r * gs * silu_(PR(t, zc + c))); } }
    __syncthreads();
}
#undef PR

__device__ __forceinline__ void sample_branch_tile(Ctx& C, int l, int tile) {
    const int lane = C.lane, w = C.w, fr = lane & 15, fq = lane >> 4;
    const int r0 = M_P + (tile >> 4) * 32 + (w >> 2) * 16, c0 = (tile & 15) * 64 + (w & 3) * 16;
    const bf16_t* A = C.y + (size_t)(r0 + fr) * WMIX + fq * 8;
    const bf16_t* B = C.wb + (size_t)l * DM * WMIX + (size_t)(c0 + fr) * WMIX + fq * 8;
    f32x4 acc = {0.f, 0.f, 0.f, 0.f};
    float gv[4][4];
#pragma unroll
    for (int br = 0; br < 4; ++br)
#pragma unroll
        for (int j = 0; j < 4; ++j) gv[br][j] = bf2f(C.gates[(size_t)(r0 + fq * 4 + j) * NGATE + br * 1024 + c0 + fr]);
#pragma unroll
    for (int br = 0; br < 4; ++br) {
        const int k0 = br == 0 ? 0 : (br == 1 ? 256 : (br == 2 ? 768 : 1024)), k1 = br == 0 ? 256 : (br == 1 ? 768 : (br == 2 ? 1024 : 1280));
#pragma unroll 8
        for (int k = k0; k < k1; k += 32) acc = mfma16(*(const bf16x8*)(A + k), *(const bf16x8*)(B + k), acc);
#pragma unroll
        for (int j = 0; j < 4; ++j) { float sc = gv[br][j]; if (br < 3) sc *= __builtin_amdgcn_rcpf(gv[br + 1][j]); acc[j] *= sc; }
    }
#pragma unroll
    for (int j = 0; j < 4; ++j) C.mb[(size_t)(r0 + fq * 4 + j) * DM + c0 + fr] = f2bf(acc[j]);
}
__device__ __forceinline__ void sample_out_tile(Ctx& C, int l, int tile) {
    const int lane = C.lane, w = C.w, fr = lane & 15, fq = lane >> 4;
    const int r0 = M_P + (tile >> 4) * 32 + (w >> 2) * 16, c0 = (tile & 15) * 64 + (w & 3) * 16;
    const bf16_t* A = C.mb + (size_t)(r0 + fr) * DM + fq * 8;
    const bf16_t* B = C.wout + (size_t)l * DM * DM + (size_t)(c0 + fr) * DM + fq * 8;
    f32x4 acc = {0.f, 0.f, 0.f, 0.f};
#pragma unroll 8
    for (int k = 0; k < DM; k += 32) acc = mfma16(*(const bf16x8*)(A + k), *(const bf16x8*)(B + k), acc);
#pragma unroll
    for (int j = 0; j < 4; ++j) C.of[(size_t)(r0 + fq * 4 + j) * DM + c0 + fr] = acc[j];
}

__device__ __forceinline__ void phase_scan(const Params& P, Ctx& C, int l) {
    for (int g = C.bx * NTHREADS + C.tid; g < 49152; g += C.G * NTHREADS) {
        const bool isA = g < 16384;
        const int gg = isA ? g : g - 16384;
        const int b = isA ? (gg >> 13) : (gg >> 14), r = isA ? (gg & 8191) : (gg & 16383), h = isA ? (r >> 11) : (r >> 12), de = isA ? (r & 2047) : (r & 4095);
        float* base = isA ? C.kva + ((size_t)(b * 128) * 4 + h) * 2048 + de : C.kvd + ((size_t)(b * 128) * 4 + h) * 4096 + de;
        const size_t stride = isA ? 8192 : 16384;
        const float* dp = C.decd + (size_t)(b * 128) * 256 + h * 64 + (de >> 6);
        const float decA = __expf(64.f * log1pf(-exp2f(-5.f - (float)h)));
        const float* lp = base; float* sp = base; const float* dlp = dp;
        float S = 0.f, va[16], da[16];
#pragma unroll
        for (int i = 0; i < 16; ++i) { va[i] = *lp; lp += stride; da[i] = isA ? decA : *dlp; dlp += 256; }
        for (int blk = 0; blk < 8; ++blk) {
            float vb[16], db[16];
            if (blk < 7) {
#pragma unroll
                for (int i = 0; i < 16; ++i) { vb[i] = *lp; lp += stride; db[i] = isA ? decA : *dlp; dlp += 256; } }
#pragma unroll
            for (int i = 0; i < 16; ++i) { *sp = S; sp += stride; S = da[i] * S + va[i]; }
#pragma unroll
            for (int i = 0; i < 16; ++i) { va[i] = vb[i]; da[i] = db[i]; }
        }
        float* fin = isA ? P.out + O_RETP + (((size_t)l * 2 + b) * 4 + h) * 2048 + de : P.out + O_HGRNP + (((size_t)l * 2 + b) * 4 + h) * 4096 + de;
        *fin = S;
    }
}

__device__ __forceinline__ void phase_finalize(const Params& P, Ctx& C, int l) {
    const int lane = C.lane; const int stride = C.G * 8;
    for (int row0 = C.bx * 8 + C.w; row0 < M_TOT; row0 += 2 * stride) {
        const int row1 = row0 + stride; const bool has1 = row1 < M_TOT; const int r1 = has1 ? row1 : row0;
        const float4* oA = (const float4*)(C.of + (size_t)row0 * DM); float4* xA = (float4*)(P.out + (size_t)row0 * DM);
        const float4* oB = (const float4*)(C.of + (size_t)r1 * DM); float4* xB = (float4*)(P.out + (size_t)r1 * DM);
        float4 o0[4], x0[4], o1[4], x1[4]; float ss0 = 0.f, ss1 = 0.f;
#pragma unroll
        for (int i = 0; i < 4; ++i) { o0[i] = oA[lane + 64 * i]; x0[i] = xA[lane + 64 * i]; o1[i] = oB[lane + 64 * i]; x1[i] = xB[lane + 64 * i]; }
#pragma unroll
        for (int i = 0; i < 4; ++i) { ss0 += o0[i].x * o0[i].x + o0[i].y * o0[i].y + o0[i].z * o0[i].z + o0[i].w * o0[i].w; ss1 += o1[i].x * o1[i].x + o1[i].y * o1[i].y + o1[i].z * o1[i].z + o1[i].w * o1[i].w; }
        ss0 = wave_sum(ss0); ss1 = wave_sum(ss1);
        const float ra = rsqrtf(ss0 * (1.f / DM) + EPS), rb = rsqrtf(ss1 * (1.f / DM) + EPS);
        float s0 = 0.f, s1 = 0.f;
#pragma unroll
        for (int i = 0; i < 4; ++i) { const float4 g = ((const float4*)(P.g_post + l * DM))[lane + 64 * i];
            x0[i].x += o0[i].x * ra * g.x; x0[i].y += o0[i].y * ra * g.y; x0[i].z += o0[i].z * ra * g.z; x0[i].w += o0[i].w * ra * g.w;
            x1[i].x += o1[i].x * rb * g.x; x1[i].y += o1[i].y * rb * g.y; x1[i].z += o1[i].z * rb * g.z; x1[i].w += o1[i].w * rb * g.w;
            xA[lane + 64 * i] = x0[i]; if (has1) xB[lane + 64 * i] = x1[i];
            s0 += x0[i].x * x0[i].x + x0[i].y * x0[i].y + x0[i].z * x0[i].z + x0[i].w * x0[i].w; s1 += x1[i].x * x1[i].x + x1[i].y * x1[i].y + x1[i].z * x1[i].z + x1[i].w * x1[i].w; }
        if (l < 3) { s0 = wave_sum(s0); s1 = wave_sum(s1); const float qa = rsqrtf(s0 * (1.f / DM) + EPS), qb = rsqrtf(s1 * (1.f / DM) + EPS);
#pragma unroll
            for (int i = 0; i < 4; ++i) { const float4 g = ((const float4*)(P.g_pre + (l + 1) * DM))[lane + 64 * i];
                uint2 ov; ov.x = pk2(x0[i].x * qa * g.x, x0[i].y * qa * g.y); ov.y = pk2(x0[i].z * qa * g.z, x0[i].w * qa * g.w);
                ((uint2*)(C.h + (size_t)row0 * DM))[lane + 64 * i] = ov;
                if (has1) { uint2 ow; ow.x = pk2(x1[i].x * qb * g.x, x1[i].y * qb * g.y); ow.y = pk2(x1[i].z * qb * g.z, x1[i].w * qb * g.w);
                    ((uint2*)(C.h + (size_t)row1 * DM))[lane + 64 * i] = ow; } } }
    }
}

#ifndef PH_MASK
#define PH_MASK 2047
#endif
__global__ void __launch_bounds__(NTHREADS, 2) fwd_kernel(Params P) {
    extern __shared__ __attribute__((aligned(16))) unsigned char lds[];
    LAS unsigned char* ldsl = (LAS unsigned char*)lds;
    volatile LAS unsigned* bst = (volatile LAS unsigned*)(ldsl + LDS_BYTES - 16);
    if (threadIdx.x == 0) { bst[0] = 0u; bst[1] = 0u; if (P.coop) (void)xb_add((unsigned*)P.ws + XB_XCNT(xb_xcc_id()), 1u); }
    __syncthreads();

    for (int ph = P.ph_lo; ph < P.ph_hi; ++ph) {
        int nrep = 1;
#ifdef DUP_SP
        if (ph > 0 && ((ph - 1) % 7) == DUP_SP) nrep = 2;
        if (ph == 0 && DUP_SP == 7) nrep = 5;
#endif
        for (int rep = 0; rep < nrep; ++rep) {
        if (rep) xcd_barrier((unsigned*)P.ws, bst);
        int tid_ = threadIdx.x, bx = blockIdx.x, G_ = gridDim.x; __attribute__((address_space(1))) unsigned char* wsg = (__attribute__((address_space(1))) unsigned char*)P.ws;
        asm volatile("" : "+v"(tid_)); asm volatile("" : "+s"(bx)); asm volatile("" : "+s"(G_)); asm volatile("" : "+s"(wsg));
        unsigned char* ws = (unsigned char*)wsg;
        Ctx C;
        C.win = (bf16_t*)(ws + WS_WIN); C.wb = (bf16_t*)(ws + WS_WB); C.wout = (bf16_t*)(ws + WS_WOUT); C.h = (bf16_t*)(ws + WS_H); C.mb = (bf16_t*)(ws + WS_H);
        C.proj = (bf16_t*)(ws + WS_PROJ); C.mf = (float*)(ws + WS_PROJ); C.gates = (bf16_t*)(ws + WS_GATES); C.of = (float*)(ws + WS_GATES); C.y = (bf16_t*)(ws + WS_Y);
        C.kva = (float*)(ws + WS_KVA); C.kvd = (float*)(ws + WS_KVD); C.decd = (float*)(ws + WS_DECD);
        C.ropeAc = (float*)(ws + WS_ROPEA); C.ropeAs = C.ropeAc + NPOS * 16; C.ropeBc = (float*)(ws + WS_ROPEB); C.ropeBs = C.ropeBc + NPOS * 8; C.lbt = (float*)(ws + WS_LB);
        C.bx = bx; C.tid = tid_; C.lane = tid_ & 63; C.w = __builtin_amdgcn_readfirstlane(tid_ >> 6); C.G = G_;
        const int vcu = (C.G % 8 == 0) ? (bx % 8) * (C.G / 8) + bx / 8 : bx;
        if (ph == 0) { if (PH_MASK & 1) phase_prologue(P, C, lds); }
        else {
            const int l = (ph - 1) / 7, sp = (ph - 1) % 7;
            if (sp == 0) {
              if (PH_MASK & 2) {
                pg8::Gemm g{C.h, C.win + (size_t)l * DIN * DM, DM, DM}; pg8::StaticOrder S; S.init(M_TOT, DIN, DM, C.G, bx);
                pg8::EpiProj E{C.proj, C.gates};
                pg8::gemm_phase<pg8::EpiProj, pg8::StaticOrder>(ldsl, g, S, E, C.tid); }
            } else if (sp == 1) {
                for (int u = bx; u < 1280; u += C.G) {
                    asm volatile("" : "+v"(C.tid)); C.lane = C.tid & 63; C.w = __builtin_amdgcn_readfirstlane(C.tid >> 6);
                    if (u < 256) { if (PH_MASK & 4) attn_prompt_unit(P, C, l, u >> 7, (u & 127) >> 1, u & 1, lds); }
                    else if (u < 512) { if (PH_MASK & 32) lin_chunk<false, true>(P, C, l, (u - 256) >> 7, (u - 256) & 127, lds); }
                    else if (u < 768) { if (PH_MASK & 32) lin_chunk<true, true>(P, C, l, (u - 512) >> 7, (u - 512) & 127, lds); }
                    else if (u < 1024) { const int v = u - 768; if (PH_MASK & 8) { if (v < 128) { if (!(PH_MASK & 4096)) sample_b_unit(P, C, l, v, lds); } else { if (!(PH_MASK & 8192)) sample_adc_unit(P, C, l, v - 128, lds); } } }
                    else { if (PH_MASK & 16) pool_prompt_unit(P, C, l, u - 1024, lds); }
                }
            } else if (sp == 2) { if (PH_MASK & 64) phase_scan(P, C, l); }
            else if (sp == 3) {
                for (int u = bx; u < 512; u += C.G) {
                    asm volatile("" : "+v"(C.tid)); C.lane = C.tid & 63; C.w = __builtin_amdgcn_readfirstlane(C.tid >> 6);
                    if (u < 256) { if (PH_MASK & 128) lin_chunk<false, false>(P, C, l, u >> 7, u & 127, lds); }
                    else { if (PH_MASK & 128) lin_chunk<true, false>(P, C, l, (u - 256) >> 7, (u - 256) & 127, lds); }
                }
            } else if (sp == 4) {
              if (PH_MASK & 256) {
                for (int t = bx; t < 256; t += C.G) sample_branch_tile(C, l, t);
                pg8::Gemm g{C.y, C.wb + (size_t)l * DM * WMIX, WMIX, WMIX}; pg8::BranchOrder S{256, C.G, vcu};
                pg8::EpiBranch E{C.gates, C.mb};
                pg8::gemm_phase<pg8::EpiBranch, pg8::BranchOrder>(ldsl, g, S, E, C.tid); }
            } else if (sp == 5) {
              if (PH_MASK & 512) {
                for (int t = bx; t < 256; t += C.G) sample_out_tile(C, l, t);
                pg8::Gemm g{C.mb, C.wout + (size_t)l * DM * DM, DM, DM}; pg8::TileOrder S{256, C.G, vcu, DM / 64};
                pg8::EpiF32 E{C.of};
                pg8::gemm_phase<pg8::EpiF32, pg8::TileOrder>(ldsl, g, S, E, C.tid); }
            } else { if (PH_MASK & 1024) phase_finalize(P, C, l); }
        }
        }
        if (ph + 1 < P.ph_hi && P.coop) { if (ph == 0) cg::this_grid().sync(); else xcd_barrier((unsigned*)P.ws, bst); }
    }
}

#ifndef N_LAUNCH_MODE
#define N_LAUNCH_MODE 1
#endif
extern "C" void kernel_launch(void* const* d_in, const int* in_sizes, int n_in, void* d_out, int out_size, void* d_ws, size_t ws_size, hipStream_t stream) {
    static int grid = 0;
    if (grid == 0) {
        if (n_in != 17 || (size_t)out_size != O_END || ws_size < WS_END) { fprintf(stderr, "kernel_launch: unexpected sizes n_in %d out %d ws %zu\n", n_in, out_size, ws_size); grid = -1; return; }
        int dev = 0, cus = 0, per_cu = 0;
        hipGetDevice(&dev); hipDeviceGetAttribute(&cus, hipDeviceAttributeMultiprocessorCount, dev);
        if (hipFuncSetAttribute((const void*)fwd_kernel, hipFuncAttributeMaxDynamicSharedMemorySize, LDS_BYTES) != hipSuccess) { fprintf(stderr, "hipFuncSetAttribute failed\n"); grid = -1; return; }
        if (hipOccupancyMaxActiveBlocksPerMultiprocessor(&per_cu, (const void*)fwd_kernel, NTHREADS, LDS_BYTES) != hipSuccess || per_cu < 1) { fprintf(stderr, "occupancy query: %d\n", per_cu); per_cu = 1; }
        (void)hipGetLastError();
        grid = cus * 1;
        if (per_cu < 1) grid = -1;
    }
    if (grid < 0) return;
    Params p{};
    const float* const* in = (const float* const*)d_in;
    p.x_prompt = in[0]; p.x_sample = in[1]; p.state_ret = in[2]; p.cache_k = in[3]; p.cache_v = in[4]; p.state_pool = in[5]; p.state_hgrn = in[6];
    p.w_in = in[7]; p.w_branch = in[8]; p.w_out = in[9]; p.g_pre = in[10]; p.g_post = in[11]; p.attn_sink = in[12]; p.w_pool = in[13];
    p.pool_scale = in[14]; p.g_hgrn = in[15]; p.lower_bounds = in[16];
    p.out = (float*)d_out; p.ws = (unsigned char*)d_ws;
    for (int i = 0; i < 16; ++i) p.invA[i] = pow(10000.0, -(double)i / 16.0);
    for (int i = 0; i < 8; ++i) p.invB[i] = pow(500000.0, -(double)i / 8.0);
    const int NPH = 29;
#if N_LAUNCH_MODE == 1
    (void)hipMemsetAsync(d_ws, 0, 16384, stream);
    p.ph_lo = 0; p.ph_hi = NPH; p.coop = 1; p.pad = 0;
    void* args[] = {&p};
    hipError_t e = hipLaunchCooperativeKernel((const void*)fwd_kernel, dim3(grid), dim3(NTHREADS), args, LDS_BYTES, stream);
    if (e != hipSuccess) fprintf(stderr, "cooperative launch failed: %s (grid %d)\n", hipGetErrorString(e), grid);
#else
    for (int ph = 0; ph < NPH; ++ph) {
        p.ph_lo = ph; p.ph_hi = ph + 1; p.coop = 0; p.pad = 0;
        hipLaunchKernelGGL(fwd_kernel, dim3(grid), dim3(NTHREADS), LDS_BYTES, stream, p);
    }
#endif
}
```

```cpp
#include <hip/hip_runtime.h>
#include <hip/hip_cooperative_groups.h>
#include <cstdio>
#include <cstdint>
#include <cmath>
namespace cg = cooperative_groups;

#define LAS __attribute__((address_space(3)))
typedef unsigned short bf16_t;
typedef short bf16x8 __attribute__((ext_vector_type(8)));
typedef float f32x4 __attribute__((ext_vector_type(4)));
typedef unsigned u32x4 __attribute__((ext_vector_type(4)));

constexpr int M_TOT = 16896, M_P = 16384, DM = 1024, DIN = 7680, NPROJ = 3584, NGATE = 4096, WMIX = 1280;
constexpr int C_QA = 0, C_KA = 128, C_VA = 256, C_ZA = 512, C_QB = 768, C_KB = 1280, C_VB = 1408, C_ZB = 1536, C_UC = 2048, C_ZC = 2304,
              C_QD = 2560, C_FD = 2816, C_ID = 3072, C_ZD = 3328;
constexpr int Y_A = 0, Y_B = 256, Y_C = 768, Y_D = 1024;
constexpr size_t O_YP = 0, O_YS = 16777216, O_RETP = 17301504, O_KP = 17367040, O_VP = 17498112, O_POOLP = 17629184, O_HGRNP = 17659904,
                 O_RETS = 17790976, O_KS = 21985280, O_VS = 30373888, O_POOLS = 38762496, O_HGRNS = 40728576, O_END = 49117184;
constexpr float EPS = 1e-6f;
constexpr int NPOS = 8196;

constexpr size_t MiB = 1u << 20;
constexpr size_t WS_ROPEA = 1 * MiB;
constexpr size_t WS_ROPEB = 3 * MiB;
constexpr size_t WS_LB = 3 * MiB + 768 * 1024;
constexpr size_t WS_WIN = 4 * MiB;
constexpr size_t WS_WB = 64 * MiB;
constexpr size_t WS_WOUT = 74 * MiB;
constexpr size_t WS_H = 82 * MiB;
constexpr size_t WS_PROJ = 115 * MiB;
constexpr size_t WS_GATES = 231 * MiB;
constexpr size_t WS_Y = 363 * MiB;
constexpr size_t WS_KVA = 405 * MiB;
constexpr size_t WS_KVD = 413 * MiB;
constexpr size_t WS_DECD = 429 * MiB;
constexpr size_t WS_END = 430 * MiB;

constexpr int LDS_BYTES = 147456;
constexpr int NTHREADS = 512;

struct Params {
    const float* x_prompt; const float* x_sample; const float* state_ret; const float* cache_k; const float* cache_v; const float* state_pool; const float* state_hgrn;
    const float* w_in; const float* w_branch; const float* w_out; const float* g_pre; const float* g_post; const float* attn_sink; const float* w_pool;
    const float* pool_scale; const float* g_hgrn; const float* lower_bounds;
    float* out; unsigned char* ws;
    double invA[16]; double invB[8];
    int ph_lo, ph_hi, coop, pad;
};

__device__ __forceinline__ float bf2f(bf16_t v) { return __uint_as_float(((unsigned)v) << 16); }
__device__ __forceinline__ bf16_t f2bf(float f) { unsigned u = __float_as_uint(f); return (bf16_t)((u + 0x7fffu + ((u >> 16) & 1u)) >> 16); }
__device__ __forceinline__ unsigned pk2(float lo, float hi) { return (unsigned)f2bf(lo) | ((unsigned)f2bf(hi) << 16); }
__device__ __forceinline__ float lo16(unsigned u) { return __uint_as_float(u << 16); }
__device__ __forceinline__ float hi16(unsigned u) { return __uint_as_float(u & 0xffff0000u); }
__device__ __forceinline__ float sigmoid_(float x) { return 1.f / (1.f + __expf(-x)); }
__device__ __forceinline__ float silu_(float x) { return x / (1.f + __expf(-x)); }
__device__ __forceinline__ float wave_sum(float v) {
    v += __shfl_xor(v, 32); v += __shfl_xor(v, 16); v += __shfl_xor(v, 8); v += __shfl_xor(v, 4); v += __shfl_xor(v, 2); v += __shfl_xor(v, 1); return v;
}
__device__ __forceinline__ float quad16_sum(float v) { v += __shfl_xor(v, 8); v += __shfl_xor(v, 4); v += __shfl_xor(v, 2); v += __shfl_xor(v, 1); return v; }
__device__ __forceinline__ float quad16_max(float v) { v = fmaxf(v, __shfl_xor(v, 8)); v = fmaxf(v, __shfl_xor(v, 4)); v = fmaxf(v, __shfl_xor(v, 2)); v = fmaxf(v, __shfl_xor(v, 1)); return v; }
__device__ __forceinline__ f32x4 mfma16(bf16x8 a, bf16x8 b, f32x4 c) { return __builtin_amdgcn_mfma_f32_16x16x32_bf16(a, b, c, 0, 0, 0); }
__device__ __forceinline__ f32x4 mma_tile(const bf16_t* As, int lda, const bf16_t* Bs, int ldb, int K, f32x4 acc, int lane) {
    const bf16_t* ap = As + (lane & 15) * lda + (lane >> 4) * 8;
    const bf16_t* bp = Bs + (lane & 15) * ldb + (lane >> 4) * 8;
    for (int k = 0; k < K; k += 32) acc = mfma16(*(const bf16x8*)(ap + k), *(const bf16x8*)(bp + k), acc);
    return acc;
}

__device__ __forceinline__ void unpack8(const u32x4 a, float (&x)[8]) { x[0] = lo16(a.x); x[1] = hi16(a.x); x[2] = lo16(a.y); x[3] = hi16(a.y); x[4] = lo16(a.z); x[5] = hi16(a.z); x[6] = lo16(a.w); x[7] = hi16(a.w); }
__device__ __forceinline__ u32x4 pack8(const float (&x)[8]) { u32x4 w; w.x = pk2(x[0], x[1]); w.y = pk2(x[2], x[3]); w.z = pk2(x[4], x[5]); w.w = pk2(x[6], x[7]); return w; }

namespace pg8 {
constexpr int BM = 256, BK = 64, HALF = 128, HTB = HALF * BK * 2, STAGE_BYTES = 8 * HTB, NXCD = 8, WGM = 8;
__host__ __device__ __forceinline__ int lds_byte(int r, int c) { const int st = (r >> 4) * 2 + (c >> 5), rr = r & 15, cc = c & 31, ob = rr * 64 + cc * 2; return st * 1024 + (ob ^ (((ob >> 9) & 1) << 5)); }
__host__ __device__ __forceinline__ void stage_rc(int b, int& R, int& C) { const int st = b / 1024, sb = b % 1024, swz = sb ^ (((sb >> 9) & 1) << 5); R = (st >> 1) * 16 + swz / 64; C = (st & 1) * 32 + (swz % 64) / 2; }
__host__ __device__ __forceinline__ int perm32(int rho) { const int n = rho >> 4, i = rho & 15; return 8 * (i >> 2) + 4 * n + (i & 3); }

struct Unit { int pm, pn, k0, nt, br; };
struct Gemm { const bf16_t* A; const bf16_t* Bt; int lda, ldb; };

struct StaticOrder {
    int nM, nN, nwg, G, c, nt;
    __device__ void init(int M, int N, int K, int G_, int c_) { nM = M / BM; nN = N / BM; nwg = nM * nN; G = G_; c = c_; nt = K / BK; }
    __device__ bool next(int i, Unit& u) const {
        const long L = (long)i * G + c; if (L >= nwg) return false;
        int wgid = (int)L; { const int q = nwg / NXCD, r = nwg % NXCD, xcd = wgid % NXCD, off = wgid / NXCD; wgid = (xcd < r ? xcd * (q + 1) : r * (q + 1) + (xcd - r) * q) + off; }
        const int nig = WGM * nN, gid = wgid / nig, fm = gid * WGM, gsz = (nM - fm) < WGM ? (nM - fm) : WGM;
        u.pm = fm + ((wgid % nig) % gsz); u.pn = (wgid % nig) / gsz; u.k0 = 0; u.nt = nt; u.br = 0; return true;
    }
};
struct TileOrder {
    int ntiles, G, c, nt;
    __device__ bool next(int i, Unit& u) const { const int t = i * G + c; if (t >= ntiles) return false; u.pm = t >> 2; u.pn = t & 3; u.k0 = 0; u.nt = nt; u.br = 0; return true; }
};
struct BranchOrder {
    int ntiles, G, c;
    __device__ bool next(int i, Unit& u) const {
        const int t = (i >> 2) * G + c; if (t >= ntiles) return false; const int br = i & 3;
        u.pm = t >> 2; u.pn = t & 3; u.br = br; u.k0 = br == 0 ? 0 : (br == 1 ? 256 : (br == 2 ? 768 : 1024)); u.nt = br == 1 ? 8 : 4; return true;
    }
};

struct EpiProj {
    static __device__ __forceinline__ bool reset(const Unit&) { return true; }
    bf16_t* proj; bf16_t* gates;
    template <bool ISG> __device__ __forceinline__ void body(f32x4 (&acc)[2][2][4][2], bf16_t* base, int ld) const {
#pragma unroll
        for (int ai = 0; ai < 2; ++ai)
#pragma unroll
            for (int m = 0; m < 4; ++m) { bf16_t* rowp = base + (size_t)(ai * HALF + m * 16) * ld;
#pragma unroll
                for (int bj = 0; bj < 2; ++bj) { f32x4 v0 = acc[ai][bj][m][0], v1 = acc[ai][bj][m][1];
                    if (ISG) {
#pragma unroll
                        for (int i = 0; i < 4; ++i) { v0[i] = fmaxf(sigmoid_(v0[i]), 1e-6f); v1[i] = fmaxf(sigmoid_(v1[i]), 1e-6f); } }
                    u32x4 w; w.x = pk2(v0[0], v0[1]); w.y = pk2(v0[2], v0[3]); w.z = pk2(v1[0], v1[1]); w.w = pk2(v1[2], v1[3]);
                    *(u32x4*)(rowp + bj * HALF) = w; } }
    }
    __device__ __forceinline__ void operator()(f32x4 (&acc)[2][2][4][2], const Unit& u, int wr, int wc, int fr, int fq) const {
        const int row0 = u.pm * BM + wr * 64 + fr;
        if (u.pn >= 14) body<true>(acc, gates + (size_t)row0 * NGATE + (u.pn - 14) * BM + wc * 32 + 8 * fq, NGATE);
        else body<false>(acc, proj + (size_t)row0 * NPROJ + u.pn * BM + wc * 32 + 8 * fq, NPROJ);
    }
};
struct EpiBranch {
    static __device__ __forceinline__ bool reset(const Unit& u) { return u.br == 3; }
    const bf16_t* gates; bf16_t* mb;
    static __device__ __forceinline__ void scale8(f32x4& v0, f32x4& v1, const u32x4 g) {
        v0[0] *= lo16(g.x); v0[1] *= hi16(g.x); v0[2] *= lo16(g.y); v0[3] *= hi16(g.y); v1[0] *= lo16(g.z); v1[1] *= hi16(g.z); v1[2] *= lo16(g.w); v1[3] *= hi16(g.w); }
    static __device__ __forceinline__ void rscale8(f32x4& v0, f32x4& v1, const u32x4 g) {
        v0[0] *= __builtin_amdgcn_rcpf(lo16(g.x)); v0[1] *= __builtin_amdgcn_rcpf(hi16(g.x)); v0[2] *= __builtin_amdgcn_rcpf(lo16(g.y)); v0[3] *= __builtin_amdgcn_rcpf(hi16(g.y));
        v1[0] *= __builtin_amdgcn_rcpf(lo16(g.z)); v1[1] *= __builtin_amdgcn_rcpf(hi16(g.z)); v1[2] *= __builtin_amdgcn_rcpf(lo16(g.w)); v1[3] *= __builtin_amdgcn_rcpf(hi16(g.w)); }
    __device__ __forceinline__ void operator()(f32x4 (&acc)[2][2][4][2], const Unit& u, int wr, int wc, int fr, int fq) const {
        const int row0 = u.pm * BM + wr * 64 + fr, col0 = u.pn * BM + wc * 32 + 8 * fq;
        const bf16_t* gbase = gates + (size_t)row0 * NGATE + u.br * 1024 + col0;
        if (u.br < 3) {
#pragma unroll
            for (int ai = 0; ai < 2; ++ai)
#pragma unroll
                for (int mp = 0; mp < 2; ++mp) {
                    u32x4 g[2][2], gn[2][2];
#pragma unroll
                    for (int mm = 0; mm < 2; ++mm)
#pragma unroll
                        for (int bj = 0; bj < 2; ++bj) { const bf16_t* p = gbase + (size_t)(ai * HALF + (mp * 2 + mm) * 16) * NGATE + bj * HALF;
                            g[mm][bj] = *(const u32x4*)p; gn[mm][bj] = *(const u32x4*)(p + 1024); }
#pragma unroll
                    for (int mm = 0; mm < 2; ++mm)
#pragma unroll
                        for (int bj = 0; bj < 2; ++bj) { const int m = mp * 2 + mm;
                            scale8(acc[ai][bj][m][0], acc[ai][bj][m][1], g[mm][bj]); rscale8(acc[ai][bj][m][0], acc[ai][bj][m][1], gn[mm][bj]); }
                }
        } else {
#pragma unroll
            for (int ai = 0; ai < 2; ++ai)
#pragma unroll
                for (int mp = 0; mp < 2; ++mp) {
                    u32x4 g[2][2];
#pragma unroll
                    for (int mm = 0; mm < 2; ++mm)
#pragma unroll
                        for (int bj = 0; bj < 2; ++bj) g[mm][bj] = *(const u32x4*)(gbase + (size_t)(ai * HALF + (mp * 2 + mm) * 16) * NGATE + bj * HALF);
#pragma unroll
                    for (int mm = 0; mm < 2; ++mm)
#pragma unroll
                        for (int bj = 0; bj < 2; ++bj) { const int m = mp * 2 + mm;
                            f32x4 v0 = acc[ai][bj][m][0], v1 = acc[ai][bj][m][1]; scale8(v0, v1, g[mm][bj]);
                            u32x4 w; w.x = pk2(v0[0], v0[1]); w.y = pk2(v0[2], v0[3]); w.z = pk2(v1[0], v1[1]); w.w = pk2(v1[2], v1[3]);
                            *(u32x4*)(mb + (size_t)(row0 + ai * HALF + m * 16) * DM + col0 + bj * HALF) = w; }
                }
        }
    }
};
struct EpiF32 {
    static __device__ __forceinline__ bool reset(const Unit&) { return true; }
    bf16_t* o;
    __device__ __forceinline__ void operator()(f32x4 (&acc)[2][2][4][2], const Unit& u, int wr, int wc, int fr, int fq) const {
        const int row0 = u.pm * BM + wr * 64 + fr, col0 = u.pn * BM + wc * 32 + 8 * fq;
#pragma unroll
        for (int ai = 0; ai < 2; ++ai)
#pragma unroll
            for (int m = 0; m < 4; ++m) { bf16_t* rowp = o + (size_t)(row0 + ai * HALF + m * 16) * DM + col0;
#pragma unroll
                for (int bj = 0; bj < 2; ++bj) { const f32x4 v0 = acc[ai][bj][m][0], v1 = acc[ai][bj][m][1];
                    u32x4 w; w.x = pk2(v0[0], v0[1]); w.y = pk2(v0[2], v0[3]); w.z = pk2(v1[0], v1[1]); w.w = pk2(v1[2], v1[3]);
                    *(u32x4*)(rowp + bj * HALF) = w; } }
    }
};

template <class Epi, class Sched>
__device__ __forceinline__ void gemm_phase(LAS unsigned char* lds, const Gemm g, const Sched& S, const Epi& E, const int tid) {
    const int wid = __builtin_amdgcn_readfirstlane(tid >> 6), lane = tid & 63, wr = wid >> 2, wc = wid & 3, fr = lane & 15, fq = lane >> 4;
    unsigned voffA[2], voffB[2];
#pragma unroll
    for (int i = 0; i < 2; ++i) { int R, C; stage_rc(tid * 16 + i * 8192, R, C); const int Rb = (R & ~31) + perm32(R & 31);
        voffA[i] = (unsigned)(R * g.lda + C) * 2u; voffB[i] = (unsigned)(Rb * g.ldb + C) * 2u; }
    const size_t kstep = (size_t)(BK * 2);
    const size_t hstepA = (size_t)HALF * g.lda * 2, hstepB = (size_t)HALF * g.ldb * 2;
    const size_t tstepA = 2 * hstepA, tstepB = 2 * hstepB;
    const unsigned ldsw = (unsigned)wid * 1024u;
    const int aoff = lds_byte(wr * 64 + fr, fq * 8), boff = lds_byte(wc * 32 + fr, fq * 8);
#define PG8_SA(b, h) (((b) * 2 + (h)) * HTB)
#define PG8_SB(b, h) ((4 + (b) * 2 + (h)) * HTB)
#define PG8_STAGE(bufoff, gbase, voff) do { _Pragma("unroll") for (int _i = 0; _i < 2; ++_i) \
        __builtin_amdgcn_global_load_lds((const unsigned*)((const char*)(gbase) + (voff)[_i]), (LAS unsigned*)(lds + (bufoff) + ldsw + _i * 8192), 16, 0, 0); } while (0)
#define PG8_LDA(dst, b, h) do { _Pragma("unroll") for (int m = 0; m < 4; ++m) _Pragma("unroll") for (int k = 0; k < 2; ++k) dst[m][k] = *(const LAS bf16x8*)(lds + PG8_SA(b, h) + aoff + m * 2048 + k * 1024); } while (0)
#define PG8_LDB(dst, b, h) do { _Pragma("unroll") for (int n = 0; n < 2; ++n) _Pragma("unroll") for (int k = 0; k < 2; ++k) dst[n][k] = *(const LAS bf16x8*)(lds + PG8_SB(b, h) + boff + n * 2048 + k * 1024); } while (0)
#define PG8_MMA(ai, bj, At, Bt) do { __builtin_amdgcn_s_setprio(1); _Pragma("unroll") for (int m = 0; m < 4; ++m) _Pragma("unroll") for (int n = 0; n < 2; ++n) _Pragma("unroll") for (int k = 0; k < 2; ++k) \
        acc[ai][bj][m][n] = __builtin_amdgcn_mfma_f32_16x16x32_bf16(Bt[n][k], At[m][k], acc[ai][bj][m][n], 0, 0, 0); __builtin_amdgcn_s_setprio(0); } while (0)
#define PG8_WAIT_V(n) asm volatile("s_waitcnt vmcnt(" #n ")" ::: "memory")
#define PG8_WAIT_L(n) asm volatile("s_waitcnt lgkmcnt(" #n ")" ::: "memory")
#define PG8_BAR __builtin_amdgcn_s_barrier()
#define PG8_SCHED __builtin_amdgcn_sched_barrier(0)
    Unit cur, nxt; int ui = 0;
    if (!S.next(0, cur)) return;
    f32x4 acc[2][2][4][2];
#pragma unroll
    for (int a = 0; a < 2; ++a)
#pragma unroll
        for (int b = 0; b < 2; ++b)
#pragma unroll
            for (int m = 0; m < 4; ++m)
#pragma unroll
                for (int n = 0; n < 2; ++n) acc[a][b][m][n] = (f32x4){0.f, 0.f, 0.f, 0.f};
    bf16x8 At[4][2], B0[2][2], B1[2][2];
    const char* cA = (const char*)g.A + (size_t)cur.pm * tstepA + (size_t)cur.k0 * 2; const char* cB = (const char*)g.Bt + (size_t)cur.pn * tstepB + (size_t)cur.k0 * 2;
    PG8_STAGE(PG8_SB(0, 0), cB, voffB); PG8_STAGE(PG8_SB(0, 1), cB + hstepB, voffB); PG8_STAGE(PG8_SA(0, 0), cA, voffA); PG8_STAGE(PG8_SA(0, 1), cA + hstepA, voffA);
    if (wr == 1) PG8_BAR;
    PG8_WAIT_V(2); PG8_BAR;
    PG8_STAGE(PG8_SB(1, 0), cB + kstep, voffB); PG8_STAGE(PG8_SA(1, 0), cA + kstep, voffA); PG8_STAGE(PG8_SB(1, 1), cB + hstepB + kstep, voffB);
    PG8_WAIT_V(6); PG8_BAR;
    for (;;) {
        const bool has_next = S.next(ui + 1, nxt);
        const char* nA = has_next ? (const char*)g.A + (size_t)nxt.pm * tstepA + (size_t)nxt.k0 * 2 : cA;
        const char* nB = has_next ? (const char*)g.Bt + (size_t)nxt.pn * tstepB + (size_t)nxt.k0 * 2 : cB;
        const int nt = cur.nt;
        for (int t = 0; t < nt; t += 2) {
            const bool last = (t == nt - 2);
            const char* a1 = cA + (size_t)(t + 1) * kstep;
            const char* a2 = last ? nA : cA + (size_t)(t + 2) * kstep; const char* b2 = last ? nB : cB + (size_t)(t + 2) * kstep;
            const char* a3 = a2 + kstep; const char* b3 = b2 + kstep;
            PG8_LDB(B0, 0, 0); PG8_LDB(B1, 0, 1); PG8_SCHED; PG8_LDA(At, 0, 0); PG8_STAGE(PG8_SA(1, 1), a1 + hstepA, voffA);
            PG8_WAIT_V(8); PG8_WAIT_L(0); PG8_BAR; PG8_MMA(0, 0, At, B0); PG8_MMA(0, 1, At, B1); PG8_BAR; PG8_SCHED;
            PG8_LDA(At, 0, 1); PG8_STAGE(PG8_SB(0, 0), b2, voffB); PG8_STAGE(PG8_SB(0, 1), b2 + hstepB, voffB); PG8_STAGE(PG8_SA(0, 0), a2, voffA);
            PG8_WAIT_V(8); PG8_WAIT_L(0); PG8_BAR; PG8_MMA(1, 0, At, B0); PG8_MMA(1, 1, At, B1); PG8_BAR; PG8_SCHED;
            PG8_LDB(B0, 1, 0); PG8_LDB(B1, 1, 1); PG8_SCHED; PG8_LDA(At, 1, 0); PG8_STAGE(PG8_SA(0, 1), a2 + hstepA, voffA);
            PG8_WAIT_V(8); PG8_WAIT_L(0); PG8_BAR; PG8_MMA(0, 0, At, B0); PG8_MMA(0, 1, At, B1); PG8_BAR; PG8_SCHED;
            PG8_LDA(At, 1, 1); PG8_STAGE(PG8_SB(1, 0), b3, voffB); PG8_STAGE(PG8_SB(1, 1), b3 + hstepB, voffB); PG8_STAGE(PG8_SA(1, 0), a3, voffA);
            PG8_WAIT_V(8); PG8_WAIT_L(0); PG8_BAR; PG8_MMA(1, 0, At, B0); PG8_MMA(1, 1, At, B1); PG8_BAR; PG8_SCHED;
        }
        if (wr == 0) PG8_BAR;
        E(acc, cur, wr, wc, fr, fq);
        if (!has_next) break;
        if (Epi::reset(cur))
#pragma unroll
        for (int a = 0; a < 2; ++a)
#pragma unroll
            for (int b = 0; b < 2; ++b)
#pragma unroll
                for (int m = 0; m < 4; ++m)
#pragma unroll
                    for (int n = 0; n < 2; ++n) acc[a][b][m][n] = (f32x4){0.f, 0.f, 0.f, 0.f};
        cur = nxt; cA = nA; cB = nB; ++ui;
        if (wr == 1) PG8_BAR;
    }
    PG8_WAIT_V(0);
    PG8_BAR;
#undef PG8_SA
#undef PG8_SB
#undef PG8_STAGE
#undef PG8_LDA
#undef PG8_LDB
#undef PG8_MMA
#undef PG8_WAIT_V
#undef PG8_WAIT_L
#undef PG8_BAR
#undef PG8_SCHED
}
}


#define XB_TMO      128
#define XB_XCNT(j)  (256  + 64 * (j))
#define XB_XSUB(j)  (1280 + 64 * (j))
#define XB_XGEN(j)  (2304 + 64 * (j))
#define XB_TOP      3328
#define XB_TOPGEN   3392
#define XCD_BAR_WORDS 3456
#define XB_SPIN_CAP (1u << 18)
__device__ __forceinline__ unsigned xb_ld(unsigned* p)              { return __hip_atomic_load(p, __ATOMIC_RELAXED, __HIP_MEMORY_SCOPE_AGENT); }
__device__ __forceinline__ unsigned xb_add(unsigned* p, unsigned v) { return __hip_atomic_fetch_add(p, v, __ATOMIC_RELAXED, __HIP_MEMORY_SCOPE_AGENT); }
__device__ __forceinline__ unsigned xb_xcc_id() { return (unsigned)__builtin_amdgcn_s_getreg((3 << 11) | 20) & 0xFu; }
#define XB_SPIN(cond, bar) do { unsigned _sp = 0; while (cond) { __builtin_amdgcn_s_sleep(1); \
    if ((++_sp & 255u) == 0u) { if (xb_ld(&(bar)[XB_TMO])) break; if (_sp > XB_SPIN_CAP) { atomicAdd(&(bar)[XB_TMO], 1u); break; } } } } while (0)
__device__ __forceinline__ void xcd_barrier_complete(unsigned* bar, unsigned x, unsigned& nloc, unsigned& nx) {
    const unsigned G = gridDim.x * gridDim.y * gridDim.z;
    unsigned sum, cnt, mine, sp = 0u;
    for (;;) {
        sum = 0u; cnt = 0u; mine = 0u;
#pragma unroll
        for (unsigned j = 0; j < 16; ++j) { const unsigned c = xb_ld(&bar[XB_XCNT(j)]); sum += c; cnt += (c > 0u) ? 1u : 0u; mine = (j == x) ? c : mine; }
        if (sum == G) break;
        __builtin_amdgcn_s_sleep(1);
        if ((++sp & 255u) == 0u) { if (xb_ld(&bar[XB_TMO])) break; if (sp > XB_SPIN_CAP) { atomicAdd(&bar[XB_TMO], 1u); break; } }
    }
    nloc = mine > 0u ? mine : 1u; nx = cnt > 0u ? cnt : 1u;
}
__device__ __forceinline__ void xcd_barrier(unsigned* bar, volatile LAS unsigned* st) {
    asm volatile("s_waitcnt vmcnt(0)" ::: "memory");
    __syncthreads();
    if (threadIdx.x == 0) {
        const unsigned x = xb_xcc_id();
        __builtin_amdgcn_s_waitcnt(0);
        unsigned nloc = st[0], nx = st[1];
        if (nloc == 0u) { xcd_barrier_complete(bar, x, nloc, nx); st[0] = nloc; st[1] = nx; }
        const unsigned old = xb_add(&bar[XB_XSUB(x)], 1u);
        const unsigned gen = old / nloc;
        if (old + 1u == (gen + 1u) * nloc) {
            __builtin_amdgcn_fence(__ATOMIC_RELEASE, "agent");
            asm volatile("s_waitcnt vmcnt(0)" ::: "memory");
            const unsigned og = xb_add(&bar[XB_TOP], 1u);
            const unsigned tg = og / nx;
            if (og + 1u == (tg + 1u) * nx) xb_add(&bar[XB_TOPGEN], 1u);
            else XB_SPIN(xb_ld(&bar[XB_TOPGEN]) == tg, bar);
            __builtin_amdgcn_fence(__ATOMIC_ACQUIRE, "agent");
            xb_add(&bar[XB_XGEN(x)], 1u);
            asm volatile("s_waitcnt vmcnt(0)" ::: "memory");
        } else {
            XB_SPIN(xb_ld(&bar[XB_XGEN(x)]) == gen, bar);
            __builtin_amdgcn_fence(__ATOMIC_ACQUIRE, "agent");
            asm volatile("s_waitcnt vmcnt(0)" ::: "memory");
        }
    }
    __syncthreads();
}

struct Ctx {
    int bx;
    bf16_t *win, *wb, *wout, *h, *proj, *gates, *y, *mb;
    float *mf, *of, *kva, *kvd, *decd, *ropeAc, *ropeAs, *ropeBc, *ropeBs, *lbt;
    int tid, lane, w, G;
};

struct TJob { const float* src; bf16_t* dst; int N, Kp; };
__device__ __forceinline__ TJob tjob_decode(const Params& P, Ctx& C, int job) {
    const int l = job / 2496, j = job % 2496; TJob t; int kt, nt;
    if (j < 1920) { kt = j / 120; nt = j % 120; t.N = DIN; t.Kp = DM; t.src = P.w_in + (size_t)l * DM * DIN; t.dst = C.win + (size_t)l * DIN * DM; }
    else if (j < 2240) { const int jj = j - 1920; kt = jj / 16; nt = jj % 16; t.N = DM; t.Kp = WMIX; t.src = P.w_branch + (size_t)l * WMIX * DM; t.dst = C.wb + (size_t)l * DM * WMIX; }
    else { const int jj = j - 2240; kt = jj / 16; nt = jj % 16; t.N = DM; t.Kp = DM; t.src = P.w_out + (size_t)l * DM * DM; t.dst = C.wout + (size_t)l * DM * DM; }
    t.src += (size_t)(kt * 64) * t.N + nt * 64; t.dst += (size_t)(nt * 64) * t.Kp + kt * 64; return t;
}

__device__ __forceinline__ void phase_prologue(const Params& P, Ctx& C, unsigned char* lds) {
    const int tid = C.tid;
    float* scr = (float*)lds;
    {
        const int kk = tid >> 3, c8 = (tid & 7) * 8, n = tid >> 3, k8 = (tid & 7) * 8;
        int job = C.bx, par = 0; float4 a, b; TJob cur;
        if (job < 4 * 2496) { cur = tjob_decode(P, C, job); const float4* sp = (const float4*)(cur.src + (size_t)kk * cur.N + c8); a = sp[0]; b = sp[1]; }
        while (job < 4 * 2496) {
            float* r = scr + par * (64 * 65) + kk * 65 + c8;
            r[0] = a.x; r[1] = a.y; r[2] = a.z; r[3] = a.w; r[4] = b.x; r[5] = b.y; r[6] = b.z; r[7] = b.w;
            const int nxt = job + C.G; TJob nj;
            if (nxt < 4 * 2496) { nj = tjob_decode(P, C, nxt); const float4* sp = (const float4*)(nj.src + (size_t)kk * nj.N + c8); a = sp[0]; b = sp[1]; }
            __syncthreads();
            const float* q = scr + par * (64 * 65) + k8 * 65 + n;
            u32x4 wv; wv.x = pk2(q[0], q[65]); wv.y = pk2(q[130], q[195]); wv.z = pk2(q[260], q[325]); wv.w = pk2(q[390], q[455]);
            *(u32x4*)(cur.dst + (size_t)n * cur.Kp + k8) = wv;
            cur = nj; job = nxt; par ^= 1;
        }
        __syncthreads();
    }
    for (int row = C.bx * 8 + C.w; row < M_TOT; row += C.G * 8) {
        const float* xs = row < M_P ? P.x_prompt + (size_t)row * DM : P.x_sample + (size_t)(row - M_P) * DM;
        float4 x[4]; float ss = 0.f;
#pragma unroll
        for (int i = 0; i < 4; ++i) { x[i] = ((const float4*)xs)[C.lane + 64 * i]; ss += x[i].x * x[i].x + x[i].y * x[i].y + x[i].z * x[i].z + x[i].w * x[i].w; }
        ss = wave_sum(ss); const float r = rsqrtf(ss * (1.f / DM) + EPS);
#pragma unroll
        for (int i = 0; i < 4; ++i) { ((float4*)(P.out + (size_t)row * DM))[C.lane + 64 * i] = x[i];
            const float4 g = ((const float4*)P.g_pre)[C.lane + 64 * i];
            uint2 o; o.x = pk2(x[i].x * r * g.x, x[i].y * r * g.y); o.y = pk2(x[i].z * r * g.z, x[i].w * r * g.w);
            ((uint2*)(C.h + (size_t)row * DM))[C.lane + 64 * i] = o; }
    }
    const int gt = C.bx * NTHREADS + tid, gn = C.G * NTHREADS;
    const double TWO_PI = 6.283185307179586476925286766559, INV_2PI = 0.15915494309189533576888376337251;
    for (int i = gt; i < NPOS * 24; i += gn) {
        int pos, f; double inv;
        if (i < NPOS * 16) { pos = i >> 4; f = i & 15; inv = P.invA[f]; } else { const int k = i - NPOS * 16; pos = k >> 3; f = k & 7; inv = P.invB[f]; }
        double r = (double)pos * inv * INV_2PI; r -= floor(r);
        const float a = (float)(r * TWO_PI);
        const float cs = cosf(a), sn = sinf(a);
        if (i < NPOS * 16) { C.ropeAc[i] = cs; C.ropeAs[i] = sn; } else { C.ropeBc[i - NPOS * 16] = cs; C.ropeBs[i - NPOS * 16] = sn; }
    }
    for (int c = gt; c < 256; c += gn) {
        const float v0 = P.lower_bounds[c], v1 = P.lower_bounds[256 + c], v2 = P.lower_bounds[512 + c], v3 = P.lower_bounds[768 + c];
        const float m = fmaxf(fmaxf(v0, v1), fmaxf(v2, v3));
        const float e0 = expf(v0 - m), e1 = expf(v1 - m), e2 = expf(v2 - m), e3 = expf(v3 - m), inv = 1.f / (e0 + e1 + e2 + e3);
        C.lbt[c] = 0.f; C.lbt[256 + c] = e1 * inv; C.lbt[512 + c] = (e1 + e2) * inv; C.lbt[768 + c] = (e1 + e2 + e3) * inv;
    }
}

__device__ __forceinline__ void attn_prompt_unit(const Params& P, Ctx& C, int l, int b, int qb, int kvh, unsigned char* lds) {
    const int tid = C.tid, lane = C.lane, w = C.w, fr = lane & 15, fq = lane >> 4;
    bf16_t* Ks = (bf16_t*)lds;
    bf16_t* Vt = (bf16_t*)(lds + 36864);
    bf16_t* Ps = (bf16_t*)(lds + 36864 + 35840) + w * (16 * 168);
    const int t0 = qb * 128; const size_t R0 = (size_t)b * 8192 + t0;
    const bool last = (qb == 63);
#pragma unroll 2
    for (int it = 0; it < 4; ++it) { const int i = tid + it * NTHREADS;
      if (i < 256 * 7) {
        const int kk = i / 7, task = i - kk * 7, tk = t0 - 128 + kk;
        bf16_t* dst = Ks + kk * 72;
        if (tk < 0) { const u32x4 z = {0u, 0u, 0u, 0u}; if (task == 0) { *(u32x4*)dst = z; *(u32x4*)(dst + 8) = z; } else *(u32x4*)(dst + (task + 1) * 8) = z; }
        else {
            const bf16_t* src = C.proj + (size_t)(b * 8192 + tk) * NPROJ + C_KB + kvh * 64;
            if (task == 0) {
                const u32x4 a = *(const u32x4*)src, bb = *(const u32x4*)(src + 8);
                const float4 c0 = *(const float4*)(C.ropeBc + tk * 8), c1 = *(const float4*)(C.ropeBc + tk * 8 + 4), s0 = *(const float4*)(C.ropeBs + tk * 8), s1 = *(const float4*)(C.ropeBs + tk * 8 + 4);
                float x1[8], x2[8]; unpack8(a, x1); unpack8(bb, x2);
                const float cs[8] = {c0.x, c0.y, c0.z, c0.w, c1.x, c1.y, c1.z, c1.w}, sn[8] = {s0.x, s0.y, s0.z, s0.w, s1.x, s1.y, s1.z, s1.w};
                float r1[8], r2[8];
#pragma unroll
                for (int j = 0; j < 8; ++j) { r1[j] = x1[j] * cs[j] - x2[j] * sn[j]; r2[j] = x2[j] * cs[j] + x1[j] * sn[j]; }
                *(u32x4*)dst = pack8(r1); *(u32x4*)(dst + 8) = pack8(r2);
            } else { const int c = task + 1; *(u32x4*)(dst + c * 8) = *(const u32x4*)(src + c * 8); }
        }
      } }
#pragma unroll
    for (int it = 0; it < 4; ++it) { const int i = tid + it * NTHREADS;
        const int kk = i & 255, c = i >> 8, tk = t0 - 128 + kk;
        u32x4 a = {0u, 0u, 0u, 0u};
        if (tk >= 0) a = *(const u32x4*)(C.proj + (size_t)(b * 8192 + tk) * NPROJ + C_VB + kvh * 64 + c * 8);
        bf16_t* d = Vt + (c * 8) * 280 + kk;
        d[0] = (bf16_t)(a.x & 0xffff); d[280] = (bf16_t)(a.x >> 16); d[560] = (bf16_t)(a.y & 0xffff); d[840] = (bf16_t)(a.y >> 16);
        d[1120] = (bf16_t)(a.z & 0xffff); d[1400] = (bf16_t)(a.z >> 16); d[1680] = (bf16_t)(a.w & 0xffff); d[1960] = (bf16_t)(a.w >> 16);
    }
    for (int i = tid; i < 64 * 24; i += NTHREADS) Vt[(i / 24) * 280 + 256 + (i % 24)] = 0;
    for (int i = lane; i < 16 * 16; i += 64) Ps[(i >> 4) * 168 + 144 + (i & 15)] = 0;
    __syncthreads();
    if (last) {
        for (int i = tid; i < 128 * 64; i += NTHREADS) { const int wq = i >> 6, d = i & 63;
            const size_t o = ((((size_t)l * 2 + b) * 128 + wq) * 2 + kvh) * 64 + d;
            P.out[O_KP + o] = bf2f(Ks[(128 + wq) * 72 + d]); P.out[O_VP + o] = bf2f(Vt[d * 280 + 128 + wq]); }
    }
    const int tq = t0 + w * 16 + fr;
#pragma unroll
    for (int g = 0; g < 4; ++g) {
        const int h = kvh * 4 + g;
        const bf16_t* qsrc = C.proj + (R0 + w * 16 + fr) * NPROJ + C_QB + h * 64;
        u32x4 q0 = *(const u32x4*)(qsrc + fq * 8); const u32x4 q1 = *(const u32x4*)(qsrc + 32 + fq * 8);
        if (fq < 2) {
            const u32x4 qp = *(const u32x4*)(qsrc + (fq ^ 1) * 8);
            const float4 c0 = *(const float4*)(C.ropeBc + tq * 8), c1 = *(const float4*)(C.ropeBc + tq * 8 + 4), s0 = *(const float4*)(C.ropeBs + tq * 8), s1 = *(const float4*)(C.ropeBs + tq * 8 + 4);
            const float sg = fq == 0 ? -1.f : 1.f;
            const float own[8] = {lo16(q0.x), hi16(q0.x), lo16(q0.y), hi16(q0.y), lo16(q0.z), hi16(q0.z), lo16(q0.w), hi16(q0.w)};
            const float par[8] = {lo16(qp.x), hi16(qp.x), lo16(qp.y), hi16(qp.y), lo16(qp.z), hi16(qp.z), lo16(qp.w), hi16(qp.w)};
            const float cs[8] = {c0.x, c0.y, c0.z, c0.w, c1.x, c1.y, c1.z, c1.w}, sn[8] = {s0.x, s0.y, s0.z, s0.w, s1.x, s1.y, s1.z, s1.w};
            float r[8];
#pragma unroll
            for (int j = 0; j < 8; ++j) r[j] = own[j] * cs[j] + sg * par[j] * sn[j];
            q0.x = pk2(r[0], r[1]); q0.y = pk2(r[2], r[3]); q0.z = pk2(r[4], r[5]); q0.w = pk2(r[6], r[7]);
        }
        const bf16x8 qa0 = __builtin_bit_cast(bf16x8, q0), qa1 = __builtin_bit_cast(bf16x8, q1);
        f32x4 S[9];
#pragma unroll
        for (int jt = 0; jt < 9; ++jt) {
            const bf16_t* kp = Ks + ((w + jt) * 16 + fr) * 72 + fq * 8;
            f32x4 a = {0.f, 0.f, 0.f, 0.f};
            a = mfma16(qa0, *(const bf16x8*)kp, a); a = mfma16(qa1, *(const bf16x8*)(kp + 32), a);
            S[jt] = a;
        }
        const float sink = P.attn_sink[l * 8 + h];
        float mx[4], sm[4];
#pragma unroll
        for (int j = 0; j < 4; ++j) {
            const int r = w * 16 + fq * 4 + j;
            float m = -1e30f;
#pragma unroll
            for (int jt = 0; jt < 9; ++jt) { const int kk = (w + jt) * 16 + fr; const bool ok = (kk >= r) && (kk <= r + 128) && (t0 - 128 + kk >= 0);
                const float s = ok ? S[jt][j] * 0.125f : -1e30f; S[jt][j] = s; m = fmaxf(m, s); }
            m = fmaxf(quad16_max(m), sink); mx[j] = m;
            float su = 0.f;
#pragma unroll
            for (int jt = 0; jt < 9; ++jt) { const float p = __expf(S[jt][j] - m); su += p; Ps[(fq * 4 + j) * 168 + jt * 16 + fr] = f2bf(p); }
            su = quad16_sum(su) + __expf(sink - m); sm[j] = 1.f / su;
        }
        __syncthreads();
        float zz[4][4];
#pragma unroll
        for (int j = 0; j < 4; ++j)
#pragma unroll
            for (int nt = 0; nt < 4; ++nt) zz[j][nt] = bf2f(C.proj[(R0 + w * 16 + fq * 4 + j) * NPROJ + C_ZB + h * 64 + nt * 16 + fr]);
        f32x4 O[4];
#pragma unroll
        for (int nt = 0; nt < 4; ++nt) O[nt] = (f32x4){0.f, 0.f, 0.f, 0.f};
#pragma unroll
        for (int kx = 0; kx < 5; ++kx) {
            const bf16x8 a = *(const bf16x8*)(Ps + fr * 168 + kx * 32 + fq * 8);
#pragma unroll
            for (int nt = 0; nt < 4; ++nt) O[nt] = mfma16(a, *(const bf16x8*)(Vt + (nt * 16 + fr) * 280 + w * 16 + kx * 32 + fq * 8), O[nt]);
        }
#pragma unroll
        for (int j = 0; j < 4; ++j) {
            const size_t row = R0 + w * 16 + fq * 4 + j;
#pragma unroll
            for (int nt = 0; nt < 4; ++nt) { const int e = nt * 16 + fr;
                C.y[row * WMIX + Y_B + h * 64 + e] = f2bf(O[nt][j] * sm[j] * silu_(zz[j][nt])); }
        }
        __syncthreads();
    }
}

__device__ __forceinline__ void pool_prompt_unit(const Params& P, Ctx& C, int l, int tile, unsigned char* lds) {
    const int tid = C.tid, lane = C.lane, w = C.w, fr = lane & 15, fq = lane >> 4;
    bf16_t* U = (bf16_t*)lds;
    bf16_t* A = (bf16_t*)(lds + 40448);
    bf16_t* Wt = (bf16_t*)(lds + 40448 + 33792);
    const int b = tile >> 7, t0 = (tile & 127) * 64; const size_t R0 = (size_t)b * 8192 + t0;
    for (int i = tid; i < 79 * 32; i += NTHREADS) { const int r = i >> 5, c = i & 31, t = t0 - 15 + r;
        u32x4 a = {0u, 0u, 0u, 0u}; if (t >= 0) a = *(const u32x4*)(C.proj + (size_t)(b * 8192 + t) * NPROJ + C_UC + c * 8);
        *(u32x4*)(U + r * 256 + c * 8) = a; }
    for (int i = tid; i < 4 * 64 * 64; i += NTHREADS) { const int g = i >> 12, cin = (i >> 6) & 63, dout = i & 63;
        Wt[(g * 64 + dout) * 72 + cin] = f2bf(P.w_pool[(size_t)l * 16384 + i]); }
    __syncthreads();
    { const int c = tid & 255, rh = tid >> 8, g = c >> 6, wn = 2 << g;
      for (int r = rh * 32; r < rh * 32 + 32; ++r) {
          float s = 0.f; for (int j = 0; j < wn; ++j) s += bf2f(U[(r + 15 - j) * 256 + c]);
          const int pos = t0 + r; const float cnt = (float)(pos + 1 < wn ? pos + 1 : wn);
          const float u = bf2f(U[(r + 15) * 256 + c]);
          A[r * 264 + c] = f2bf(s / cnt - u);
          if (t0 == 8128 && r >= 49) P.out[O_POOLP + (((size_t)l * 2 + b) * 15 + (r - 49)) * 256 + c] = u;
      } }
    __syncthreads();
    for (int tl = w; tl < 64; tl += 8) { const int rt = tl >> 4, ct = tl & 15, g = ct >> 2;
        f32x4 acc = {0.f, 0.f, 0.f, 0.f};
        acc = mma_tile(A + rt * 16 * 264 + g * 64, 264, Wt + (g * 64 + (ct & 3) * 16) * 72, 72, 64, acc, lane);
        const int c = ct * 16 + fr; const float sc = P.pool_scale[l * 256 + c];
        float zz[4];
#pragma unroll
        for (int j = 0; j < 4; ++j) zz[j] = bf2f(C.proj[(R0 + rt * 16 + fq * 4 + j) * NPROJ + C_ZC + c]);
#pragma unroll
        for (int j = 0; j < 4; ++j) { const size_t row = R0 + rt * 16 + fq * 4 + j;
            C.y[row * WMIX + Y_C + c] = f2bf(acc[j] * sc * silu_(zz[j])); }
    }
    __syncthreads();
}

template <bool IS_D, bool KV>
__device__ __forceinline__ void lin_chunk(const Params& P, Ctx& C, int l, int b, int n, unsigned char* lds) {
    const int lane = C.lane, w = C.w, fr = lane & 15, fq = lane >> 4;
    constexpr int DK = IS_D ? 64 : 32, NCG = DK / 8, HPR = KV ? 4 : 2;
    constexpr int SLOT = KV ? 18432 : 53248, VP = KV ? 72 : 136;
    const size_t R0 = (size_t)b * 8192 + n * 64;
    const bf16_t* prow = C.proj + (R0 + lane) * NPROJ;
    for (int h0 = 0; h0 < 4; h0 += HPR) {
        float decv[(HPR * NCG) / 8][8];
#pragma unroll
        for (int ti = 0; ti < (HPR * NCG) / 8; ++ti) { const int task = w + ti * 8;
            const int hh = task / NCG, cg = task % NCG, h = h0 + hh, d0 = cg * 8;
            unsigned char* slot = lds + hh * SLOT;
            float q[8], k[8], Bt[8], Bm[8], Bl[8];
            if (IS_D) {
                float qv[8], fv[8]; unpack8(*(const u32x4*)(prow + C_QD + h * 64 + d0), qv); unpack8(*(const u32x4*)(prow + C_FD + h * 64 + d0), fv);
                const float4 l0 = *(const float4*)(C.lbt + l * 256 + h * 64 + d0), l1 = *(const float4*)(C.lbt + l * 256 + h * 64 + d0 + 4);
                const float lb[8] = {l0.x, l0.y, l0.z, l0.w, l1.x, l1.y, l1.z, l1.w};
#pragma unroll
                for (int j = 0; j < 8; ++j) { const float f = lb[j] + (1.f - lb[j]) * sigmoid_(fv[j]); q[j] = silu_(qv[j]); k[j] = 1.f - f;
                    float v = __logf(f);
#pragma unroll
                    for (int off = 1; off < 64; off <<= 1) { const float u = __shfl_up(v, off); if (lane >= off) v += u; }
                    Bt[j] = v; Bm[j] = __shfl(v, 31); Bl[j] = __shfl(v, 63); }
#pragma unroll
                for (int j = 0; j < 8; ++j) decv[ti][j] = Bl[j];
            } else {
                const float lg = log1pf(-exp2f(-5.f - (float)h));
                const int i0 = d0 & 15, pos = n * 64 + lane;
                float q1[8], q2[8], k1[8], k2[8];
                unpack8(*(const u32x4*)(prow + C_QA + h * 32 + i0), q1); unpack8(*(const u32x4*)(prow + C_QA + h * 32 + 16 + i0), q2);
                unpack8(*(const u32x4*)(prow + C_KA + h * 32 + i0), k1); unpack8(*(const u32x4*)(prow + C_KA + h * 32 + 16 + i0), k2);
                const float4 c0 = *(const float4*)(C.ropeAc + pos * 16 + i0), c1 = *(const float4*)(C.ropeAc + pos * 16 + i0 + 4), s0 = *(const float4*)(C.ropeAs + pos * 16 + i0), s1 = *(const float4*)(C.ropeAs + pos * 16 + i0 + 4);
                const float cs[8] = {c0.x, c0.y, c0.z, c0.w, c1.x, c1.y, c1.z, c1.w}, sn[8] = {s0.x, s0.y, s0.z, s0.w, s1.x, s1.y, s1.z, s1.w};
#pragma unroll
                for (int j = 0; j < 8; ++j) {
                    q[j] = d0 < 16 ? q1[j] * cs[j] - q2[j] * sn[j] : q2[j] * cs[j] + q1[j] * sn[j];
                    k[j] = (d0 < 16 ? k1[j] * cs[j] - k2[j] * sn[j] : k2[j] * cs[j] + k1[j] * sn[j]) * 0.17677669529663687f;
                    Bt[j] = (float)(lane + 1) * lg; Bm[j] = 32.f * lg; Bl[j] = 64.f * lg; }
            }
            if (!KV) {
                bf16_t* Qh = (bf16_t*)slot; bf16_t* Kh = (bf16_t*)(slot + 9216); bf16_t* PQ = (bf16_t*)(slot + 18432);
                float a[8], c[8], e[8];
#pragma unroll
                for (int j = 0; j < 8; ++j) { a[j] = q[j] * __expf(Bt[j] - Bm[j]); c[j] = k[j] * __expf(Bm[j] - Bt[j]); e[j] = q[j] * __expf(Bt[j]); }
                *(u32x4*)(Qh + lane * 72 + d0) = pack8(a); *(u32x4*)(Kh + lane * 72 + d0) = pack8(c); *(u32x4*)(PQ + lane * 136 + 64 + d0) = pack8(e);
            } else {
                bf16_t* KdT = (bf16_t*)slot;
#pragma unroll
                for (int j = 0; j < 8; ++j) KdT[(d0 + j) * 72 + lane] = f2bf(k[j] * __expf(Bl[j] - Bt[j]));
            }
        }
        if (IS_D && KV && lane == 63) {
#pragma unroll
            for (int ti = 0; ti < (HPR * NCG) / 8; ++ti) { const int task = w + ti * 8, h = h0 + task / NCG, d0 = (task % NCG) * 8;
#pragma unroll
                for (int j = 0; j < 8; ++j) C.decd[(size_t)(b * 128 + n) * 256 + h * 64 + d0 + j] = __expf(decv[ti][j]); } }
#pragma unroll
        for (int tv = 0; tv < HPR; ++tv) { const int task = w + tv * 8;
            const int hh = task >> 3, e0 = (task & 7) * 8, h = h0 + hh;
            bf16_t* VS = (bf16_t*)(lds + hh * SLOT + (KV ? 9216 : 35840));
            const u32x4 v = *(const u32x4*)(prow + (IS_D ? C_ID : C_VA) + h * 64 + e0);
            bf16_t* d = VS + e0 * VP + lane;
            d[0] = (bf16_t)(v.x & 0xffff); d[VP] = (bf16_t)(v.x >> 16); d[2 * VP] = (bf16_t)(v.y & 0xffff); d[3 * VP] = (bf16_t)(v.y >> 16);
            d[4 * VP] = (bf16_t)(v.z & 0xffff); d[5 * VP] = (bf16_t)(v.z >> 16); d[6 * VP] = (bf16_t)(v.w & 0xffff); d[7 * VP] = (bf16_t)(v.w >> 16);
            if (!KV && lane < DK) {
                const float* sp = (IS_D ? C.kvd : C.kva) + ((size_t)(b * 128 + n) * 4 + h) * (DK * 64) + lane * 64 + e0;
                const float4 s0 = *(const float4*)sp, s1 = *(const float4*)(sp + 4);
                bf16_t* ds = VS + e0 * VP + 64 + lane;
                ds[0] = f2bf(s0.x); ds[VP] = f2bf(s0.y); ds[2 * VP] = f2bf(s0.z); ds[3 * VP] = f2bf(s0.w); ds[4 * VP] = f2bf(s1.x); ds[5 * VP] = f2bf(s1.y); ds[6 * VP] = f2bf(s1.z); ds[7 * VP] = f2bf(s1.w);
            }
        }
        __syncthreads();
        if (KV) {
            constexpr int TPH = (DK / 16) * 4;
            for (int tl = w; tl < 4 * TPH; tl += 8) { const int hh = tl / TPH, r = tl % TPH, dt = r >> 2, et = r & 3, h = h0 + hh;
                const bf16_t* KdT = (const bf16_t*)(lds + hh * SLOT); const bf16_t* VT = (const bf16_t*)(lds + hh * SLOT + 9216);
                f32x4 acc = {0.f, 0.f, 0.f, 0.f};
                acc = mma_tile(KdT + dt * 16 * 72, 72, VT + et * 16 * 72, 72, 64, acc, lane);
                float* kvbase = (IS_D ? C.kvd : C.kva) + ((size_t)(b * 128 + n) * 4 + h) * (DK * 64);
#pragma unroll
                for (int j = 0; j < 4; ++j) kvbase[(dt * 16 + fq * 4 + j) * 64 + et * 16 + fr] = acc[j]; }
        } else {
            for (int tl = w; tl < 32; tl += 8) { const int hh = tl >> 4, rt = (tl >> 2) & 3, ct = tl & 3;
                const bf16_t* Qh = (const bf16_t*)(lds + hh * SLOT); const bf16_t* Kh = (const bf16_t*)(lds + hh * SLOT + 9216); bf16_t* PQ = (bf16_t*)(lds + hh * SLOT + 18432);
                f32x4 acc = {0.f, 0.f, 0.f, 0.f};
                if (ct <= rt) acc = mma_tile(Qh + rt * 16 * 72, 72, Kh + ct * 16 * 72, 72, DK, acc, lane);
#pragma unroll
                for (int j = 0; j < 4; ++j) { const int t = rt * 16 + fq * 4 + j, sidx = ct * 16 + fr; PQ[t * 136 + sidx] = f2bf(sidx <= t ? acc[j] : 0.f); } }
            __syncthreads();
            { const int hh = w >> 2, rt = w & 3, h = h0 + hh;
                const bf16_t* PQ = (const bf16_t*)(lds + hh * SLOT + 18432); const bf16_t* VS = (const bf16_t*)(lds + hh * SLOT + 35840);
                float zz[4][4], gg[4];
#pragma unroll
                for (int et = 0; et < 4; ++et) { gg[et] = IS_D ? P.g_hgrn[l * 256 + h * 64 + et * 16 + fr] : 1.f;
#pragma unroll
                    for (int j = 0; j < 4; ++j) zz[j][et] = bf2f(C.proj[(R0 + rt * 16 + fq * 4 + j) * NPROJ + (IS_D ? C_ZD : C_ZA) + h * 64 + et * 16 + fr]); }
                f32x4 O[4];
#pragma unroll
                for (int et = 0; et < 4; ++et) { O[et] = (f32x4){0.f, 0.f, 0.f, 0.f}; O[et] = mma_tile(PQ + rt * 16 * 136, 136, VS + et * 16 * 136, 136, 64 + DK, O[et], lane); }
#pragma unroll
                for (int j = 0; j < 4; ++j) {
                    float ss = O[0][j] * O[0][j] + O[1][j] * O[1][j] + O[2][j] * O[2][j] + O[3][j] * O[3][j];
                    ss = quad16_sum(ss); const float r = rsqrtf(ss * (1.f / 64.f) + EPS);
                    const size_t row = R0 + rt * 16 + fq * 4 + j;
#pragma unroll
                    for (int et = 0; et < 4; ++et) { const int e = et * 16 + fr;
                        C.y[row * WMIX + (IS_D ? Y_D : Y_A) + h * 64 + e] = f2bf(O[et][j] * r * gg[et] * silu_(zz[j][et])); }
                }
            }
        }
        __syncthreads();
    }
}

#define PR(t, c) bf2f(prb[(t) * NPROJ + (c)])
__device__ __forceinline__ void sample_b_unit(const Params& P, Ctx& C, int l, int sb, unsigned char* lds) {
    const int tid = C.tid, lane = C.lane, w = C.w;
    bf16_t* prb = (bf16_t*)lds;
    float* qbq = (float*)(lds + 28672);
    float* kn = qbq + 2048;
    float* ps = kn + 512;
    float* kv = ps + 32 * 136;
    const size_t R0 = (size_t)M_P + sb * 4;
    const float4* kc4 = (const float4*)(P.cache_k + ((size_t)l * 128 + sb) * 16384);
    const float4* vc4 = (const float4*)(P.cache_v + ((size_t)l * 128 + sb) * 16384);
    for (int i = tid; i < 4 * 448; i += NTHREADS) { const int t = i / 448, c = i % 448;
        *(u32x4*)(prb + t * NPROJ + c * 8) = *(const u32x4*)(C.proj + (R0 + t) * NPROJ + c * 8); }
    { float4* ko = (float4*)(P.out + O_KS + ((size_t)l * 128 + sb) * 16384);
#pragma unroll
      for (int j = 0; j < 8; ++j) { const int i = tid + NTHREADS * j, e = i * 4, wq = e >> 7, r = e & 127; const float4 v = kc4[i];
          *(float4*)(kv + (wq * 2 + (r >> 6)) * 68 + (r & 63)) = v;
          if (wq >= 4) ko[i - 128] = v; } }
    __syncthreads();
    for (int i = tid; i < 2048; i += NTHREADS) { const int t = i >> 9, c = i & 511, h = c >> 6, d = c & 63; const int pos = 8192 + t;
        float v;
        if (d < 16) { const int ii = d & 7; const float cs = C.ropeBc[pos * 8 + ii], sn = C.ropeBs[pos * 8 + ii];
            const float x1 = PR(t, C_QB + h * 64 + ii), x2 = PR(t, C_QB + h * 64 + 8 + ii); v = d < 8 ? x1 * cs - x2 * sn : x2 * cs + x1 * sn; }
        else v = PR(t, C_QB + c);
        qbq[i] = v * 0.125f; }
    { const int t = tid >> 7, c = tid & 127, kh = c >> 6, d = c & 63, pos = 8192 + t;
        float v;
        if (d < 16) { const int ii = d & 7; const float cs = C.ropeBc[pos * 8 + ii], sn = C.ropeBs[pos * 8 + ii];
            const float x1 = PR(t, C_KB + kh * 64 + ii), x2 = PR(t, C_KB + kh * 64 + 8 + ii); v = d < 8 ? x1 * cs - x2 * sn : x2 * cs + x1 * sn; }
        else v = PR(t, C_KB + c);
        kn[tid] = v;
        P.out[O_KS + (((size_t)l * 128 + sb) * 128 + 124 + t) * 128 + c] = v;
        P.out[O_VS + (((size_t)l * 128 + sb) * 128 + 124 + t) * 128 + c] = PR(t, C_VB + c); }
    __syncthreads();
    for (int i = tid; i < 4224; i += NTHREADS) { const int kh = i / 2112, rem = i - kh * 2112, r16 = rem / 132, kk = rem - r16 * 132, g = r16 >> 2, t = r16 & 3, h = kh * 4 + g;
        const bool ok = kk < 128 ? (kk >= t) : (kk - 128 <= t);
        const float4* kp = (const float4*)(kk < 128 ? kv + (kk * 2 + kh) * 68 : kn + (kk - 128) * 128 + kh * 64);
        const float4* qp = (const float4*)(qbq + t * 512 + h * 64);
        float s = 0.f;
#pragma unroll 4
        for (int d = 0; d < 16; ++d) { const float4 a = qp[d], bq = kp[d]; s += a.x * bq.x + a.y * bq.y + a.z * bq.z + a.w * bq.w; }
        ps[(h * 4 + t) * 136 + kk] = ok ? s : -1e30f; }
    __syncthreads();
    { float4* vo = (float4*)(P.out + O_VS + ((size_t)l * 128 + sb) * 16384);
#pragma unroll
      for (int j = 0; j < 8; ++j) { const int i = tid + NTHREADS * j, e = i * 4, wq = e >> 7, r = e & 127; const float4 v = vc4[i];
          *(float4*)(kv + (wq * 2 + (r >> 6)) * 68 + (r & 63)) = v;
          if (wq >= 4) vo[i - 128] = v; } }
    { const int h = w; const float sink = P.attn_sink[l * 8 + h];
      for (int t = 0; t < 4; ++t) { float* pr_ = ps + (h * 4 + t) * 136;
          const float s0 = pr_[lane], s1 = pr_[lane + 64], s2 = lane < 4 ? pr_[lane + 128] : -1e30f;
          float m = fmaxf(fmaxf(s0, s1), s2); m = fmaxf(m, __shfl_xor(m, 32)); m = fmaxf(m, __shfl_xor(m, 16)); m = fmaxf(m, __shfl_xor(m, 8)); m = fmaxf(m, __shfl_xor(m, 4)); m = fmaxf(m, __shfl_xor(m, 2)); m = fmaxf(m, __shfl_xor(m, 1));
          m = fmaxf(m, sink);
          const float p0 = __expf(s0 - m), p1 = __expf(s1 - m), p2 = lane < 4 ? __expf(s2 - m) : 0.f;
          const float inv = 1.f / (wave_sum(p0 + p1 + p2) + __expf(sink - m));
          pr_[lane] = p0 * inv; pr_[lane + 64] = p1 * inv; if (lane < 4) pr_[lane + 128] = p2 * inv; } }
    __syncthreads();
    { const int h = w, kh = h >> 2, e = lane;
      float o0 = 0.f, o1 = 0.f, o2 = 0.f, o3 = 0.f; const float* p0 = ps + (h * 4) * 136;
#pragma unroll 8
      for (int kk = 0; kk < 128; ++kk) { const float v = kv[(kk * 2 + kh) * 68 + e]; o0 += p0[kk] * v; o1 += p0[136 + kk] * v; o2 += p0[272 + kk] * v; o3 += p0[408 + kk] * v; }
#pragma unroll
      for (int kk = 128; kk < 132; ++kk) { const float v = PR(kk - 128, C_VB + kh * 64 + e); o0 += p0[kk] * v; o1 += p0[136 + kk] * v; o2 += p0[272 + kk] * v; o3 += p0[408 + kk] * v; }
      const int c = h * 64 + e;
      C.y[(R0 + 0) * WMIX + Y_B + c] = f2bf(o0 * silu_(PR(0, C_ZB + c))); C.y[(R0 + 1) * WMIX + Y_B + c] = f2bf(o1 * silu_(PR(1, C_ZB + c)));
      C.y[(R0 + 2) * WMIX + Y_B + c] = f2bf(o2 * silu_(PR(2, C_ZB + c))); C.y[(R0 + 3) * WMIX + Y_B + c] = f2bf(o3 * silu_(PR(3, C_ZB + c))); }
    __syncthreads();
}

__device__ __forceinline__ void sample_adc_unit(const Params& P, Ctx& C, int l, int sb, unsigned char* lds) {
    const int tid = C.tid, lane = C.lane, w = C.w;
    bf16_t* prb = (bf16_t*)lds;
    float* qa = (float*)(lds + 28672);
    float* ka = qa + 512;
    float* qd = ka + 512;
    float* fd = qd + 1024;
    float* pl = fd + 1024;
    float* part = pl + 1024;
    const size_t R0 = (size_t)M_P + sb * 4;
    const int h = w >> 1, half = w & 1, e = lane;
    const float* SD0 = P.state_hgrn + (((size_t)l * 128 + sb) * 4 + h) * 4096 + (half * 32) * 64 + e;
    const float* SA0 = P.state_ret + (((size_t)l * 128 + sb) * 4 + h) * 2048 + (half * 16) * 64 + e;
    float sd[32], sa[16];
#pragma unroll
    for (int i = 0; i < 32; ++i) sd[i] = SD0[i * 64];
#pragma unroll
    for (int i = 0; i < 16; ++i) sa[i] = SA0[i * 64];
    for (int i = tid; i < 4 * 448; i += NTHREADS) { const int t = i / 448, c = i % 448;
        *(u32x4*)(prb + t * NPROJ + c * 8) = *(const u32x4*)(C.proj + (R0 + t) * NPROJ + c * 8); }
    __syncthreads();
    { const int t = tid >> 7, c = tid & 127, hh = c >> 5, d = c & 31, ii = d & 15, pos = 8192 + t;
        const float cs = C.ropeAc[pos * 16 + ii], sn = C.ropeAs[pos * 16 + ii];
        const float q1 = PR(t, C_QA + hh * 32 + ii), q2 = PR(t, C_QA + hh * 32 + 16 + ii), k1 = PR(t, C_KA + hh * 32 + ii), k2 = PR(t, C_KA + hh * 32 + 16 + ii);
        qa[tid] = d < 16 ? q1 * cs - q2 * sn : q2 * cs + q1 * sn;
        ka[tid] = (d < 16 ? k1 * cs - k2 * sn : k2 * cs + k1 * sn) * 0.17677669529663687f; }
    for (int i = tid; i < 1024; i += NTHREADS) { const int t = i >> 8, c = i & 255;
        qd[i] = silu_(PR(t, C_QD + c)); const float lb = C.lbt[l * 256 + c]; fd[i] = lb + (1.f - lb) * sigmoid_(PR(t, C_FD + c));
        const int g = c >> 6, wn = 2 << g; float s = 0.f;
        for (int j = 0; j < wn; ++j) { const int ee = 15 + t - j; s += ee >= 15 ? PR(ee - 15, C_UC + c) : P.state_pool[(((size_t)l * 128 + sb) * 15 + ee) * 256 + c]; }
        pl[i] = s / (float)wn - PR(t, C_UC + c); }
    for (int i = tid; i < 15 * 256; i += NTHREADS) { const int r = i >> 8, c = i & 255;
        P.out[O_POOLS + (((size_t)l * 128 + sb) * 15 + r) * 256 + c] = r < 11 ? P.state_pool[(((size_t)l * 128 + sb) * 15 + r + 4) * 256 + c] : PR(r - 11, C_UC + c); }
    const int pc = tid & 255, tp = tid >> 8, pg = pc >> 6;
    const float* wp = P.w_pool + ((size_t)l * 4 + pg) * 4096 + (pc & 63);
    __syncthreads();
    {
        float* S1 = P.out + O_HGRNS + (((size_t)l * 128 + sb) * 4 + h) * 4096 + (half * 32) * 64 + e;
        const float v0 = PR(0, C_ID + h * 64 + e), v1 = PR(1, C_ID + h * 64 + e), v2 = PR(2, C_ID + h * 64 + e), v3 = PR(3, C_ID + h * 64 + e);
        float o0 = 0.f, o1 = 0.f, o2 = 0.f, o3 = 0.f;
#pragma unroll
        for (int i = 0; i < 32; ++i) { float s = sd[i]; const int c = h * 64 + half * 32 + i;
            float f = fd[c]; s = f * s + (1.f - f) * v0; o0 += qd[c] * s; f = fd[256 + c]; s = f * s + (1.f - f) * v1; o1 += qd[256 + c] * s;
            f = fd[512 + c]; s = f * s + (1.f - f) * v2; o2 += qd[512 + c] * s; f = fd[768 + c]; s = f * s + (1.f - f) * v3; o3 += qd[768 + c] * s; S1[i * 64] = s; __builtin_amdgcn_sched_barrier(0); }
        float* pp = part + (w * 2 + 1) * 256 + e; pp[0] = o0; pp[64] = o1; pp[128] = o2; pp[192] = o3;
    }
    {
        const float gam = 1.f - exp2f(-5.f - (float)h);
        float* S1 = P.out + O_RETS + (((size_t)l * 128 + sb) * 4 + h) * 2048 + (half * 16) * 64 + e;
        const float v0 = PR(0, C_VA + h * 64 + e), v1 = PR(1, C_VA + h * 64 + e), v2 = PR(2, C_VA + h * 64 + e), v3 = PR(3, C_VA + h * 64 + e);
        float o0 = 0.f, o1 = 0.f, o2 = 0.f, o3 = 0.f;
#pragma unroll
        for (int i = 0; i < 16; ++i) { float s = sa[i]; const int c = h * 32 + half * 16 + i;
            s = gam * s + ka[c] * v0; o0 += qa[c] * s; s = gam * s + ka[128 + c] * v1; o1 += qa[128 + c] * s;
            s = gam * s + ka[256 + c] * v2; o2 += qa[256 + c] * s; s = gam * s + ka[384 + c] * v3; o3 += qa[384 + c] * s; S1[i * 64] = s; __builtin_amdgcn_sched_barrier(0); }
        float* pp = part + (w * 2) * 256 + e; pp[0] = o0; pp[64] = o1; pp[128] = o2; pp[192] = o3;
    }
    { float a0 = 0.f, a1 = 0.f;
      for (int c0 = 0; c0 < 64; c0 += 16) { float wv[16];
#pragma unroll
          for (int i = 0; i < 16; ++i) wv[i] = wp[(c0 + i) * 64];
#pragma unroll
          for (int i = 0; i < 16; ++i) { a0 += pl[(2 * tp) * 256 + pg * 64 + c0 + i] * wv[i]; a1 += pl[(2 * tp + 1) * 256 + pg * 64 + c0 + i] * wv[i]; } }
      const float sc = P.pool_scale[l * 256 + pc];
      C.y[(R0 + 2 * tp) * WMIX + Y_C + pc] = f2bf(a0 * sc * silu_(PR(2 * tp, C_ZC + pc)));
      C.y[(R0 + 2 * tp + 1) * WMIX + Y_C + pc] = f2bf(a1 * sc * silu_(PR(2 * tp + 1, C_ZC + pc))); }
    __syncthreads();
    { const bool isd = w >= 4; const int hh = w & 3, c = hh * 64 + e;
      const float* p0 = part + ((2 * hh) * 2 + (isd ? 1 : 0)) * 256 + e; const float* p1 = p0 + 512;
      const float gs = isd ? P.g_hgrn[l * 256 + c] : 1.f; const int zc = isd ? C_ZD : C_ZA, yc = isd ? Y_D : Y_A;
#pragma unroll
      for (int t = 0; t < 4; ++t) { const float o = p0[t * 64] + p1[t * 64];
          const float r = rsqrtf(wave_sum(o * o) * (1.f / 64.f) + EPS);
          C.y[(R0 + t) * WMIX + yc + c] = f2bf(o * r * gs * silu_(PR(t, zc + c))); } }
    __syncthreads();
}
#undef PR

__device__ __forceinline__ void sample_branch_tile(Ctx& C, int l, int tile) {
    const int lane = C.lane, w = C.w, fr = lane & 15, fq = lane >> 4;
    const int r0 = M_P + (tile >> 4) * 32 + (w >> 2) * 16, c0 = (tile & 15) * 64 + (w & 3) * 16;
    const bf16_t* A = C.y + (size_t)(r0 + fr) * WMIX + fq * 8;
    const bf16_t* B = C.wb + (size_t)l * DM * WMIX + (size_t)(c0 + fr) * WMIX + fq * 8;
    f32x4 acc = {0.f, 0.f, 0.f, 0.f};
    float gv[4][4];
#pragma unroll
    for (int br = 0; br < 4; ++br)
#pragma unroll
        for (int j = 0; j < 4; ++j) gv[br][j] = bf2f(C.gates[(size_t)(r0 + fq * 4 + j) * NGATE + br * 1024 + c0 + fr]);
#pragma unroll
    for (int br = 0; br < 4; ++br) {
        const int k0 = br == 0 ? 0 : (br == 1 ? 256 : (br == 2 ? 768 : 1024)), k1 = br == 0 ? 256 : (br == 1 ? 768 : (br == 2 ? 1024 : 1280));
#pragma unroll 8
        for (int k = k0; k < k1; k += 32) acc = mfma16(*(const bf16x8*)(A + k), *(const bf16x8*)(B + k), acc);
#pragma unroll
        for (int j = 0; j < 4; ++j) { float sc = gv[br][j]; if (br < 3) sc *= __builtin_amdgcn_rcpf(gv[br + 1][j]); acc[j] *= sc; }
    }
#pragma unroll
    for (int j = 0; j < 4; ++j) C.mb[(size_t)(r0 + fq * 4 + j) * DM + c0 + fr] = f2bf(acc[j]);
}
__device__ __forceinline__ void sample_out_tile(Ctx& C, int l, int tile) {
    const int lane = C.lane, w = C.w, fr = lane & 15, fq = lane >> 4;
    const int r0 = M_P + (tile >> 4) * 32 + (w >> 2) * 16, c0 = (tile & 15) * 64 + (w & 3) * 16;
    const bf16_t* A = C.mb + (size_t)(r0 + fr) * DM + fq * 8;
    const bf16_t* B = C.wout + (size_t)l * DM * DM + (size_t)(c0 + fr) * DM + fq * 8;
    f32x4 acc = {0.f, 0.f, 0.f, 0.f};
#pragma unroll 8
    for (int k = 0; k < DM; k += 32) acc = mfma16(*(const bf16x8*)(A + k), *(const bf16x8*)(B + k), acc);
#pragma unroll
    for (int j = 0; j < 4; ++j) ((bf16_t*)C.of)[(size_t)(r0 + fq * 4 + j) * DM + c0 + fr] = f2bf(acc[j]);
}

__device__ __forceinline__ void phase_scan(const Params& P, Ctx& C, int l) {
    for (int g = C.bx * NTHREADS + C.tid; g < 49152; g += C.G * NTHREADS) {
        const bool isA = g < 16384;
        const int gg = isA ? g : g - 16384;
        const int b = isA ? (gg >> 13) : (gg >> 14), r = isA ? (gg & 8191) : (gg & 16383), h = isA ? (r >> 11) : (r >> 12), de = isA ? (r & 2047) : (r & 4095);
        float* base = isA ? C.kva + ((size_t)(b * 128) * 4 + h) * 2048 + de : C.kvd + ((size_t)(b * 128) * 4 + h) * 4096 + de;
        const size_t stride = isA ? 8192 : 16384;
        const float* dp = C.decd + (size_t)(b * 128) * 256 + h * 64 + (de >> 6);
        const float decA = __expf(64.f * log1pf(-exp2f(-5.f - (float)h)));
        const float* lp = base; float* sp = base; const float* dlp = dp;
        float S = 0.f, va[16], da[16];
#pragma unroll
        for (int i = 0; i < 16; ++i) { va[i] = *lp; lp += stride; da[i] = isA ? decA : *dlp; dlp += 256; }
        for (int blk = 0; blk < 8; ++blk) {
            float vb[16], db[16];
            if (blk < 7) {
#pragma unroll
                for (int i = 0; i < 16; ++i) { vb[i] = *lp; lp += stride; db[i] = isA ? decA : *dlp; dlp += 256; } }
#pragma unroll
            for (int i = 0; i < 16; ++i) { *sp = S; sp += stride; S = da[i] * S + va[i]; }
#pragma unroll
            for (int i = 0; i < 16; ++i) { va[i] = vb[i]; da[i] = db[i]; }
        }
        float* fin = isA ? P.out + O_RETP + (((size_t)l * 2 + b) * 4 + h) * 2048 + de : P.out + O_HGRNP + (((size_t)l * 2 + b) * 4 + h) * 4096 + de;
        *fin = S;
    }
}

__device__ __forceinline__ void phase_finalize(const Params& P, Ctx& C, int l) {
    const int lane = C.lane; const int stride = C.G * 8;
    for (int row0 = C.bx * 8 + C.w; row0 < M_TOT; row0 += 2 * stride) {
        const int row1 = row0 + stride; const bool has1 = row1 < M_TOT; const int r1 = has1 ? row1 : row0;
        const uint2* oA = (const uint2*)((const bf16_t*)C.of + (size_t)row0 * DM); float4* xA = (float4*)(P.out + (size_t)row0 * DM);
        const uint2* oB = (const uint2*)((const bf16_t*)C.of + (size_t)r1 * DM); float4* xB = (float4*)(P.out + (size_t)r1 * DM);
        float4 o0[4], x0[4], o1[4], x1[4]; float ss0 = 0.f, ss1 = 0.f;
#pragma unroll
        for (int i = 0; i < 4; ++i) { const uint2 pa = oA[lane + 64 * i], pb = oB[lane + 64 * i]; x0[i] = xA[lane + 64 * i]; x1[i] = xB[lane + 64 * i];
            o0[i] = make_float4(lo16(pa.x), hi16(pa.x), lo16(pa.y), hi16(pa.y)); o1[i] = make_float4(lo16(pb.x), hi16(pb.x), lo16(pb.y), hi16(pb.y)); }
#pragma unroll
        for (int i = 0; i < 4; ++i) { ss0 += o0[i].x * o0[i].x + o0[i].y * o0[i].y + o0[i].z * o0[i].z + o0[i].w * o0[i].w; ss1 += o1[i].x * o1[i].x + o1[i].y * o1[i].y + o1[i].z * o1[i].z + o1[i].w * o1[i].w; }
        ss0 = wave_sum(ss0); ss1 = wave_sum(ss1);
        const float ra = rsqrtf(ss0 * (1.f / DM) + EPS), rb = rsqrtf(ss1 * (1.f / DM) + EPS);
        float s0 = 0.f, s1 = 0.f;
#pragma unroll
        for (int i = 0; i < 4; ++i) { const float4 g = ((const float4*)(P.g_post + l * DM))[lane + 64 * i];
            x0[i].x += o0[i].x * ra * g.x; x0[i].y += o0[i].y * ra * g.y; x0[i].z += o0[i].z * ra * g.z; x0[i].w += o0[i].w * ra * g.w;
            x1[i].x += o1[i].x * rb * g.x; x1[i].y += o1[i].y * rb * g.y; x1[i].z += o1[i].z * rb * g.z; x1[i].w += o1[i].w * rb * g.w;
            xA[lane + 64 * i] = x0[i]; if (has1) xB[lane + 64 * i] = x1[i];
            s0 += x0[i].x * x0[i].x + x0[i].y * x0[i].y + x0[i].z * x0[i].z + x0[i].w * x0[i].w; s1 += x1[i].x * x1[i].x + x1[i].y * x1[i].y + x1[i].z * x1[i].z + x1[i].w * x1[i].w; }
        if (l < 3) { s0 = wave_sum(s0); s1 = wave_sum(s1); const float qa = rsqrtf(s0 * (1.f / DM) + EPS), qb = rsqrtf(s1 * (1.f / DM) + EPS);
#pragma unroll
            for (int i = 0; i < 4; ++i) { const float4 g = ((const float4*)(P.g_pre + (l + 1) * DM))[lane + 64 * i];
                uint2 ov; ov.x = pk2(x0[i].x * qa * g.x, x0[i].y * qa * g.y); ov.y = pk2(x0[i].z * qa * g.z, x0[i].w * qa * g.w);
                ((uint2*)(C.h + (size_t)row0 * DM))[lane + 64 * i] = ov;
                if (has1) { uint2 ow; ow.x = pk2(x1[i].x * qb * g.x, x1[i].y * qb * g.y); ow.y = pk2(x1[i].z * qb * g.z, x1[i].w * qb * g.w);
                    ((uint2*)(C.h + (size_t)row1 * DM))[lane + 64 * i] = ow; } } }
    }
}

#ifndef PH_MASK
#define PH_MASK 2047
#endif
__global__ void __launch_bounds__(NTHREADS, 2) fwd_kernel(Params P) {
    extern __shared__ __attribute__((aligned(16))) unsigned char lds[];
    LAS unsigned char* ldsl = (LAS unsigned char*)lds;
    volatile LAS unsigned* bst = (volatile LAS unsigned*)(ldsl + LDS_BYTES - 16);
    if (threadIdx.x == 0) { bst[0] = 0u; bst[1] = 0u; if (P.coop) (void)xb_add((unsigned*)P.ws + XB_XCNT(xb_xcc_id()), 1u); }
    __syncthreads();

    for (int ph = P.ph_lo; ph < P.ph_hi; ++ph) {
        int nrep = 1;
#ifdef DUP_SP
        if (ph > 0 && ((ph - 1) % 7) == DUP_SP) nrep = 2;
        if (ph == 0 && DUP_SP == 7) nrep = 5;
#endif
        for (int rep = 0; rep < nrep; ++rep) {
        if (rep) xcd_barrier((unsigned*)P.ws, bst);
        int tid_ = threadIdx.x, bx = blockIdx.x, G_ = gridDim.x; __attribute__((address_space(1))) unsigned char* wsg = (__attribute__((address_space(1))) unsigned char*)P.ws;
        asm volatile("" : "+v"(tid_)); asm volatile("" : "+s"(bx)); asm volatile("" : "+s"(G_)); asm volatile("" : "+s"(wsg));
        unsigned char* ws = (unsigned char*)wsg;
        Ctx C;
        C.win = (bf16_t*)(ws + WS_WIN); C.wb = (bf16_t*)(ws + WS_WB); C.wout = (bf16_t*)(ws + WS_WOUT); C.h = (bf16_t*)(ws + WS_H); C.mb = (bf16_t*)(ws + WS_H);
        C.proj = (bf16_t*)(ws + WS_PROJ); C.mf = (float*)(ws + WS_PROJ); C.gates = (bf16_t*)(ws + WS_GATES); C.of = (float*)(ws + WS_GATES); C.y = (bf16_t*)(ws + WS_Y);
        C.kva = (float*)(ws + WS_KVA); C.kvd = (float*)(ws + WS_KVD); C.decd = (float*)(ws + WS_DECD);
        C.ropeAc = (float*)(ws + WS_ROPEA); C.ropeAs = C.ropeAc + NPOS * 16; C.ropeBc = (float*)(ws + WS_ROPEB); C.ropeBs = C.ropeBc + NPOS * 8; C.lbt = (float*)(ws + WS_LB);
        C.bx = bx; C.tid = tid_; C.lane = tid_ & 63; C.w = __builtin_amdgcn_readfirstlane(tid_ >> 6); C.G = G_;
        const int vcu = (C.G % 8 == 0) ? (bx % 8) * (C.G / 8) + bx / 8 : bx;
        if (ph == 0) { if (PH_MASK & 1) phase_prologue(P, C, lds); }
        else {
            const int l = (ph - 1) / 7, sp = (ph - 1) % 7;
            if (sp == 0) {
              if (PH_MASK & 2) {
                pg8::Gemm g{C.h, C.win + (size_t)l * DIN * DM, DM, DM}; pg8::StaticOrder S; S.init(M_TOT, DIN, DM, C.G, bx);
                pg8::EpiProj E{C.proj, C.gates};
                pg8::gemm_phase<pg8::EpiProj, pg8::StaticOrder>(ldsl, g, S, E, C.tid); }
            } else if (sp == 1) {
                for (int u = bx; u < 1280; u += C.G) {
                    asm volatile("" : "+v"(C.tid)); C.lane = C.tid & 63; C.w = __builtin_amdgcn_readfirstlane(C.tid >> 6);
                    if (u < 256) { if (PH_MASK & 4) attn_prompt_unit(P, C, l, u >> 7, (u & 127) >> 1, u & 1, lds); }
                    else if (u < 512) { if (PH_MASK & 32) lin_chunk<false, true>(P, C, l, (u - 256) >> 7, (u - 256) & 127, lds); }
                    else if (u < 768) { if (PH_MASK & 32) lin_chunk<true, true>(P, C, l, (u - 512) >> 7, (u - 512) & 127, lds); }
                    else if (u < 1024) { const int v = u - 768; if (PH_MASK & 8) { if (v < 128) { if (!(PH_MASK & 4096)) sample_b_unit(P, C, l, v, lds); } else { if (!(PH_MASK & 8192)) sample_adc_unit(P, C, l, v - 128, lds); } } }
                    else { if (PH_MASK & 16) pool_prompt_unit(P, C, l, u - 1024, lds); }
                }
            } else if (sp == 2) { if (PH_MASK & 64) phase_scan(P, C, l); }
            else if (sp == 3) {
                for (int u = bx; u < 512; u += C.G) {
                    asm volatile("" : "+v"(C.tid)); C.lane = C.tid & 63; C.w = __builtin_amdgcn_readfirstlane(C.tid >> 6);
                    if (u < 256) { if (PH_MASK & 128) lin_chunk<false, false>(P, C, l, u >> 7, u & 127, lds); }
                    else { if (PH_MASK & 128) lin_chunk<true, false>(P, C, l, (u - 256) >> 7, (u - 256) & 127, lds); }
                }
            } else if (sp == 4) {
              if (PH_MASK & 256) {
                for (int t = bx; t < 256; t += C.G) sample_branch_tile(C, l, t);
                pg8::Gemm g{C.y, C.wb + (size_t)l * DM * WMIX, WMIX, WMIX}; pg8::BranchOrder S{256, C.G, vcu};
                pg8::EpiBranch E{C.gates, C.mb};
                pg8::gemm_phase<pg8::EpiBranch, pg8::BranchOrder>(ldsl, g, S, E, C.tid); }
            } else if (sp == 5) {
              if (PH_MASK & 512) {
                for (int t = bx; t < 256; t += C.G) sample_out_tile(C, l, t);
                pg8::Gemm g{C.mb, C.wout + (size_t)l * DM * DM, DM, DM}; pg8::TileOrder S{256, C.G, vcu, DM / 64};
                pg8::EpiF32 E{(bf16_t*)C.of};
                pg8::gemm_phase<pg8::EpiF32, pg8::TileOrder>(ldsl, g, S, E, C.tid); }
            } else { if (PH_MASK & 1024) phase_finalize(P, C, l); }
        }
        }
        if (ph + 1 < P.ph_hi && P.coop) { if (ph == 0) cg::this_grid().sync(); else xcd_barrier((unsigned*)P.ws, bst); }
    }
}

#ifndef N_LAUNCH_MODE
#define N_LAUNCH_MODE 1
#endif
extern "C" void kernel_launch(void* const* d_in, const int* in_sizes, int n_in, void* d_out, int out_size, void* d_ws, size_t ws_size, hipStream_t stream) {
    static int grid = 0;
    if (grid == 0) {
        if (n_in != 17 || (size_t)out_size != O_END || ws_size < WS_END) { fprintf(stderr, "kernel_launch: unexpected sizes n_in %d out %d ws %zu\n", n_in, out_size, ws_size); grid = -1; return; }
        int dev = 0, cus = 0, per_cu = 0;
        hipGetDevice(&dev); hipDeviceGetAttribute(&cus, hipDeviceAttributeMultiprocessorCount, dev);
        if (hipFuncSetAttribute((const void*)fwd_kernel, hipFuncAttributeMaxDynamicSharedMemorySize, LDS_BYTES) != hipSuccess) { fprintf(stderr, "hipFuncSetAttribute failed\n"); grid = -1; return; }
        if (hipOccupancyMaxActiveBlocksPerMultiprocessor(&per_cu, (const void*)fwd_kernel, NTHREADS, LDS_BYTES) != hipSuccess || per_cu < 1) { fprintf(stderr, "occupancy query: %d\n", per_cu); per_cu = 1; }
        (void)hipGetLastError();
        grid = cus * 1;
        if (per_cu < 1) grid = -1;
    }
    if (grid < 0) return;
    Params p{};
    const float* const* in = (const float* const*)d_in;
    p.x_prompt = in[0]; p.x_sample = in[1]; p.state_ret = in[2]; p.cache_k = in[3]; p.cache_v = in[4]; p.state_pool = in[5]; p.state_hgrn = in[6];
    p.w_in = in[7]; p.w_branch = in[8]; p.w_out = in[9]; p.g_pre = in[10]; p.g_post = in[11]; p.attn_sink = in[12]; p.w_pool = in[13];
    p.pool_scale = in[14]; p.g_hgrn = in[15]; p.lower_bounds = in[16];
    p.out = (float*)d_out; p.ws = (unsigned char*)d_ws;
    for (int i = 0; i < 16; ++i) p.invA[i] = pow(10000.0, -(double)i / 16.0);
    for (int i = 0; i < 8; ++i) p.invB[i] = pow(500000.0, -(double)i / 8.0);
    const int NPH = 29;
#if N_LAUNCH_MODE == 1
    (void)hipMemsetAsync(d_ws, 0, 16384, stream);
    p.ph_lo = 0; p.ph_hi = NPH; p.coop = 1; p.pad = 0;
    void* args[] = {&p};
    hipError_t e = hipLaunchCooperativeKernel((const void*)fwd_kernel, dim3(grid), dim3(NTHREADS), args, LDS_BYTES, stream);
    if (e != hipSuccess) fprintf(stderr, "cooperative launch failed: %s (grid %d)\n", hipGetErrorString(e), grid);
#else
    for (int ph = 0; ph < NPH; ++ph) {
        p.ph_lo = ph; p.ph_hi = ph + 1; p.coop = 0; p.pad = 0;
        hipLaunchKernelGGL(fwd_kernel, dim3(grid), dim3(NTHREADS), LDS_BYTES, stream, p);
    }
#endif
}
```

```cpp
#include <hip/hip_runtime.h>
#include <hip/hip_cooperative_groups.h>
#include <cstdio>
#include <cstdint>
#include <cmath>
namespace cg = cooperative_groups;

#define LAS __attribute__((address_space(3)))
typedef unsigned short bf16_t;
typedef short bf16x8 __attribute__((ext_vector_type(8)));
typedef float f32x4 __attribute__((ext_vector_type(4)));
typedef unsigned u32x4 __attribute__((ext_vector_type(4)));

constexpr int M_TOT = 16896, M_P = 16384, DM = 1024, DIN = 7680, NPROJ = 3584, NGATE = 4096, WMIX = 1280;
constexpr int C_QA = 0, C_KA = 128, C_VA = 256, C_ZA = 512, C_QB = 768, C_KB = 1280, C_VB = 1408, C_ZB = 1536, C_UC = 2048, C_ZC = 2304,
              C_QD = 2560, C_FD = 2816, C_ID = 3072, C_ZD = 3328;
constexpr int Y_A = 0, Y_B = 256, Y_C = 768, Y_D = 1024;
constexpr size_t O_YP = 0, O_YS = 16777216, O_RETP = 17301504, O_KP = 17367040, O_VP = 17498112, O_POOLP = 17629184, O_HGRNP = 17659904,
                 O_RETS = 17790976, O_KS = 21985280, O_VS = 30373888, O_POOLS = 38762496, O_HGRNS = 40728576, O_END = 49117184;
constexpr float EPS = 1e-6f;
constexpr int NPOS = 8196;

constexpr size_t MiB = 1u << 20;
constexpr size_t WS_ROPEA = 1 * MiB;
constexpr size_t WS_ROPEB = 3 * MiB;
constexpr size_t WS_LB = 3 * MiB + 768 * 1024;
constexpr size_t WS_WIN = 4 * MiB;
constexpr size_t WS_WB = 64 * MiB;
constexpr size_t WS_WOUT = 74 * MiB;
constexpr size_t WS_H = 82 * MiB;
constexpr size_t WS_PROJ = 115 * MiB;
constexpr size_t WS_GATES = 231 * MiB;
constexpr size_t WS_Y = 363 * MiB;
constexpr size_t WS_KVA = 405 * MiB;
constexpr size_t WS_KVD = 413 * MiB;
constexpr size_t WS_DECD = 429 * MiB;
constexpr size_t WS_END = 430 * MiB;

constexpr int LDS_BYTES = 147456;
constexpr int NTHREADS = 512;

struct Params {
    const float* x_prompt; const float* x_sample; const float* state_ret; const float* cache_k; const float* cache_v; const float* state_pool; const float* state_hgrn;
    const float* w_in; const float* w_branch; const float* w_out; const float* g_pre; const float* g_post; const float* attn_sink; const float* w_pool;
    const float* pool_scale; const float* g_hgrn; const float* lower_bounds;
    float* out; unsigned char* ws;
    double invA[16]; double invB[8];
    int ph_lo, ph_hi, coop, pad;
};

__device__ __forceinline__ float bf2f(bf16_t v) { return __uint_as_float(((unsigned)v) << 16); }
__device__ __forceinline__ bf16_t f2bf(float f) { unsigned r; asm("v_cvt_pk_bf16_f32 %0, %1, %1" : "=v"(r) : "v"(f)); return (bf16_t)(r & 0xffffu); }
__device__ __forceinline__ unsigned pk2(float lo, float hi) { unsigned r; asm("v_cvt_pk_bf16_f32 %0, %1, %2" : "=v"(r) : "v"(lo), "v"(hi)); return r; }
__device__ __forceinline__ float lo16(unsigned u) { return __uint_as_float(u << 16); }
__device__ __forceinline__ float hi16(unsigned u) { return __uint_as_float(u & 0xffff0000u); }
__device__ __forceinline__ float sigmoid_(float x) { return 1.f / (1.f + __expf(-x)); }
__device__ __forceinline__ float silu_(float x) { return x / (1.f + __expf(-x)); }
__device__ __forceinline__ float wave_sum(float v) {
    v += __shfl_xor(v, 32); v += __shfl_xor(v, 16); v += __shfl_xor(v, 8); v += __shfl_xor(v, 4); v += __shfl_xor(v, 2); v += __shfl_xor(v, 1); return v;
}
__device__ __forceinline__ float quad16_sum(float v) { v += __shfl_xor(v, 8); v += __shfl_xor(v, 4); v += __shfl_xor(v, 2); v += __shfl_xor(v, 1); return v; }
__device__ __forceinline__ float quad16_max(float v) { v = fmaxf(v, __shfl_xor(v, 8)); v = fmaxf(v, __shfl_xor(v, 4)); v = fmaxf(v, __shfl_xor(v, 2)); v = fmaxf(v, __shfl_xor(v, 1)); return v; }
__device__ __forceinline__ f32x4 mfma16(bf16x8 a, bf16x8 b, f32x4 c) { return __builtin_amdgcn_mfma_f32_16x16x32_bf16(a, b, c, 0, 0, 0); }
__device__ __forceinline__ f32x4 mma_tile(const bf16_t* As, int lda, const bf16_t* Bs, int ldb, int K, f32x4 acc, int lane) {
    const bf16_t* ap = As + (lane & 15) * lda + (lane >> 4) * 8;
    const bf16_t* bp = Bs + (lane & 15) * ldb + (lane >> 4) * 8;
    for (int k = 0; k < K; k += 32) acc = mfma16(*(const bf16x8*)(ap + k), *(const bf16x8*)(bp + k), acc);
    return acc;
}

__device__ __forceinline__ void unpack8(const u32x4 a, float (&x)[8]) { x[0] = lo16(a.x); x[1] = hi16(a.x); x[2] = lo16(a.y); x[3] = hi16(a.y); x[4] = lo16(a.z); x[5] = hi16(a.z); x[6] = lo16(a.w); x[7] = hi16(a.w); }
__device__ __forceinline__ u32x4 pack8(const float (&x)[8]) { u32x4 w; w.x = pk2(x[0], x[1]); w.y = pk2(x[2], x[3]); w.z = pk2(x[4], x[5]); w.w = pk2(x[6], x[7]); return w; }

namespace pg8 {
constexpr int BM = 256, BK = 64, HALF = 128, HTB = HALF * BK * 2, STAGE_BYTES = 8 * HTB, NXCD = 8, WGM = 8;
__host__ __device__ __forceinline__ int lds_byte(int r, int c) { const int st = (r >> 4) * 2 + (c >> 5), rr = r & 15, cc = c & 31, ob = rr * 64 + cc * 2; return st * 1024 + (ob ^ (((ob >> 9) & 1) << 5)); }
__host__ __device__ __forceinline__ void stage_rc(int b, int& R, int& C) { const int st = b / 1024, sb = b % 1024, swz = sb ^ (((sb >> 9) & 1) << 5); R = (st >> 1) * 16 + swz / 64; C = (st & 1) * 32 + (swz % 64) / 2; }
__host__ __device__ __forceinline__ int perm32(int rho) { const int n = rho >> 4, i = rho & 15; return 8 * (i >> 2) + 4 * n + (i & 3); }

struct Unit { int pm, pn, k0, nt, br; };
struct Gemm { const bf16_t* A; const bf16_t* Bt; int lda, ldb; };

struct StaticOrder {
    int nM, nN, nwg, G, c, nt;
    __device__ void init(int M, int N, int K, int G_, int c_) { nM = M / BM; nN = N / BM; nwg = nM * nN; G = G_; c = c_; nt = K / BK; }
    __device__ bool next(int i, Unit& u) const {
        const long L = (long)i * G + c; if (L >= nwg) return false;
        int wgid = (int)L; { const int q = nwg / NXCD, r = nwg % NXCD, xcd = wgid % NXCD, off = wgid / NXCD; wgid = (xcd < r ? xcd * (q + 1) : r * (q + 1) + (xcd - r) * q) + off; }
        const int nig = WGM * nN, gid = wgid / nig, fm = gid * WGM, gsz = (nM - fm) < WGM ? (nM - fm) : WGM;
        u.pm = fm + ((wgid % nig) % gsz); u.pn = (wgid % nig) / gsz; u.k0 = 0; u.nt = nt; u.br = 0; return true;
    }
};
struct TileOrder {
    int ntiles, G, c, nt;
    __device__ bool next(int i, Unit& u) const { const int t = i * G + c; if (t >= ntiles) return false; u.pm = t >> 2; u.pn = t & 3; u.k0 = 0; u.nt = nt; u.br = 0; return true; }
};
struct BranchOrder {
    int ntiles, G, c;
    __device__ bool next(int i, Unit& u) const {
        const int t = (i >> 2) * G + c; if (t >= ntiles) return false; const int br = i & 3;
        u.pm = t >> 2; u.pn = t & 3; u.br = br; u.k0 = br == 0 ? 0 : (br == 1 ? 256 : (br == 2 ? 768 : 1024)); u.nt = br == 1 ? 8 : 4; return true;
    }
};

struct EpiProj {
    static __device__ __forceinline__ bool reset(const Unit&) { return true; }
    bf16_t* proj; bf16_t* gates;
    template <bool ISG> __device__ __forceinline__ void body(f32x4 (&acc)[2][2][4][2], bf16_t* base, int ld) const {
#pragma unroll
        for (int ai = 0; ai < 2; ++ai)
#pragma unroll
            for (int m = 0; m < 4; ++m) { bf16_t* rowp = base + (size_t)(ai * HALF + m * 16) * ld;
#pragma unroll
                for (int bj = 0; bj < 2; ++bj) { f32x4 v0 = acc[ai][bj][m][0], v1 = acc[ai][bj][m][1];
                    if (ISG) {
#pragma unroll
                        for (int i = 0; i < 4; ++i) { v0[i] = fmaxf(sigmoid_(v0[i]), 1e-6f); v1[i] = fmaxf(sigmoid_(v1[i]), 1e-6f); } }
                    u32x4 w; w.x = pk2(v0[0], v0[1]); w.y = pk2(v0[2], v0[3]); w.z = pk2(v1[0], v1[1]); w.w = pk2(v1[2], v1[3]);
                    *(u32x4*)(rowp + bj * HALF) = w; } }
    }
    __device__ __forceinline__ void operator()(f32x4 (&acc)[2][2][4][2], const Unit& u, int wr, int wc, int fr, int fq) const {
        const int row0 = u.pm * BM + wr * 64 + fr;
        if (u.pn >= 14) body<true>(acc, gates + (size_t)row0 * NGATE + (u.pn - 14) * BM + wc * 32 + 8 * fq, NGATE);
        else body<false>(acc, proj + (size_t)row0 * NPROJ + u.pn * BM + wc * 32 + 8 * fq, NPROJ);
    }
};
struct EpiBranch {
    static __device__ __forceinline__ bool reset(const Unit& u) { return u.br == 3; }
    const bf16_t* gates; bf16_t* mb;
    static __device__ __forceinline__ void scale8(f32x4& v0, f32x4& v1, const u32x4 g) {
        v0[0] *= lo16(g.x); v0[1] *= hi16(g.x); v0[2] *= lo16(g.y); v0[3] *= hi16(g.y); v1[0] *= lo16(g.z); v1[1] *= hi16(g.z); v1[2] *= lo16(g.w); v1[3] *= hi16(g.w); }
    static __device__ __forceinline__ void rscale8(f32x4& v0, f32x4& v1, const u32x4 g) {
        v0[0] *= __builtin_amdgcn_rcpf(lo16(g.x)); v0[1] *= __builtin_amdgcn_rcpf(hi16(g.x)); v0[2] *= __builtin_amdgcn_rcpf(lo16(g.y)); v0[3] *= __builtin_amdgcn_rcpf(hi16(g.y));
        v1[0] *= __builtin_amdgcn_rcpf(lo16(g.z)); v1[1] *= __builtin_amdgcn_rcpf(hi16(g.z)); v1[2] *= __builtin_amdgcn_rcpf(lo16(g.w)); v1[3] *= __builtin_amdgcn_rcpf(hi16(g.w)); }
    __device__ __forceinline__ void operator()(f32x4 (&acc)[2][2][4][2], const Unit& u, int wr, int wc, int fr, int fq) const {
        const int row0 = u.pm * BM + wr * 64 + fr, col0 = u.pn * BM + wc * 32 + 8 * fq;
        const bf16_t* gbase = gates + (size_t)row0 * NGATE + u.br * 1024 + col0;
        if (u.br < 3) {
#pragma unroll
            for (int ai = 0; ai < 2; ++ai)
#pragma unroll
                for (int mp = 0; mp < 2; ++mp) {
                    u32x4 g[2][2], gn[2][2];
#pragma unroll
                    for (int mm = 0; mm < 2; ++mm)
#pragma unroll
                        for (int bj = 0; bj < 2; ++bj) { const bf16_t* p = gbase + (size_t)(ai * HALF + (mp * 2 + mm) * 16) * NGATE + bj * HALF;
                            g[mm][bj] = *(const u32x4*)p; gn[mm][bj] = *(const u32x4*)(p + 1024); }
#pragma unroll
                    for (int mm = 0; mm < 2; ++mm)
#pragma unroll
                        for (int bj = 0; bj < 2; ++bj) { const int m = mp * 2 + mm;
                            scale8(acc[ai][bj][m][0], acc[ai][bj][m][1], g[mm][bj]); rscale8(acc[ai][bj][m][0], acc[ai][bj][m][1], gn[mm][bj]); }
                }
        } else {
#pragma unroll
            for (int ai = 0; ai < 2; ++ai)
#pragma unroll
                for (int mp = 0; mp < 2; ++mp) {
                    u32x4 g[2][2];
#pragma unroll
                    for (int mm = 0; mm < 2; ++mm)
#pragma unroll
                        for (int bj = 0; bj < 2; ++bj) g[mm][bj] = *(const u32x4*)(gbase + (size_t)(ai * HALF + (mp * 2 + mm) * 16) * NGATE + bj * HALF);
#pragma unroll
                    for (int mm = 0; mm < 2; ++mm)
#pragma unroll
                        for (int bj = 0; bj < 2; ++bj) { const int m = mp * 2 + mm;
                            f32x4 v0 = acc[ai][bj][m][0], v1 = acc[ai][bj][m][1]; scale8(v0, v1, g[mm][bj]);
                            u32x4 w; w.x = pk2(v0[0], v0[1]); w.y = pk2(v0[2], v0[3]); w.z = pk2(v1[0], v1[1]); w.w = pk2(v1[2], v1[3]);
                            *(u32x4*)(mb + (size_t)(row0 + ai * HALF + m * 16) * DM + col0 + bj * HALF) = w; }
                }
        }
    }
};
struct EpiF32 {
    static __device__ __forceinline__ bool reset(const Unit&) { return true; }
    bf16_t* o;
    __device__ __forceinline__ void operator()(f32x4 (&acc)[2][2][4][2], const Unit& u, int wr, int wc, int fr, int fq) const {
        const int row0 = u.pm * BM + wr * 64 + fr, col0 = u.pn * BM + wc * 32 + 8 * fq;
#pragma unroll
        for (int ai = 0; ai < 2; ++ai)
#pragma unroll
            for (int m = 0; m < 4; ++m) { bf16_t* rowp = o + (size_t)(row0 + ai * HALF + m * 16) * DM + col0;
#pragma unroll
                for (int bj = 0; bj < 2; ++bj) { const f32x4 v0 = acc[ai][bj][m][0], v1 = acc[ai][bj][m][1];
                    u32x4 w; w.x = pk2(v0[0], v0[1]); w.y = pk2(v0[2], v0[3]); w.z = pk2(v1[0], v1[1]); w.w = pk2(v1[2], v1[3]);
                    *(u32x4*)(rowp + bj * HALF) = w; } }
    }
};

template <class Epi, class Sched>
__device__ __forceinline__ void gemm_phase(LAS unsigned char* lds, const Gemm g, const Sched& S, const Epi& E, const int tid) {
    const int wid = __builtin_amdgcn_readfirstlane(tid >> 6), lane = tid & 63, wr = wid >> 2, wc = wid & 3, fr = lane & 15, fq = lane >> 4;
    unsigned voffA[2], voffB[2];
#pragma unroll
    for (int i = 0; i < 2; ++i) { int R, C; stage_rc(tid * 16 + i * 8192, R, C); const int Rb = (R & ~31) + perm32(R & 31);
        voffA[i] = (unsigned)(R * g.lda + C) * 2u; voffB[i] = (unsigned)(Rb * g.ldb + C) * 2u; }
    const size_t kstep = (size_t)(BK * 2);
    const size_t hstepA = (size_t)HALF * g.lda * 2, hstepB = (size_t)HALF * g.ldb * 2;
    const size_t tstepA = 2 * hstepA, tstepB = 2 * hstepB;
    const unsigned ldsw = (unsigned)wid * 1024u;
    const int aoff = lds_byte(wr * 64 + fr, fq * 8), boff = lds_byte(wc * 32 + fr, fq * 8);
#define PG8_SA(b, h) (((b) * 2 + (h)) * HTB)
#define PG8_SB(b, h) ((4 + (b) * 2 + (h)) * HTB)
#define PG8_STAGE(bufoff, gbase, voff) do { _Pragma("unroll") for (int _i = 0; _i < 2; ++_i) \
        __builtin_amdgcn_global_load_lds((const unsigned*)((const char*)(gbase) + (voff)[_i]), (LAS unsigned*)(lds + (bufoff) + ldsw + _i * 8192), 16, 0, 0); } while (0)
#define PG8_LDA(dst, b, h) do { _Pragma("unroll") for (int m = 0; m < 4; ++m) _Pragma("unroll") for (int k = 0; k < 2; ++k) dst[m][k] = *(const LAS bf16x8*)(lds + PG8_SA(b, h) + aoff + m * 2048 + k * 1024); } while (0)
#define PG8_LDB(dst, b, h) do { _Pragma("unroll") for (int n = 0; n < 2; ++n) _Pragma("unroll") for (int k = 0; k < 2; ++k) dst[n][k] = *(const LAS bf16x8*)(lds + PG8_SB(b, h) + boff + n * 2048 + k * 1024); } while (0)
#define PG8_MMA(ai, bj, At, Bt) do { __builtin_amdgcn_s_setprio(1); _Pragma("unroll") for (int m = 0; m < 4; ++m) _Pragma("unroll") for (int n = 0; n < 2; ++n) _Pragma("unroll") for (int k = 0; k < 2; ++k) \
        acc[ai][bj][m][n] = __builtin_amdgcn_mfma_f32_16x16x32_bf16(Bt[n][k], At[m][k], acc[ai][bj][m][n], 0, 0, 0); __builtin_amdgcn_s_setprio(0); } while (0)
#define PG8_WAIT_V(n) asm volatile("s_waitcnt vmcnt(" #n ")" ::: "memory")
#define PG8_WAIT_L(n) asm volatile("s_waitcnt lgkmcnt(" #n ")" ::: "memory")
#define PG8_BAR __builtin_amdgcn_s_barrier()
#define PG8_SCHED __builtin_amdgcn_sched_barrier(0)
    Unit cur, nxt; int ui = 0;
    if (!S.next(0, cur)) return;
    f32x4 acc[2][2][4][2];
#pragma unroll
    for (int a = 0; a < 2; ++a)
#pragma unroll
        for (int b = 0; b < 2; ++b)
#pragma unroll
            for (int m = 0; m < 4; ++m)
#pragma unroll
                for (int n = 0; n < 2; ++n) acc[a][b][m][n] = (f32x4){0.f, 0.f, 0.f, 0.f};
    bf16x8 At[4][2], B0[2][2], B1[2][2];
    const char* cA = (const char*)g.A + (size_t)cur.pm * tstepA + (size_t)cur.k0 * 2; const char* cB = (const char*)g.Bt + (size_t)cur.pn * tstepB + (size_t)cur.k0 * 2;
    PG8_STAGE(PG8_SB(0, 0), cB, voffB); PG8_STAGE(PG8_SB(0, 1), cB + hstepB, voffB); PG8_STAGE(PG8_SA(0, 0), cA, voffA); PG8_STAGE(PG8_SA(0, 1), cA + hstepA, voffA);
    if (wr == 1) PG8_BAR;
    PG8_WAIT_V(2); PG8_BAR;
    PG8_STAGE(PG8_SB(1, 0), cB + kstep, voffB); PG8_STAGE(PG8_SA(1, 0), cA + kstep, voffA); PG8_STAGE(PG8_SB(1, 1), cB + hstepB + kstep, voffB);
    PG8_WAIT_V(6); PG8_BAR;
    for (;;) {
        const bool has_next = S.next(ui + 1, nxt);
        const char* nA = has_next ? (const char*)g.A + (size_t)nxt.pm * tstepA + (size_t)nxt.k0 * 2 : cA;
        const char* nB = has_next ? (const char*)g.Bt + (size_t)nxt.pn * tstepB + (size_t)nxt.k0 * 2 : cB;
        const int nt = cur.nt;
        for (int t = 0; t < nt; t += 2) {
            const bool last = (t == nt - 2);
            const char* a1 = cA + (size_t)(t + 1) * kstep;
            const char* a2 = last ? nA : cA + (size_t)(t + 2) * kstep; const char* b2 = last ? nB : cB + (size_t)(t + 2) * kstep;
            const char* a3 = a2 + kstep; const char* b3 = b2 + kstep;
            PG8_LDB(B0, 0, 0); PG8_LDB(B1, 0, 1); PG8_SCHED; PG8_LDA(At, 0, 0); PG8_STAGE(PG8_SA(1, 1), a1 + hstepA, voffA);
            PG8_WAIT_V(8); PG8_WAIT_L(0); PG8_BAR; PG8_MMA(0, 0, At, B0); PG8_MMA(0, 1, At, B1); PG8_BAR; PG8_SCHED;
            PG8_LDA(At, 0, 1); PG8_STAGE(PG8_SB(0, 0), b2, voffB); PG8_STAGE(PG8_SB(0, 1), b2 + hstepB, voffB); PG8_STAGE(PG8_SA(0, 0), a2, voffA);
            PG8_WAIT_V(8); PG8_WAIT_L(0); PG8_BAR; PG8_MMA(1, 0, At, B0); PG8_MMA(1, 1, At, B1); PG8_BAR; PG8_SCHED;
            PG8_LDB(B0, 1, 0); PG8_LDB(B1, 1, 1); PG8_SCHED; PG8_LDA(At, 1, 0); PG8_STAGE(PG8_SA(0, 1), a2 + hstepA, voffA);
            PG8_WAIT_V(8); PG8_WAIT_L(0); PG8_BAR; PG8_MMA(0, 0, At, B0); PG8_MMA(0, 1, At, B1); PG8_BAR; PG8_SCHED;
            PG8_LDA(At, 1, 1); PG8_STAGE(PG8_SB(1, 0), b3, voffB); PG8_STAGE(PG8_SB(1, 1), b3 + hstepB, voffB); PG8_STAGE(PG8_SA(1, 0), a3, voffA);
            PG8_WAIT_V(8); PG8_WAIT_L(0); PG8_BAR; PG8_MMA(1, 0, At, B0); PG8_MMA(1, 1, At, B1); PG8_BAR; PG8_SCHED;
        }
        if (wr == 0) PG8_BAR;
        E(acc, cur, wr, wc, fr, fq);
        if (!has_next) break;
        if (Epi::reset(cur))
#pragma unroll
        for (int a = 0; a < 2; ++a)
#pragma unroll
            for (int b = 0; b < 2; ++b)
#pragma unroll
                for (int m = 0; m < 4; ++m)
#pragma unroll
                    for (int n = 0; n < 2; ++n) acc[a][b][m][n] = (f32x4){0.f, 0.f, 0.f, 0.f};
        cur = nxt; cA = nA; cB = nB; ++ui;
        if (wr == 1) PG8_BAR;
    }
    PG8_WAIT_V(0);
    PG8_BAR;
#undef PG8_SA
#undef PG8_SB
#undef PG8_STAGE
#undef PG8_LDA
#undef PG8_LDB
#undef PG8_MMA
#undef PG8_WAIT_V
#undef PG8_WAIT_L
#undef PG8_BAR
#undef PG8_SCHED
}
}


#define XB_TMO      128
#define XB_XCNT(j)  (256  + 64 * (j))
#define XB_XSUB(j)  (1280 + 64 * (j))
#define XB_XGEN(j)  (2304 + 64 * (j))
#define XB_TOP      3328
#define XB_TOPGEN   3392
#define XCD_BAR_WORDS 3456
#define XB_SPIN_CAP (1u << 18)
__device__ __forceinline__ unsigned xb_ld(unsigned* p)              { return __hip_atomic_load(p, __ATOMIC_RELAXED, __HIP_MEMORY_SCOPE_AGENT); }
__device__ __forceinline__ unsigned xb_add(unsigned* p, unsigned v) { return __hip_atomic_fetch_add(p, v, __ATOMIC_RELAXED, __HIP_MEMORY_SCOPE_AGENT); }
__device__ __forceinline__ unsigned xb_xcc_id() { return (unsigned)__builtin_amdgcn_s_getreg((3 << 11) | 20) & 0xFu; }
#define XB_SPIN(cond, bar) do { unsigned _sp = 0; while (cond) { __builtin_amdgcn_s_sleep(1); \
    if ((++_sp & 255u) == 0u) { if (xb_ld(&(bar)[XB_TMO])) break; if (_sp > XB_SPIN_CAP) { atomicAdd(&(bar)[XB_TMO], 1u); break; } } } } while (0)
__device__ __forceinline__ void xcd_barrier_complete(unsigned* bar, unsigned x, unsigned& nloc, unsigned& nx) {
    const unsigned G = gridDim.x * gridDim.y * gridDim.z;
    unsigned sum, cnt, mine, sp = 0u;
    for (;;) {
        sum = 0u; cnt = 0u; mine = 0u;
#pragma unroll
        for (unsigned j = 0; j < 16; ++j) { const unsigned c = xb_ld(&bar[XB_XCNT(j)]); sum += c; cnt += (c > 0u) ? 1u : 0u; mine = (j == x) ? c : mine; }
        if (sum == G) break;
        __builtin_amdgcn_s_sleep(1);
        if ((++sp & 255u) == 0u) { if (xb_ld(&bar[XB_TMO])) break; if (sp > XB_SPIN_CAP) { atomicAdd(&bar[XB_TMO], 1u); break; } }
    }
    nloc = mine > 0u ? mine : 1u; nx = cnt > 0u ? cnt : 1u;
}
__device__ __forceinline__ void xcd_barrier(unsigned* bar, volatile LAS unsigned* st) {
    asm volatile("s_waitcnt vmcnt(0)" ::: "memory");
    __syncthreads();
    if (threadIdx.x == 0) {
        const unsigned x = xb_xcc_id();
        __builtin_amdgcn_s_waitcnt(0);
        unsigned nloc = st[0], nx = st[1];
        if (nloc == 0u) { xcd_barrier_complete(bar, x, nloc, nx); st[0] = nloc; st[1] = nx; }
        const unsigned old = xb_add(&bar[XB_XSUB(x)], 1u);
        const unsigned gen = old / nloc;
        if (old + 1u == (gen + 1u) * nloc) {
            __builtin_amdgcn_fence(__ATOMIC_RELEASE, "agent");
            asm volatile("s_waitcnt vmcnt(0)" ::: "memory");
            const unsigned og = xb_add(&bar[XB_TOP], 1u);
            const unsigned tg = og / nx;
            if (og + 1u == (tg + 1u) * nx) xb_add(&bar[XB_TOPGEN], 1u);
            else XB_SPIN(xb_ld(&bar[XB_TOPGEN]) == tg, bar);
            __builtin_amdgcn_fence(__ATOMIC_ACQUIRE, "agent");
            xb_add(&bar[XB_XGEN(x)], 1u);
            asm volatile("s_waitcnt vmcnt(0)" ::: "memory");
        } else {
            XB_SPIN(xb_ld(&bar[XB_XGEN(x)]) == gen, bar);
            __builtin_amdgcn_fence(__ATOMIC_ACQUIRE, "agent");
            asm volatile("s_waitcnt vmcnt(0)" ::: "memory");
        }
    }
    __syncthreads();
}

struct Ctx {
    int bx;
    bf16_t *win, *wb, *wout, *h, *proj, *gates, *y, *mb;
    float *mf, *of, *kva, *kvd, *decd, *ropeAc, *ropeAs, *ropeBc, *ropeBs, *lbt;
    int tid, lane, w, G;
};

struct TJob { const float* src; bf16_t* dst; int N, Kp; };
__device__ __forceinline__ TJob tjob_decode(const Params& P, Ctx& C, int job) {
    const int l = job / 2496, j = job % 2496; TJob t; int kt, nt;
    if (j < 1920) { kt = j / 120; nt = j % 120; t.N = DIN; t.Kp = DM; t.src = P.w_in + (size_t)l * DM * DIN; t.dst = C.win + (size_t)l * DIN * DM; }
    else if (j < 2240) { const int jj = j - 1920; kt = jj / 16; nt = jj % 16; t.N = DM; t.Kp = WMIX; t.src = P.w_branch + (size_t)l * WMIX * DM; t.dst = C.wb + (size_t)l * DM * WMIX; }
    else { const int jj = j - 2240; kt = jj / 16; nt = jj % 16; t.N = DM; t.Kp = DM; t.src = P.w_out + (size_t)l * DM * DM; t.dst = C.wout + (size_t)l * DM * DM; }
    t.src += (size_t)(kt * 64) * t.N + nt * 64; t.dst += (size_t)(nt * 64) * t.Kp + kt * 64; return t;
}

__device__ __forceinline__ void phase_prologue(const Params& P, Ctx& C, unsigned char* lds) {
    const int tid = C.tid;
    float* scr = (float*)lds;
    {
        const int kk = tid >> 3, c8 = (tid & 7) * 8, n = tid >> 3, k8 = (tid & 7) * 8;
        int job = C.bx, par = 0; float4 a, b; TJob cur;
        if (job < 4 * 2496) { cur = tjob_decode(P, C, job); const float4* sp = (const float4*)(cur.src + (size_t)kk * cur.N + c8); a = sp[0]; b = sp[1]; }
        while (job < 4 * 2496) {
            float* r = scr + par * (64 * 65) + kk * 65 + c8;
            r[0] = a.x; r[1] = a.y; r[2] = a.z; r[3] = a.w; r[4] = b.x; r[5] = b.y; r[6] = b.z; r[7] = b.w;
            const int nxt = job + C.G; TJob nj;
            if (nxt < 4 * 2496) { nj = tjob_decode(P, C, nxt); const float4* sp = (const float4*)(nj.src + (size_t)kk * nj.N + c8); a = sp[0]; b = sp[1]; }
            __syncthreads();
            const float* q = scr + par * (64 * 65) + k8 * 65 + n;
            u32x4 wv; wv.x = pk2(q[0], q[65]); wv.y = pk2(q[130], q[195]); wv.z = pk2(q[260], q[325]); wv.w = pk2(q[390], q[455]);
            *(u32x4*)(cur.dst + (size_t)n * cur.Kp + k8) = wv;
            cur = nj; job = nxt; par ^= 1;
        }
        __syncthreads();
    }
    for (int row = C.bx * 8 + C.w; row < M_TOT; row += C.G * 8) {
        const float* xs = row < M_P ? P.x_prompt + (size_t)row * DM : P.x_sample + (size_t)(row - M_P) * DM;
        float4 x[4]; float ss = 0.f;
#pragma unroll
        for (int i = 0; i < 4; ++i) { x[i] = ((const float4*)xs)[C.lane + 64 * i]; ss += x[i].x * x[i].x + x[i].y * x[i].y + x[i].z * x[i].z + x[i].w * x[i].w; }
        ss = wave_sum(ss); const float r = rsqrtf(ss * (1.f / DM) + EPS);
#pragma unroll
        for (int i = 0; i < 4; ++i) { ((float4*)(P.out + (size_t)row * DM))[C.lane + 64 * i] = x[i];
            const float4 g = ((const float4*)P.g_pre)[C.lane + 64 * i];
            uint2 o; o.x = pk2(x[i].x * r * g.x, x[i].y * r * g.y); o.y = pk2(x[i].z * r * g.z, x[i].w * r * g.w);
            ((uint2*)(C.h + (size_t)row * DM))[C.lane + 64 * i] = o; }
    }
    const int gt = C.bx * NTHREADS + tid, gn = C.G * NTHREADS;
    const double TWO_PI = 6.283185307179586476925286766559, INV_2PI = 0.15915494309189533576888376337251;
    for (int i = gt; i < NPOS * 24; i += gn) {
        int pos, f; double inv;
        if (i < NPOS * 16) { pos = i >> 4; f = i & 15; inv = P.invA[f]; } else { const int k = i - NPOS * 16; pos = k >> 3; f = k & 7; inv = P.invB[f]; }
        double r = (double)pos * inv * INV_2PI; r -= floor(r);
        const float a = (float)(r * TWO_PI);
        const float cs = cosf(a), sn = sinf(a);
        if (i < NPOS * 16) { C.ropeAc[i] = cs; C.ropeAs[i] = sn; } else { C.ropeBc[i - NPOS * 16] = cs; C.ropeBs[i - NPOS * 16] = sn; }
    }
    for (int c = gt; c < 256; c += gn) {
        const float v0 = P.lower_bounds[c], v1 = P.lower_bounds[256 + c], v2 = P.lower_bounds[512 + c], v3 = P.lower_bounds[768 + c];
        const float m = fmaxf(fmaxf(v0, v1), fmaxf(v2, v3));
        const float e0 = expf(v0 - m), e1 = expf(v1 - m), e2 = expf(v2 - m), e3 = expf(v3 - m), inv = 1.f / (e0 + e1 + e2 + e3);
        C.lbt[c] = 0.f; C.lbt[256 + c] = e1 * inv; C.lbt[512 + c] = (e1 + e2) * inv; C.lbt[768 + c] = (e1 + e2 + e3) * inv;
    }
}

__device__ __forceinline__ void attn_prompt_unit(const Params& P, Ctx& C, int l, int b, int qb, int kvh, unsigned char* lds) {
    const int tid = C.tid, lane = C.lane, w = C.w, fr = lane & 15, fq = lane >> 4;
    bf16_t* Ks = (bf16_t*)lds;
    bf16_t* Vt = (bf16_t*)(lds + 36864);
    bf16_t* Ps = (bf16_t*)(lds + 36864 + 35840) + w * (16 * 168);
    const int t0 = qb * 128; const size_t R0 = (size_t)b * 8192 + t0;
    const bool last = (qb == 63);
#pragma unroll 2
    for (int it = 0; it < 4; ++it) { const int i = tid + it * NTHREADS;
      if (i < 256 * 7) {
        const int kk = i / 7, task = i - kk * 7, tk = t0 - 128 + kk;
        bf16_t* dst = Ks + kk * 72;
        if (tk < 0) { const u32x4 z = {0u, 0u, 0u, 0u}; if (task == 0) { *(u32x4*)dst = z; *(u32x4*)(dst + 8) = z; } else *(u32x4*)(dst + (task + 1) * 8) = z; }
        else {
            const bf16_t* src = C.proj + (size_t)(b * 8192 + tk) * NPROJ + C_KB + kvh * 64;
            if (task == 0) {
                const u32x4 a = *(const u32x4*)src, bb = *(const u32x4*)(src + 8);
                const float4 c0 = *(const float4*)(C.ropeBc + tk * 8), c1 = *(const float4*)(C.ropeBc + tk * 8 + 4), s0 = *(const float4*)(C.ropeBs + tk * 8), s1 = *(const float4*)(C.ropeBs + tk * 8 + 4);
                float x1[8], x2[8]; unpack8(a, x1); unpack8(bb, x2);
                const float cs[8] = {c0.x, c0.y, c0.z, c0.w, c1.x, c1.y, c1.z, c1.w}, sn[8] = {s0.x, s0.y, s0.z, s0.w, s1.x, s1.y, s1.z, s1.w};
                float r1[8], r2[8];
#pragma unroll
                for (int j = 0; j < 8; ++j) { r1[j] = x1[j] * cs[j] - x2[j] * sn[j]; r2[j] = x2[j] * cs[j] + x1[j] * sn[j]; }
                *(u32x4*)dst = pack8(r1); *(u32x4*)(dst + 8) = pack8(r2);
            } else { const int c = task + 1; *(u32x4*)(dst + c * 8) = *(const u32x4*)(src + c * 8); }
        }
      } }
#pragma unroll
    for (int it = 0; it < 4; ++it) { const int i = tid + it * NTHREADS;
        const int kk = i & 255, c = i >> 8, tk = t0 - 128 + kk;
        u32x4 a = {0u, 0u, 0u, 0u};
        if (tk >= 0) a = *(const u32x4*)(C.proj + (size_t)(b * 8192 + tk) * NPROJ + C_VB + kvh * 64 + c * 8);
        bf16_t* d = Vt + (c * 8) * 280 + kk;
        d[0] = (bf16_t)(a.x & 0xffff); d[280] = (bf16_t)(a.x >> 16); d[560] = (bf16_t)(a.y & 0xffff); d[840] = (bf16_t)(a.y >> 16);
        d[1120] = (bf16_t)(a.z & 0xffff); d[1400] = (bf16_t)(a.z >> 16); d[1680] = (bf16_t)(a.w & 0xffff); d[1960] = (bf16_t)(a.w >> 16);
    }
    for (int i = tid; i < 64 * 24; i += NTHREADS) Vt[(i / 24) * 280 + 256 + (i % 24)] = 0;
    for (int i = lane; i < 16 * 16; i += 64) Ps[(i >> 4) * 168 + 144 + (i & 15)] = 0;
    __syncthreads();
    if (last) {
        for (int i = tid; i < 128 * 64; i += NTHREADS) { const int wq = i >> 6, d = i & 63;
            const size_t o = ((((size_t)l * 2 + b) * 128 + wq) * 2 + kvh) * 64 + d;
            P.out[O_KP + o] = bf2f(Ks[(128 + wq) * 72 + d]); P.out[O_VP + o] = bf2f(Vt[d * 280 + 128 + wq]); }
    }
    const int tq = t0 + w * 16 + fr;
#pragma unroll
    for (int g = 0; g < 4; ++g) {
        const int h = kvh * 4 + g;
        const bf16_t* qsrc = C.proj + (R0 + w * 16 + fr) * NPROJ + C_QB + h * 64;
        u32x4 q0 = *(const u32x4*)(qsrc + fq * 8); const u32x4 q1 = *(const u32x4*)(qsrc + 32 + fq * 8);
        if (fq < 2) {
            const u32x4 qp = *(const u32x4*)(qsrc + (fq ^ 1) * 8);
            const float4 c0 = *(const float4*)(C.ropeBc + tq * 8), c1 = *(const float4*)(C.ropeBc + tq * 8 + 4), s0 = *(const float4*)(C.ropeBs + tq * 8), s1 = *(const float4*)(C.ropeBs + tq * 8 + 4);
            const float sg = fq == 0 ? -1.f : 1.f;
            const float own[8] = {lo16(q0.x), hi16(q0.x), lo16(q0.y), hi16(q0.y), lo16(q0.z), hi16(q0.z), lo16(q0.w), hi16(q0.w)};
            const float par[8] = {lo16(qp.x), hi16(qp.x), lo16(qp.y), hi16(qp.y), lo16(qp.z), hi16(qp.z), lo16(qp.w), hi16(qp.w)};
            const float cs[8] = {c0.x, c0.y, c0.z, c0.w, c1.x, c1.y, c1.z, c1.w}, sn[8] = {s0.x, s0.y, s0.z, s0.w, s1.x, s1.y, s1.z, s1.w};
            float r[8];
#pragma unroll
            for (int j = 0; j < 8; ++j) r[j] = own[j] * cs[j] + sg * par[j] * sn[j];
            q0.x = pk2(r[0], r[1]); q0.y = pk2(r[2], r[3]); q0.z = pk2(r[4], r[5]); q0.w = pk2(r[6], r[7]);
        }
        const bf16x8 qa0 = __builtin_bit_cast(bf16x8, q0), qa1 = __builtin_bit_cast(bf16x8, q1);
        f32x4 S[9];
#pragma unroll
        for (int jt = 0; jt < 9; ++jt) {
            const bf16_t* kp = Ks + ((w + jt) * 16 + fr) * 72 + fq * 8;
            f32x4 a = {0.f, 0.f, 0.f, 0.f};
            a = mfma16(qa0, *(const bf16x8*)kp, a); a = mfma16(qa1, *(const bf16x8*)(kp + 32), a);
            S[jt] = a;
        }
        const float sink = P.attn_sink[l * 8 + h];
        float mx[4], sm[4];
#pragma unroll
        for (int j = 0; j < 4; ++j) {
            const int r = w * 16 + fq * 4 + j;
            float m = -1e30f;
#pragma unroll
            for (int jt = 0; jt < 9; ++jt) { const int kk = (w + jt) * 16 + fr; const bool ok = (kk >= r) && (kk <= r + 128) && (t0 - 128 + kk >= 0);
                const float s = ok ? S[jt][j] * 0.125f : -1e30f; S[jt][j] = s; m = fmaxf(m, s); }
            m = fmaxf(quad16_max(m), sink); mx[j] = m;
            float su = 0.f;
#pragma unroll
            for (int jt = 0; jt < 9; ++jt) { const float p = __expf(S[jt][j] - m); su += p; Ps[(fq * 4 + j) * 168 + jt * 16 + fr] = f2bf(p); }
            su = quad16_sum(su) + __expf(sink - m); sm[j] = 1.f / su;
        }
        __syncthreads();
        float zz[4][4];
#pragma unroll
        for (int j = 0; j < 4; ++j)
#pragma unroll
            for (int nt = 0; nt < 4; ++nt) zz[j][nt] = bf2f(C.proj[(R0 + w * 16 + fq * 4 + j) * NPROJ + C_ZB + h * 64 + nt * 16 + fr]);
        f32x4 O[4];
#pragma unroll
        for (int nt = 0; nt < 4; ++nt) O[nt] = (f32x4){0.f, 0.f, 0.f, 0.f};
#pragma unroll
        for (int kx = 0; kx < 5; ++kx) {
            const bf16x8 a = *(const bf16x8*)(Ps + fr * 168 + kx * 32 + fq * 8);
#pragma unroll
            for (int nt = 0; nt < 4; ++nt) O[nt] = mfma16(a, *(const bf16x8*)(Vt + (nt * 16 + fr) * 280 + w * 16 + kx * 32 + fq * 8), O[nt]);
        }
#pragma unroll
        for (int j = 0; j < 4; ++j) {
            const size_t row = R0 + w * 16 + fq * 4 + j;
#pragma unroll
            for (int nt = 0; nt < 4; ++nt) { const int e = nt * 16 + fr;
                C.y[row * WMIX + Y_B + h * 64 + e] = f2bf(O[nt][j] * sm[j] * silu_(zz[j][nt])); }
        }
        __syncthreads();
    }
}

__device__ __forceinline__ void pool_prompt_unit(const Params& P, Ctx& C, int l, int tile, unsigned char* lds) {
    const int tid = C.tid, lane = C.lane, w = C.w, fr = lane & 15, fq = lane >> 4;
    bf16_t* U = (bf16_t*)lds;
    bf16_t* A = (bf16_t*)(lds + 40448);
    bf16_t* Wt = (bf16_t*)(lds + 40448 + 33792);
    const int b = tile >> 7, t0 = (tile & 127) * 64; const size_t R0 = (size_t)b * 8192 + t0;
    for (int i = tid; i < 79 * 32; i += NTHREADS) { const int r = i >> 5, c = i & 31, t = t0 - 15 + r;
        u32x4 a = {0u, 0u, 0u, 0u}; if (t >= 0) a = *(const u32x4*)(C.proj + (size_t)(b * 8192 + t) * NPROJ + C_UC + c * 8);
        *(u32x4*)(U + r * 256 + c * 8) = a; }
    for (int i = tid; i < 4 * 64 * 64; i += NTHREADS) { const int g = i >> 12, cin = (i >> 6) & 63, dout = i & 63;
        Wt[(g * 64 + dout) * 72 + cin] = f2bf(P.w_pool[(size_t)l * 16384 + i]); }
    __syncthreads();
    { const int c = tid & 255, rh = tid >> 8, g = c >> 6, wn = 2 << g;
      for (int r = rh * 32; r < rh * 32 + 32; ++r) {
          float s = 0.f; for (int j = 0; j < wn; ++j) s += bf2f(U[(r + 15 - j) * 256 + c]);
          const int pos = t0 + r; const float cnt = (float)(pos + 1 < wn ? pos + 1 : wn);
          const float u = bf2f(U[(r + 15) * 256 + c]);
          A[r * 264 + c] = f2bf(s / cnt - u);
          if (t0 == 8128 && r >= 49) P.out[O_POOLP + (((size_t)l * 2 + b) * 15 + (r - 49)) * 256 + c] = u;
      } }
    __syncthreads();
    for (int tl = w; tl < 64; tl += 8) { const int rt = tl >> 4, ct = tl & 15, g = ct >> 2;
        f32x4 acc = {0.f, 0.f, 0.f, 0.f};
        acc = mma_tile(A + rt * 16 * 264 + g * 64, 264, Wt + (g * 64 + (ct & 3) * 16) * 72, 72, 64, acc, lane);
        const int c = ct * 16 + fr; const float sc = P.pool_scale[l * 256 + c];
        float zz[4];
#pragma unroll
        for (int j = 0; j < 4; ++j) zz[j] = bf2f(C.proj[(R0 + rt * 16 + fq * 4 + j) * NPROJ + C_ZC + c]);
#pragma unroll
        for (int j = 0; j < 4; ++j) { const size_t row = R0 + rt * 16 + fq * 4 + j;
            C.y[row * WMIX + Y_C + c] = f2bf(acc[j] * sc * silu_(zz[j])); }
    }
    __syncthreads();
}

template <bool IS_D, bool KV>
__device__ __forceinline__ void lin_chunk(const Params& P, Ctx& C, int l, int b, int n, unsigned char* lds) {
    const int lane = C.lane, w = C.w, fr = lane & 15, fq = lane >> 4;
    constexpr int DK = IS_D ? 64 : 32, NCG = DK / 8, HPR = KV ? 4 : 2;
    constexpr int SLOT = KV ? 18432 : 53248, VP = KV ? 72 : 136;
    const size_t R0 = (size_t)b * 8192 + n * 64;
    const bf16_t* prow = C.proj + (R0 + lane) * NPROJ;
    for (int h0 = 0; h0 < 4; h0 += HPR) {
        float decv[(HPR * NCG) / 8][8];
#pragma unroll
        for (int ti = 0; ti < (HPR * NCG) / 8; ++ti) { const int task = w + ti * 8;
            const int hh = task / NCG, cg = task % NCG, h = h0 + hh, d0 = cg * 8;
            unsigned char* slot = lds + hh * SLOT;
            float q[8], k[8], Bt[8], Bm[8], Bl[8];
            if (IS_D) {
                float qv[8], fv[8]; unpack8(*(const u32x4*)(prow + C_QD + h * 64 + d0), qv); unpack8(*(const u32x4*)(prow + C_FD + h * 64 + d0), fv);
                const float4 l0 = *(const float4*)(C.lbt + l * 256 + h * 64 + d0), l1 = *(const float4*)(C.lbt + l * 256 + h * 64 + d0 + 4);
                const float lb[8] = {l0.x, l0.y, l0.z, l0.w, l1.x, l1.y, l1.z, l1.w};
#pragma unroll
                for (int j = 0; j < 8; ++j) { const float f = lb[j] + (1.f - lb[j]) * sigmoid_(fv[j]); q[j] = silu_(qv[j]); k[j] = 1.f - f;
                    float v = __logf(f);
#pragma unroll
                    for (int off = 1; off < 64; off <<= 1) { const float u = __shfl_up(v, off); if (lane >= off) v += u; }
                    Bt[j] = v; Bm[j] = __shfl(v, 31); Bl[j] = __shfl(v, 63); }
#pragma unroll
                for (int j = 0; j < 8; ++j) decv[ti][j] = Bl[j];
            } else {
                const float lg = log1pf(-exp2f(-5.f - (float)h));
                const int i0 = d0 & 15, pos = n * 64 + lane;
                float q1[8], q2[8], k1[8], k2[8];
                unpack8(*(const u32x4*)(prow + C_QA + h * 32 + i0), q1); unpack8(*(const u32x4*)(prow + C_QA + h * 32 + 16 + i0), q2);
                unpack8(*(const u32x4*)(prow + C_KA + h * 32 + i0), k1); unpack8(*(const u32x4*)(prow + C_KA + h * 32 + 16 + i0), k2);
                const float4 c0 = *(const float4*)(C.ropeAc + pos * 16 + i0), c1 = *(const float4*)(C.ropeAc + pos * 16 + i0 + 4), s0 = *(const float4*)(C.ropeAs + pos * 16 + i0), s1 = *(const float4*)(C.ropeAs + pos * 16 + i0 + 4);
                const float cs[8] = {c0.x, c0.y, c0.z, c0.w, c1.x, c1.y, c1.z, c1.w}, sn[8] = {s0.x, s0.y, s0.z, s0.w, s1.x, s1.y, s1.z, s1.w};
#pragma unroll
                for (int j = 0; j < 8; ++j) {
                    q[j] = d0 < 16 ? q1[j] * cs[j] - q2[j] * sn[j] : q2[j] * cs[j] + q1[j] * sn[j];
                    k[j] = (d0 < 16 ? k1[j] * cs[j] - k2[j] * sn[j] : k2[j] * cs[j] + k1[j] * sn[j]) * 0.17677669529663687f;
                    Bt[j] = (float)(lane + 1) * lg; Bm[j] = 32.f * lg; Bl[j] = 64.f * lg; }
            }
            if (!KV) {
                bf16_t* Qh = (bf16_t*)slot; bf16_t* Kh = (bf16_t*)(slot + 9216); bf16_t* PQ = (bf16_t*)(slot + 18432);
                float a[8], c[8], e[8];
#pragma unroll
                for (int j = 0; j < 8; ++j) { a[j] = q[j] * __expf(Bt[j] - Bm[j]); c[j] = k[j] * __expf(Bm[j] - Bt[j]); e[j] = q[j] * __expf(Bt[j]); }
                *(u32x4*)(Qh + lane * 72 + d0) = pack8(a); *(u32x4*)(Kh + lane * 72 + d0) = pack8(c); *(u32x4*)(PQ + lane * 136 + 64 + d0) = pack8(e);
            } else {
                bf16_t* KdT = (bf16_t*)slot;
#pragma unroll
                for (int j = 0; j < 8; ++j) KdT[(d0 + j) * 72 + lane] = f2bf(k[j] * __expf(Bl[j] - Bt[j]));
            }
        }
        if (IS_D && KV && lane == 63) {
#pragma unroll
            for (int ti = 0; ti < (HPR * NCG) / 8; ++ti) { const int task = w + ti * 8, h = h0 + task / NCG, d0 = (task % NCG) * 8;
#pragma unroll
                for (int j = 0; j < 8; ++j) C.decd[(size_t)(b * 128 + n) * 256 + h * 64 + d0 + j] = __expf(decv[ti][j]); } }
#pragma unroll
        for (int tv = 0; tv < HPR; ++tv) { const int task = w + tv * 8;
            const int hh = task >> 3, e0 = (task & 7) * 8, h = h0 + hh;
            bf16_t* VS = (bf16_t*)(lds + hh * SLOT + (KV ? 9216 : 35840));
            const u32x4 v = *(const u32x4*)(prow + (IS_D ? C_ID : C_VA) + h * 64 + e0);
            bf16_t* d = VS + e0 * VP + lane;
            d[0] = (bf16_t)(v.x & 0xffff); d[VP] = (bf16_t)(v.x >> 16); d[2 * VP] = (bf16_t)(v.y & 0xffff); d[3 * VP] = (bf16_t)(v.y >> 16);
            d[4 * VP] = (bf16_t)(v.z & 0xffff); d[5 * VP] = (bf16_t)(v.z >> 16); d[6 * VP] = (bf16_t)(v.w & 0xffff); d[7 * VP] = (bf16_t)(v.w >> 16);
            if (!KV && lane < DK) {
                const float* sp = (IS_D ? C.kvd : C.kva) + ((size_t)(b * 128 + n) * 4 + h) * (DK * 64) + lane * 64 + e0;
                const float4 s0 = *(const float4*)sp, s1 = *(const float4*)(sp + 4);
                bf16_t* ds = VS + e0 * VP + 64 + lane;
                ds[0] = f2bf(s0.x); ds[VP] = f2bf(s0.y); ds[2 * VP] = f2bf(s0.z); ds[3 * VP] = f2bf(s0.w); ds[4 * VP] = f2bf(s1.x); ds[5 * VP] = f2bf(s1.y); ds[6 * VP] = f2bf(s1.z); ds[7 * VP] = f2bf(s1.w);
            }
        }
        __syncthreads();
        if (KV) {
            constexpr int TPH = (DK / 16) * 4;
            for (int tl = w; tl < 4 * TPH; tl += 8) { const int hh = tl / TPH, r = tl % TPH, dt = r >> 2, et = r & 3, h = h0 + hh;
                const bf16_t* KdT = (const bf16_t*)(lds + hh * SLOT); const bf16_t* VT = (const bf16_t*)(lds + hh * SLOT + 9216);
                f32x4 acc = {0.f, 0.f, 0.f, 0.f};
                acc = mma_tile(KdT + dt * 16 * 72, 72, VT + et * 16 * 72, 72, 64, acc, lane);
                float* kvbase = (IS_D ? C.kvd : C.kva) + ((size_t)(b * 128 + n) * 4 + h) * (DK * 64);
#pragma unroll
                for (int j = 0; j < 4; ++j) kvbase[(dt * 16 + fq * 4 + j) * 64 + et * 16 + fr] = acc[j]; }
        } else {
            for (int tl = w; tl < 32; tl += 8) { const int hh = tl >> 4, rt = (tl >> 2) & 3, ct = tl & 3;
                const bf16_t* Qh = (const bf16_t*)(lds + hh * SLOT); const bf16_t* Kh = (const bf16_t*)(lds + hh * SLOT + 9216); bf16_t* PQ = (bf16_t*)(lds + hh * SLOT + 18432);
                f32x4 acc = {0.f, 0.f, 0.f, 0.f};
                if (ct <= rt) acc = mma_tile(Qh + rt * 16 * 72, 72, Kh + ct * 16 * 72, 72, DK, acc, lane);
#pragma unroll
                for (int j = 0; j < 4; ++j) { const int t = rt * 16 + fq * 4 + j, sidx = ct * 16 + fr; PQ[t * 136 + sidx] = f2bf(sidx <= t ? acc[j] : 0.f); } }
            __syncthreads();
            { const int hh = w >> 2, rt = w & 3, h = h0 + hh;
                const bf16_t* PQ = (const bf16_t*)(lds + hh * SLOT + 18432); const bf16_t* VS = (const bf16_t*)(lds + hh * SLOT + 35840);
                float zz[4][4], gg[4];
#pragma unroll
                for (int et = 0; et < 4; ++et) { gg[et] = IS_D ? P.g_hgrn[l * 256 + h * 64 + et * 16 + fr] : 1.f;
#pragma unroll
                    for (int j = 0; j < 4; ++j) zz[j][et] = bf2f(C.proj[(R0 + rt * 16 + fq * 4 + j) * NPROJ + (IS_D ? C_ZD : C_ZA) + h * 64 + et * 16 + fr]); }
                f32x4 O[4];
#pragma unroll
                for (int et = 0; et < 4; ++et) { O[et] = (f32x4){0.f, 0.f, 0.f, 0.f}; O[et] = mma_tile(PQ + rt * 16 * 136, 136, VS + et * 16 * 136, 136, 64 + DK, O[et], lane); }
#pragma unroll
                for (int j = 0; j < 4; ++j) {
                    float ss = O[0][j] * O[0][j] + O[1][j] * O[1][j] + O[2][j] * O[2][j] + O[3][j] * O[3][j];
                    ss = quad16_sum(ss); const float r = rsqrtf(ss * (1.f / 64.f) + EPS);
                    const size_t row = R0 + rt * 16 + fq * 4 + j;
#pragma unroll
                    for (int et = 0; et < 4; ++et) { const int e = et * 16 + fr;
                        C.y[row * WMIX + (IS_D ? Y_D : Y_A) + h * 64 + e] = f2bf(O[et][j] * r * gg[et] * silu_(zz[j][et])); }
                }
            }
        }
        __syncthreads();
    }
}

#define PR(t, c) bf2f(prb[(t) * NPROJ + (c)])
__device__ __forceinline__ void sample_b_unit(const Params& P, Ctx& C, int l, int sb, unsigned char* lds) {
    const int tid = C.tid, lane = C.lane, w = C.w;
    bf16_t* prb = (bf16_t*)lds;
    float* qbq = (float*)(lds + 28672);
    float* kn = qbq + 2048;
    float* ps = kn + 512;
    float* kv = ps + 32 * 136;
    const size_t R0 = (size_t)M_P + sb * 4;
    const float4* kc4 = (const float4*)(P.cache_k + ((size_t)l * 128 + sb) * 16384);
    const float4* vc4 = (const float4*)(P.cache_v + ((size_t)l * 128 + sb) * 16384);
    for (int i = tid; i < 4 * 448; i += NTHREADS) { const int t = i / 448, c = i % 448;
        *(u32x4*)(prb + t * NPROJ + c * 8) = *(const u32x4*)(C.proj + (R0 + t) * NPROJ + c * 8); }
    { float4* ko = (float4*)(P.out + O_KS + ((size_t)l * 128 + sb) * 16384);
      f32x4 cv[8];
#pragma unroll
      for (int j = 0; j < 8; ++j) cv[j] = ((const f32x4*)kc4)[tid + NTHREADS * j];
#pragma unroll
      for (int j = 0; j < 8; ++j) { const int i = tid + NTHREADS * j, e = i * 4, wq = e >> 7, r = e & 127;
          *(f32x4*)(kv + (wq * 2 + (r >> 6)) * 68 + (r & 63)) = cv[j];
          if (wq >= 4) ((f32x4*)ko)[i - 128] = cv[j]; } }
    __syncthreads();
    for (int i = tid; i < 2048; i += NTHREADS) { const int t = i >> 9, c = i & 511, h = c >> 6, d = c & 63; const int pos = 8192 + t;
        float v;
        if (d < 16) { const int ii = d & 7; const float cs = C.ropeBc[pos * 8 + ii], sn = C.ropeBs[pos * 8 + ii];
            const float x1 = PR(t, C_QB + h * 64 + ii), x2 = PR(t, C_QB + h * 64 + 8 + ii); v = d < 8 ? x1 * cs - x2 * sn : x2 * cs + x1 * sn; }
        else v = PR(t, C_QB + c);
        qbq[i] = v * 0.125f; }
    { const int t = tid >> 7, c = tid & 127, kh = c >> 6, d = c & 63, pos = 8192 + t;
        float v;
        if (d < 16) { const int ii = d & 7; const float cs = C.ropeBc[pos * 8 + ii], sn = C.ropeBs[pos * 8 + ii];
            const float x1 = PR(t, C_KB + kh * 64 + ii), x2 = PR(t, C_KB + kh * 64 + 8 + ii); v = d < 8 ? x1 * cs - x2 * sn : x2 * cs + x1 * sn; }
        else v = PR(t, C_KB + c);
        kn[tid] = v;
        P.out[O_KS + (((size_t)l * 128 + sb) * 128 + 124 + t) * 128 + c] = v;
        P.out[O_VS + (((size_t)l * 128 + sb) * 128 + 124 + t) * 128 + c] = PR(t, C_VB + c); }
    __syncthreads();
    for (int i = tid; i < 4224; i += NTHREADS) { const int kh = i / 2112, rem = i - kh * 2112, r16 = rem / 132, kk = rem - r16 * 132, g = r16 >> 2, t = r16 & 3, h = kh * 4 + g;
        const bool ok = kk < 128 ? (kk >= t) : (kk - 128 <= t);
        const float4* kp = (const float4*)(kk < 128 ? kv + (kk * 2 + kh) * 68 : kn + (kk - 128) * 128 + kh * 64);
        const float4* qp = (const float4*)(qbq + t * 512 + h * 64);
        float s = 0.f;
#pragma unroll 4
        for (int d = 0; d < 16; ++d) { const float4 a = qp[d], bq = kp[d]; s += a.x * bq.x + a.y * bq.y + a.z * bq.z + a.w * bq.w; }
        ps[(h * 4 + t) * 136 + kk] = ok ? s : -1e30f; }
    __syncthreads();
    { float4* vo = (float4*)(P.out + O_VS + ((size_t)l * 128 + sb) * 16384);
      f32x4 cv[8];
#pragma unroll
      for (int j = 0; j < 8; ++j) cv[j] = ((const f32x4*)vc4)[tid + NTHREADS * j];
#pragma unroll
      for (int j = 0; j < 8; ++j) { const int i = tid + NTHREADS * j, e = i * 4, wq = e >> 7, r = e & 127;
          *(f32x4*)(kv + (wq * 2 + (r >> 6)) * 68 + (r & 63)) = cv[j];
          if (wq >= 4) ((f32x4*)vo)[i - 128] = cv[j]; } }
    { const int h = w; const float sink = P.attn_sink[l * 8 + h];
      for (int t = 0; t < 4; ++t) { float* pr_ = ps + (h * 4 + t) * 136;
          const float s0 = pr_[lane], s1 = pr_[lane + 64], s2 = lane < 4 ? pr_[lane + 128] : -1e30f;
          float m = fmaxf(fmaxf(s0, s1), s2); m = fmaxf(m, __shfl_xor(m, 32)); m = fmaxf(m, __shfl_xor(m, 16)); m = fmaxf(m, __shfl_xor(m, 8)); m = fmaxf(m, __shfl_xor(m, 4)); m = fmaxf(m, __shfl_xor(m, 2)); m = fmaxf(m, __shfl_xor(m, 1));
          m = fmaxf(m, sink);
          const float p0 = __expf(s0 - m), p1 = __expf(s1 - m), p2 = lane < 4 ? __expf(s2 - m) : 0.f;
          const float inv = 1.f / (wave_sum(p0 + p1 + p2) + __expf(sink - m));
          pr_[lane] = p0 * inv; pr_[lane + 64] = p1 * inv; if (lane < 4) pr_[lane + 128] = p2 * inv; } }
    __syncthreads();
    { const int h = w, kh = h >> 2, e = lane;
      float o0 = 0.f, o1 = 0.f, o2 = 0.f, o3 = 0.f; const float* p0 = ps + (h * 4) * 136;
#pragma unroll 8
      for (int kk = 0; kk < 128; ++kk) { const float v = kv[(kk * 2 + kh) * 68 + e]; o0 += p0[kk] * v; o1 += p0[136 + kk] * v; o2 += p0[272 + kk] * v; o3 += p0[408 + kk] * v; }
#pragma unroll
      for (int kk = 128; kk < 132; ++kk) { const float v = PR(kk - 128, C_VB + kh * 64 + e); o0 += p0[kk] * v; o1 += p0[136 + kk] * v; o2 += p0[272 + kk] * v; o3 += p0[408 + kk] * v; }
      const int c = h * 64 + e;
      C.y[(R0 + 0) * WMIX + Y_B + c] = f2bf(o0 * silu_(PR(0, C_ZB + c))); C.y[(R0 + 1) * WMIX + Y_B + c] = f2bf(o1 * silu_(PR(1, C_ZB + c)));
      C.y[(R0 + 2) * WMIX + Y_B + c] = f2bf(o2 * silu_(PR(2, C_ZB + c))); C.y[(R0 + 3) * WMIX + Y_B + c] = f2bf(o3 * silu_(PR(3, C_ZB + c))); }
    __syncthreads();
}

__device__ __forceinline__ void sample_adc_unit(const Params& P, Ctx& C, int l, int sb, unsigned char* lds) {
    const int tid = C.tid, lane = C.lane, w = C.w;
    bf16_t* prb = (bf16_t*)lds;
    float* qa = (float*)(lds + 28672);
    float* ka = qa + 512;
    float* qd = ka + 512;
    float* fd = qd + 1024;
    float* pl = fd + 1024;
    float* part = pl + 1024;
    const size_t R0 = (size_t)M_P + sb * 4;
    const int h = w >> 1, half = w & 1, e = lane;
    const float* SD0 = P.state_hgrn + (((size_t)l * 128 + sb) * 4 + h) * 4096 + (half * 32) * 64 + e;
    const float* SA0 = P.state_ret + (((size_t)l * 128 + sb) * 4 + h) * 2048 + (half * 16) * 64 + e;
    float sd[32], sa[16];
#pragma unroll
    for (int i = 0; i < 32; ++i) sd[i] = SD0[i * 64];
#pragma unroll
    for (int i = 0; i < 16; ++i) sa[i] = SA0[i * 64];
    for (int i = tid; i < 4 * 448; i += NTHREADS) { const int t = i / 448, c = i % 448;
        *(u32x4*)(prb + t * NPROJ + c * 8) = *(const u32x4*)(C.proj + (R0 + t) * NPROJ + c * 8); }
    __syncthreads();
    { const int t = tid >> 7, c = tid & 127, hh = c >> 5, d = c & 31, ii = d & 15, pos = 8192 + t;
        const float cs = C.ropeAc[pos * 16 + ii], sn = C.ropeAs[pos * 16 + ii];
        const float q1 = PR(t, C_QA + hh * 32 + ii), q2 = PR(t, C_QA + hh * 32 + 16 + ii), k1 = PR(t, C_KA + hh * 32 + ii), k2 = PR(t, C_KA + hh * 32 + 16 + ii);
        qa[tid] = d < 16 ? q1 * cs - q2 * sn : q2 * cs + q1 * sn;
        ka[tid] = (d < 16 ? k1 * cs - k2 * sn : k2 * cs + k1 * sn) * 0.17677669529663687f; }
    for (int i = tid; i < 1024; i += NTHREADS) { const int t = i >> 8, c = i & 255;
        qd[i] = silu_(PR(t, C_QD + c)); const float lb = C.lbt[l * 256 + c]; fd[i] = lb + (1.f - lb) * sigmoid_(PR(t, C_FD + c));
        const int g = c >> 6, wn = 2 << g; float s = 0.f;
        for (int j = 0; j < wn; ++j) { const int ee = 15 + t - j; s += ee >= 15 ? PR(ee - 15, C_UC + c) : P.state_pool[(((size_t)l * 128 + sb) * 15 + ee) * 256 + c]; }
        pl[i] = s / (float)wn - PR(t, C_UC + c); }
    { float pv[8];
#pragma unroll
      for (int it = 0; it < 8; ++it) { const int i = tid + it * NTHREADS, r = i >> 8, c = i & 255;
          pv[it] = (i < 15 * 256) ? (r < 11 ? P.state_pool[(((size_t)l * 128 + sb) * 15 + r + 4) * 256 + c] : PR(r - 11, C_UC + c)) : 0.f; }
#pragma unroll
      for (int it = 0; it < 8; ++it) { const int i = tid + it * NTHREADS, r = i >> 8, c = i & 255;
          if (i < 15 * 256) P.out[O_POOLS + (((size_t)l * 128 + sb) * 15 + r) * 256 + c] = pv[it]; } }
    const int pc = tid & 255, tp = tid >> 8, pg = pc >> 6;
    const float* wp = P.w_pool + ((size_t)l * 4 + pg) * 4096 + (pc & 63);
    __syncthreads();
    {
        float* S1 = P.out + O_HGRNS + (((size_t)l * 128 + sb) * 4 + h) * 4096 + (half * 32) * 64 + e;
        const float v0 = PR(0, C_ID + h * 64 + e), v1 = PR(1, C_ID + h * 64 + e), v2 = PR(2, C_ID + h * 64 + e), v3 = PR(3, C_ID + h * 64 + e);
        float o0 = 0.f, o1 = 0.f, o2 = 0.f, o3 = 0.f;
#pragma unroll
        for (int i = 0; i < 32; ++i) { float s = sd[i]; const int c = h * 64 + half * 32 + i;
            float f = fd[c]; s = f * s + (1.f - f) * v0; o0 += qd[c] * s; f = fd[256 + c]; s = f * s + (1.f - f) * v1; o1 += qd[256 + c] * s;
            f = fd[512 + c]; s = f * s + (1.f - f) * v2; o2 += qd[512 + c] * s; f = fd[768 + c]; s = f * s + (1.f - f) * v3; o3 += qd[768 + c] * s; S1[i * 64] = s; __builtin_amdgcn_sched_barrier(0); }
        float* pp = part + (w * 2 + 1) * 256 + e; pp[0] = o0; pp[64] = o1; pp[128] = o2; pp[192] = o3;
    }
    {
        const float gam = 1.f - exp2f(-5.f - (float)h);
        float* S1 = P.out + O_RETS + (((size_t)l * 128 + sb) * 4 + h) * 2048 + (half * 16) * 64 + e;
        const float v0 = PR(0, C_VA + h * 64 + e), v1 = PR(1, C_VA + h * 64 + e), v2 = PR(2, C_VA + h * 64 + e), v3 = PR(3, C_VA + h * 64 + e);
        float o0 = 0.f, o1 = 0.f, o2 = 0.f, o3 = 0.f;
#pragma unroll
        for (int i = 0; i < 16; ++i) { float s = sa[i]; const int c = h * 32 + half * 16 + i;
            s = gam * s + ka[c] * v0; o0 += qa[c] * s; s = gam * s + ka[128 + c] * v1; o1 += qa[128 + c] * s;
            s = gam * s + ka[256 + c] * v2; o2 += qa[256 + c] * s; s = gam * s + ka[384 + c] * v3; o3 += qa[384 + c] * s; S1[i * 64] = s; __builtin_amdgcn_sched_barrier(0); }
        float* pp = part + (w * 2) * 256 + e; pp[0] = o0; pp[64] = o1; pp[128] = o2; pp[192] = o3;
    }
    { float a0 = 0.f, a1 = 0.f;
      for (int c0 = 0; c0 < 64; c0 += 16) { float wv[16];
#pragma unroll
          for (int i = 0; i < 16; ++i) wv[i] = wp[(c0 + i) * 64];
#pragma unroll
          for (int i = 0; i < 16; ++i) { a0 += pl[(2 * tp) * 256 + pg * 64 + c0 + i] * wv[i]; a1 += pl[(2 * tp + 1) * 256 + pg * 64 + c0 + i] * wv[i]; } }
      const float sc = P.pool_scale[l * 256 + pc];
      C.y[(R0 + 2 * tp) * WMIX + Y_C + pc] = f2bf(a0 * sc * silu_(PR(2 * tp, C_ZC + pc)));
      C.y[(R0 + 2 * tp + 1) * WMIX + Y_C + pc] = f2bf(a1 * sc * silu_(PR(2 * tp + 1, C_ZC + pc))); }
    __syncthreads();
    { const bool isd = w >= 4; const int hh = w & 3, c = hh * 64 + e;
      const float* p0 = part + ((2 * hh) * 2 + (isd ? 1 : 0)) * 256 + e; const float* p1 = p0 + 512;
      const float gs = isd ? P.g_hgrn[l * 256 + c] : 1.f; const int zc = isd ? C_ZD : C_ZA, yc = isd ? Y_D : Y_A;
#pragma unroll
      for (int t = 0; t < 4; ++t) { const float o = p0[t * 64] + p1[t * 64];
          const float r = rsqrtf(wave_sum(o * o) * (1.f / 64.f) + EPS);
          C.y[(R0 + t) * WMIX + yc + c] = f2bf(o * r * gs * silu_(PR(t, zc + c))); } }
    __syncthreads();
}
#undef PR

__device__ __forceinline__ void sample_branch_tile(Ctx& C, int l, int tile) {
    const int lane = C.lane, w = C.w, fr = lane & 15, fq = lane >> 4;
    const int r0 = M_P + (tile >> 4) * 32 + (w >> 2) * 16, c0 = (tile & 15) * 64 + (w & 3) * 16;
    const bf16_t* A = C.y + (size_t)(r0 + fr) * WMIX + fq * 8;
    const bf16_t* B = C.wb + (size_t)l * DM * WMIX + (size_t)(c0 + fr) * WMIX + fq * 8;
    f32x4 acc = {0.f, 0.f, 0.f, 0.f};
    float gv[4][4];
#pragma unroll
    for (int br = 0; br < 4; ++br)
#pragma unroll
        for (int j = 0; j < 4; ++j) gv[br][j] = bf2f(C.gates[(size_t)(r0 + fq * 4 + j) * NGATE + br * 1024 + c0 + fr]);
#pragma unroll
    for (int br = 0; br < 4; ++br) {
        const int k0 = br == 0 ? 0 : (br == 1 ? 256 : (br == 2 ? 768 : 1024)), k1 = br == 0 ? 256 : (br == 1 ? 768 : (br == 2 ? 1024 : 1280));
#pragma unroll 8
        for (int k = k0; k < k1; k += 32) acc = mfma16(*(const bf16x8*)(A + k), *(const bf16x8*)(B + k), acc);
#pragma unroll
        for (int j = 0; j < 4; ++j) { float sc = gv[br][j]; if (br < 3) sc *= __builtin_amdgcn_rcpf(gv[br + 1][j]); acc[j] *= sc; }
    }
#pragma unroll
    for (int j = 0; j < 4; ++j) C.mb[(size_t)(r0 + fq * 4 + j) * DM + c0 + fr] = f2bf(acc[j]);
}
__device__ __forceinline__ void sample_out_tile(Ctx& C, int l, int tile) {
    const int lane = C.lane, w = C.w, fr = lane & 15, fq = lane >> 4;
    const int r0 = M_P + (tile >> 4) * 32 + (w >> 2) * 16, c0 = (tile & 15) * 64 + (w & 3) * 16;
    const bf16_t* A = C.mb + (size_t)(r0 + fr) * DM + fq * 8;
    const bf16_t* B = C.wout + (size_t)l * DM * DM + (size_t)(c0 + fr) * DM + fq * 8;
    f32x4 acc = {0.f, 0.f, 0.f, 0.f};
#pragma unroll 8
    for (int k = 0; k < DM; k += 32) acc = mfma16(*(const bf16x8*)(A + k), *(const bf16x8*)(B + k), acc);
#pragma unroll
    for (int j = 0; j < 4; ++j) ((bf16_t*)C.of)[(size_t)(r0 + fq * 4 + j) * DM + c0 + fr] = f2bf(acc[j]);
}

__device__ __forceinline__ void phase_scan(const Params& P, Ctx& C, int l) {
    for (int g = C.bx * NTHREADS + C.tid; g < 49152; g += C.G * NTHREADS) {
        const bool isA = g < 16384;
        const int gg = isA ? g : g - 16384;
        const int b = isA ? (gg >> 13) : (gg >> 14), r = isA ? (gg & 8191) : (gg & 16383), h = isA ? (r >> 11) : (r >> 12), de = isA ? (r & 2047) : (r & 4095);
        float* base = isA ? C.kva + ((size_t)(b * 128) * 4 + h) * 2048 + de : C.kvd + ((size_t)(b * 128) * 4 + h) * 4096 + de;
        const size_t stride = isA ? 8192 : 16384;
        const float* dp = C.decd + (size_t)(b * 128) * 256 + h * 64 + (de >> 6);
        const float decA = __expf(64.f * log1pf(-exp2f(-5.f - (float)h)));
        const float* lp = base; float* sp = base; const float* dlp = dp;
        float S = 0.f, va[16], da[16];
#pragma unroll
        for (int i = 0; i < 16; ++i) { va[i] = *lp; lp += stride; da[i] = isA ? decA : *dlp; dlp += 256; }
        for (int blk = 0; blk < 8; ++blk) {
            float vb[16], db[16];
            if (blk < 7) {
#pragma unroll
                for (int i = 0; i < 16; ++i) { vb[i] = *lp; lp += stride; db[i] = isA ? decA : *dlp; dlp += 256; } }
#pragma unroll
            for (int i = 0; i < 16; ++i) { *sp = S; sp += stride; S = da[i] * S + va[i]; }
#pragma unroll
            for (int i = 0; i < 16; ++i) { va[i] = vb[i]; da[i] = db[i]; }
        }
        float* fin = isA ? P.out + O_RETP + (((size_t)l * 2 + b) * 4 + h) * 2048 + de : P.out + O_HGRNP + (((size_t)l * 2 + b) * 4 + h) * 4096 + de;
        *fin = S;
    }
}

__device__ __forceinline__ void phase_finalize(const Params& P, Ctx& C, int l) {
    const int lane = C.lane; const int stride = C.G * 8;
    for (int row0 = C.bx * 8 + C.w; row0 < M_TOT; row0 += 2 * stride) {
        const int row1 = row0 + stride; const bool has1 = row1 < M_TOT; const int r1 = has1 ? row1 : row0;
        const uint2* oA = (const uint2*)((const bf16_t*)C.of + (size_t)row0 * DM); float4* xA = (float4*)(P.out + (size_t)row0 * DM);
        const uint2* oB = (const uint2*)((const bf16_t*)C.of + (size_t)r1 * DM); float4* xB = (float4*)(P.out + (size_t)r1 * DM);
        float4 o0[4], x0[4], o1[4], x1[4]; float ss0 = 0.f, ss1 = 0.f;
#pragma unroll
        for (int i = 0; i < 4; ++i) { const uint2 pa = oA[lane + 64 * i], pb = oB[lane + 64 * i]; x0[i] = xA[lane + 64 * i]; x1[i] = xB[lane + 64 * i];
            o0[i] = make_float4(lo16(pa.x), hi16(pa.x), lo16(pa.y), hi16(pa.y)); o1[i] = make_float4(lo16(pb.x), hi16(pb.x), lo16(pb.y), hi16(pb.y)); }
#pragma unroll
        for (int i = 0; i < 4; ++i) { ss0 += o0[i].x * o0[i].x + o0[i].y * o0[i].y + o0[i].z * o0[i].z + o0[i].w * o0[i].w; ss1 += o1[i].x * o1[i].x + o1[i].y * o1[i].y + o1[i].z * o1[i].z + o1[i].w * o1[i].w; }
        ss0 = wave_sum(ss0); ss1 = wave_sum(ss1);
        const float ra = rsqrtf(ss0 * (1.f / DM) + EPS), rb = rsqrtf(ss1 * (1.f / DM) + EPS);
        float s0 = 0.f, s1 = 0.f;
#pragma unroll
        for (int i = 0; i < 4; ++i) { const float4 g = ((const float4*)(P.g_post + l * DM))[lane + 64 * i];
            x0[i].x += o0[i].x * ra * g.x; x0[i].y += o0[i].y * ra * g.y; x0[i].z += o0[i].z * ra * g.z; x0[i].w += o0[i].w * ra * g.w;
            x1[i].x += o1[i].x * rb * g.x; x1[i].y += o1[i].y * rb * g.y; x1[i].z += o1[i].z * rb * g.z; x1[i].w += o1[i].w * rb * g.w;
            xA[lane + 64 * i] = x0[i]; if (has1) xB[lane + 64 * i] = x1[i];
            s0 += x0[i].x * x0[i].x + x0[i].y * x0[i].y + x0[i].z * x0[i].z + x0[i].w * x0[i].w; s1 += x1[i].x * x1[i].x + x1[i].y * x1[i].y + x1[i].z * x1[i].z + x1[i].w * x1[i].w; }
        if (l < 3) { s0 = wave_sum(s0); s1 = wave_sum(s1); const float qa = rsqrtf(s0 * (1.f / DM) + EPS), qb = rsqrtf(s1 * (1.f / DM) + EPS);
#pragma unroll
            for (int i = 0; i < 4; ++i) { const float4 g = ((const float4*)(P.g_pre + (l + 1) * DM))[lane + 64 * i];
                uint2 ov; ov.x = pk2(x0[i].x * qa * g.x, x0[i].y * qa * g.y); ov.y = pk2(x0[i].z * qa * g.z, x0[i].w * qa * g.w);
                ((uint2*)(C.h + (size_t)row0 * DM))[lane + 64 * i] = ov;
                if (has1) { uint2 ow; ow.x = pk2(x1[i].x * qb * g.x, x1[i].y * qb * g.y); ow.y = pk2(x1[i].z * qb * g.z, x1[i].w * qb * g.w);
                    ((uint2*)(C.h + (size_t)row1 * DM))[lane + 64 * i] = ow; } } }
    }
}

#ifndef PH_MASK
#define PH_MASK 2047
#endif
__global__ void __launch_bounds__(NTHREADS, 2) fwd_kernel(Params P) {
    extern __shared__ __attribute__((aligned(16))) unsigned char lds[];
    LAS unsigned char* ldsl = (LAS unsigned char*)lds;
    volatile LAS unsigned* bst = (volatile LAS unsigned*)(ldsl + LDS_BYTES - 16);
    if (threadIdx.x == 0) { bst[0] = 0u; bst[1] = 0u; if (P.coop) (void)xb_add((unsigned*)P.ws + XB_XCNT(xb_xcc_id()), 1u); }
    __syncthreads();

    for (int ph = P.ph_lo; ph < P.ph_hi; ++ph) {
        int nrep = 1;
#ifdef DUP_SP
        if (ph > 0 && ((ph - 1) % 7) == DUP_SP) nrep = 2;
        if (ph == 0 && DUP_SP == 7) nrep = 5;
#endif
        for (int rep = 0; rep < nrep; ++rep) {
        if (rep) xcd_barrier((unsigned*)P.ws, bst);
        int tid_ = threadIdx.x, bx = blockIdx.x, G_ = gridDim.x; __attribute__((address_space(1))) unsigned char* wsg = (__attribute__((address_space(1))) unsigned char*)P.ws;
        asm volatile("" : "+v"(tid_)); asm volatile("" : "+s"(bx)); asm volatile("" : "+s"(G_)); asm volatile("" : "+s"(wsg));
        unsigned char* ws = (unsigned char*)wsg;
        Ctx C;
        C.win = (bf16_t*)(ws + WS_WIN); C.wb = (bf16_t*)(ws + WS_WB); C.wout = (bf16_t*)(ws + WS_WOUT); C.h = (bf16_t*)(ws + WS_H); C.mb = (bf16_t*)(ws + WS_H);
        C.proj = (bf16_t*)(ws + WS_PROJ); C.mf = (float*)(ws + WS_PROJ); C.gates = (bf16_t*)(ws + WS_GATES); C.of = (float*)(ws + WS_GATES); C.y = (bf16_t*)(ws + WS_Y);
        C.kva = (float*)(ws + WS_KVA); C.kvd = (float*)(ws + WS_KVD); C.decd = (float*)(ws + WS_DECD);
        C.ropeAc = (float*)(ws + WS_ROPEA); C.ropeAs = C.ropeAc + NPOS * 16; C.ropeBc = (float*)(ws + WS_ROPEB); C.ropeBs = C.ropeBc + NPOS * 8; C.lbt = (float*)(ws + WS_LB);
        C.bx = bx; C.tid = tid_; C.lane = tid_ & 63; C.w = __builtin_amdgcn_readfirstlane(tid_ >> 6); C.G = G_;
        const int vcu = (C.G % 8 == 0) ? (bx % 8) * (C.G / 8) + bx / 8 : bx;
        if (ph == 0) { if (PH_MASK & 1) phase_prologue(P, C, lds); }
        else {
            const int l = (ph - 1) / 7, sp = (ph - 1) % 7;
            if (sp == 0) {
              if (PH_MASK & 2) {
                pg8::Gemm g{C.h, C.win + (size_t)l * DIN * DM, DM, DM}; pg8::StaticOrder S; S.init(M_TOT, DIN, DM, C.G, bx);
                pg8::EpiProj E{C.proj, C.gates};
                pg8::gemm_phase<pg8::EpiProj, pg8::StaticOrder>(ldsl, g, S, E, C.tid); }
            } else if (sp == 1) {
                for (int u = bx; u < 1280; u += C.G) {
                    asm volatile("" : "+v"(C.tid)); C.lane = C.tid & 63; C.w = __builtin_amdgcn_readfirstlane(C.tid >> 6);
                    if (u < 256) { if (PH_MASK & 4) attn_prompt_unit(P, C, l, u >> 7, (u & 127) >> 1, u & 1, lds); }
                    else if (u < 512) { if (PH_MASK & 32) lin_chunk<false, true>(P, C, l, (u - 256) >> 7, (u - 256) & 127, lds); }
                    else if (u < 768) { if (PH_MASK & 32) lin_chunk<true, true>(P, C, l, (u - 512) >> 7, (u - 512) & 127, lds); }
                    else if (u < 1024) { const int v = u - 768; if (PH_MASK & 8) { if (v < 128) { if (!(PH_MASK & 4096)) sample_b_unit(P, C, l, v, lds); } else { if (!(PH_MASK & 8192)) sample_adc_unit(P, C, l, v - 128, lds); } } }
                    else { if (PH_MASK & 16) pool_prompt_unit(P, C, l, u - 1024, lds); }
                }
            } else if (sp == 2) { if (PH_MASK & 64) phase_scan(P, C, l); }
            else if (sp == 3) {
                for (int u = bx; u < 512; u += C.G) {
                    asm volatile("" : "+v"(C.tid)); C.lane = C.tid & 63; C.w = __builtin_amdgcn_readfirstlane(C.tid >> 6);
                    if (u < 256) { if (PH_MASK & 128) lin_chunk<false, false>(P, C, l, u >> 7, u & 127, lds); }
                    else { if (PH_MASK & 128) lin_chunk<true, false>(P, C, l, (u - 256) >> 7, (u - 256) & 127, lds); }
                }
            } else if (sp == 4) {
              if (PH_MASK & 256) {
                for (int t = bx; t < 256; t += C.G) sample_branch_tile(C, l, t);
                pg8::Gemm g{C.y, C.wb + (size_t)l * DM * WMIX, WMIX, WMIX}; pg8::BranchOrder S{256, C.G, vcu};
                pg8::EpiBranch E{C.gates, C.mb};
                pg8::gemm_phase<pg8::EpiBranch, pg8::BranchOrder>(ldsl, g, S, E, C.tid); }
            } else if (sp == 5) {
              if (PH_MASK & 512) {
                for (int t = bx; t < 256; t += C.G) sample_out_tile(C, l, t);
                pg8::Gemm g{C.mb, C.wout + (size_t)l * DM * DM, DM, DM}; pg8::TileOrder S{256, C.G, vcu, DM / 64};
                pg8::EpiF32 E{(bf16_t*)C.of};
                pg8::gemm_phase<pg8::EpiF32, pg8::TileOrder>(ldsl, g, S, E, C.tid); }
            } else { if (PH_MASK & 1024) phase_finalize(P, C, l); }
        }
        }
        if (ph + 1 < P.ph_hi && P.coop) { if (ph == 0) cg::this_grid().sync(); else xcd_barrier((unsigned*)P.ws, bst); }
    }
}

#ifndef N_LAUNCH_MODE
#define N_LAUNCH_MODE 1
#endif
extern "C" void kernel_launch(void* const* d_in, const int* in_sizes, int n_in, void* d_out, int out_size, void* d_ws, size_t ws_size, hipStream_t stream) {
    static int grid = 0;
    if (grid == 0) {
        if (n_in != 17 || (size_t)out_size != O_END || ws_size < WS_END) { fprintf(stderr, "kernel_launch: unexpected sizes n_in %d out %d ws %zu\n", n_in, out_size, ws_size); grid = -1; return; }
        int dev = 0, cus = 0, per_cu = 0;
        hipGetDevice(&dev); hipDeviceGetAttribute(&cus, hipDeviceAttributeMultiprocessorCount, dev);
        if (hipFuncSetAttribute((const void*)fwd_kernel, hipFuncAttributeMaxDynamicSharedMemorySize, LDS_BYTES) != hipSuccess) { fprintf(stderr, "hipFuncSetAttribute failed\n"); grid = -1; return; }
        if (hipOccupancyMaxActiveBlocksPerMultiprocessor(&per_cu, (const void*)fwd_kernel, NTHREADS, LDS_BYTES) != hipSuccess || per_cu < 1) { fprintf(stderr, "occupancy query: %d\n", per_cu); per_cu = 1; }
        (void)hipGetLastError();
        grid = cus * 1;
        if (per_cu < 1) grid = -1;
    }
    if (grid < 0) return;
    Params p{};
    const float* const* in = (const float* const*)d_in;
    p.x_prompt = in[0]; p.x_sample = in[1]; p.state_ret = in[2]; p.cache_k = in[3]; p.cache_v = in[4]; p.state_pool = in[5]; p.state_hgrn = in[6];
    p.w_in = in[7]; p.w_branch = in[8]; p.w_out = in[9]; p.g_pre = in[10]; p.g_post = in[11]; p.attn_sink = in[12]; p.w_pool = in[13];
    p.pool_scale = in[14]; p.g_hgrn = in[15]; p.lower_bounds = in[16];
    p.out = (float*)d_out; p.ws = (unsigned char*)d_ws;
    for (int i = 0; i < 16; ++i) p.invA[i] = pow(10000.0, -(double)i / 16.0);
    for (int i = 0; i < 8; ++i) p.invB[i] = pow(500000.0, -(double)i / 8.0);
    const int NPH = 29;
#if N_LAUNCH_MODE == 1
    (void)hipMemsetAsync(d_ws, 0, 16384, stream);
    p.ph_lo = 0; p.ph_hi = NPH; p.coop = 1; p.pad = 0;
    void* args[] = {&p};
    hipError_t e = hipLaunchCooperativeKernel((const void*)fwd_kernel, dim3(grid), dim3(NTHREADS), args, LDS_BYTES, stream);
    if (e != hipSuccess) fprintf(stderr, "cooperative launch failed: %s (grid %d)\n", hipGetErrorString(e), grid);
#else
    for (int ph = 0; ph < NPH; ++ph) {
        p.ph_lo = ph; p.ph_hi = ph + 1; p.coop = 0; p.pad = 0;
        hipLaunchKernelGGL(fwd_kernel, dim3(grid), dim3(NTHREADS), LDS_BYTES, stream, p);
    }
#endif
}
```

```cpp
#include <hip/hip_runtime.h>
#include <hip/hip_cooperative_groups.h>
#include <cstdio>
#include <cstdint>
#include <cmath>
namespace cg = cooperative_groups;

#define LAS __attribute__((address_space(3)))
typedef unsigned short bf16_t;
typedef short bf16x8 __attribute__((ext_vector_type(8)));
typedef float f32x4 __attribute__((ext_vector_type(4)));
typedef unsigned u32x4 __attribute__((ext_vector_type(4)));

constexpr int M_TOT = 16896, M_P = 16384, DM = 1024, DIN = 7680, NPROJ = 3584, NGATE = 4096, WMIX = 1280;
constexpr int C_QA = 0, C_KA = 128, C_VA = 256, C_ZA = 512, C_QB = 768, C_KB = 1280, C_VB = 1408, C_ZB = 1536, C_UC = 2048, C_ZC = 2304,
              C_QD = 2560, C_FD = 2816, C_ID = 3072, C_ZD = 3328;
constexpr int Y_A = 0, Y_B = 256, Y_C = 768, Y_D = 1024;
constexpr size_t O_YP = 0, O_YS = 16777216, O_RETP = 17301504, O_KP = 17367040, O_VP = 17498112, O_POOLP = 17629184, O_HGRNP = 17659904,
                 O_RETS = 17790976, O_KS = 21985280, O_VS = 30373888, O_POOLS = 38762496, O_HGRNS = 40728576, O_END = 49117184;
constexpr float EPS = 1e-6f;
constexpr int NPOS = 8196;

constexpr size_t MiB = 1u << 20;
constexpr size_t WS_ROPEA = 1 * MiB;
constexpr size_t WS_ROPEB = 3 * MiB;
constexpr size_t WS_LB = 3 * MiB + 768 * 1024;
constexpr size_t WS_WIN = 4 * MiB;
constexpr size_t WS_WB = 64 * MiB;
constexpr size_t WS_WOUT = 74 * MiB;
constexpr size_t WS_H = 82 * MiB;
constexpr size_t WS_PROJ = 115 * MiB;
constexpr size_t WS_GATES = 231 * MiB;
constexpr size_t WS_Y = 363 * MiB;
constexpr size_t WS_KVA = 405 * MiB;
constexpr size_t WS_KVD = 413 * MiB;
constexpr size_t WS_DECD = 429 * MiB;
constexpr size_t WS_END = 430 * MiB;

constexpr int LDS_BYTES = 147456;
constexpr int NTHREADS = 512;

struct Params {
    const float* x_prompt; const float* x_sample; const float* state_ret; const float* cache_k; const float* cache_v; const float* state_pool; const float* state_hgrn;
    const float* w_in; const float* w_branch; const float* w_out; const float* g_pre; const float* g_post; const float* attn_sink; const float* w_pool;
    const float* pool_scale; const float* g_hgrn; const float* lower_bounds;
    float* out; unsigned char* ws;
    double invA[16]; double invB[8];
    int ph_lo, ph_hi, coop, pad;
};

__device__ __forceinline__ float bf2f(bf16_t v) { return __uint_as_float(((unsigned)v) << 16); }
__device__ __forceinline__ bf16_t f2bf(float f) { unsigned r; asm("v_cvt_pk_bf16_f32 %0, %1, %1" : "=v"(r) : "v"(f)); return (bf16_t)(r & 0xffffu); }
__device__ __forceinline__ unsigned pk2(float lo, float hi) { unsigned r; asm("v_cvt_pk_bf16_f32 %0, %1, %2" : "=v"(r) : "v"(lo), "v"(hi)); return r; }
__device__ __forceinline__ float lo16(unsigned u) { return __uint_as_float(u << 16); }
__device__ __forceinline__ float hi16(unsigned u) { return __uint_as_float(u & 0xffff0000u); }
__device__ __forceinline__ float sigmoid_(float x) { return __builtin_amdgcn_rcpf(1.f + __expf(-x)); }
__device__ __forceinline__ float silu_(float x) { return x * __builtin_amdgcn_rcpf(1.f + __expf(-x)); }
__device__ __forceinline__ float wave_sum(float v) {
    v += __shfl_xor(v, 32); v += __shfl_xor(v, 16); v += __shfl_xor(v, 8); v += __shfl_xor(v, 4); v += __shfl_xor(v, 2); v += __shfl_xor(v, 1); return v;
}
__device__ __forceinline__ float quad16_sum(float v) { v += __shfl_xor(v, 8); v += __shfl_xor(v, 4); v += __shfl_xor(v, 2); v += __shfl_xor(v, 1); return v; }
__device__ __forceinline__ float quad16_max(float v) { v = fmaxf(v, __shfl_xor(v, 8)); v = fmaxf(v, __shfl_xor(v, 4)); v = fmaxf(v, __shfl_xor(v, 2)); v = fmaxf(v, __shfl_xor(v, 1)); return v; }
__device__ __forceinline__ f32x4 mfma16(bf16x8 a, bf16x8 b, f32x4 c) { return __builtin_amdgcn_mfma_f32_16x16x32_bf16(a, b, c, 0, 0, 0); }
__device__ __forceinline__ f32x4 mma_tile(const bf16_t* As, int lda, const bf16_t* Bs, int ldb, int K, f32x4 acc, int lane) {
    const bf16_t* ap = As + (lane & 15) * lda + (lane >> 4) * 8;
    const bf16_t* bp = Bs + (lane & 15) * ldb + (lane >> 4) * 8;
    for (int k = 0; k < K; k += 32) acc = mfma16(*(const bf16x8*)(ap + k), *(const bf16x8*)(bp + k), acc);
    return acc;
}

__device__ __forceinline__ void unpack8(const u32x4 a, float (&x)[8]) { x[0] = lo16(a.x); x[1] = hi16(a.x); x[2] = lo16(a.y); x[3] = hi16(a.y); x[4] = lo16(a.z); x[5] = hi16(a.z); x[6] = lo16(a.w); x[7] = hi16(a.w); }
__device__ __forceinline__ u32x4 pack8(const float (&x)[8]) { u32x4 w; w.x = pk2(x[0], x[1]); w.y = pk2(x[2], x[3]); w.z = pk2(x[4], x[5]); w.w = pk2(x[6], x[7]); return w; }

namespace pg8 {
constexpr int BM = 256, BK = 64, HALF = 128, HTB = HALF * BK * 2, STAGE_BYTES = 8 * HTB, NXCD = 8, WGM = 8;
__host__ __device__ __forceinline__ int lds_byte(int r, int c) { const int st = (r >> 4) * 2 + (c >> 5), rr = r & 15, cc = c & 31, ob = rr * 64 + cc * 2; return st * 1024 + (ob ^ (((ob >> 9) & 1) << 5)); }
__host__ __device__ __forceinline__ void stage_rc(int b, int& R, int& C) { const int st = b / 1024, sb = b % 1024, swz = sb ^ (((sb >> 9) & 1) << 5); R = (st >> 1) * 16 + swz / 64; C = (st & 1) * 32 + (swz % 64) / 2; }
__host__ __device__ __forceinline__ int perm32(int rho) { const int n = rho >> 4, i = rho & 15; return 8 * (i >> 2) + 4 * n + (i & 3); }

struct Unit { int pm, pn, k0, nt, br; };
struct Gemm { const bf16_t* A; const bf16_t* Bt; int lda, ldb; };

struct StaticOrder {
    int nM, nN, nwg, G, c, nt;
    __device__ void init(int M, int N, int K, int G_, int c_) { nM = M / BM; nN = N / BM; nwg = nM * nN; G = G_; c = c_; nt = K / BK; }
    __device__ bool next(int i, Unit& u) const {
        const long L = (long)i * G + c; if (L >= nwg) return false;
        int wgid = (int)L; { const int q = nwg / NXCD, r = nwg % NXCD, xcd = wgid % NXCD, off = wgid / NXCD; wgid = (xcd < r ? xcd * (q + 1) : r * (q + 1) + (xcd - r) * q) + off; }
        const int nig = WGM * nN, gid = wgid / nig, fm = gid * WGM, gsz = (nM - fm) < WGM ? (nM - fm) : WGM;
        u.pm = fm + ((wgid % nig) % gsz); u.pn = (wgid % nig) / gsz; u.k0 = 0; u.nt = nt; u.br = 0; return true;
    }
};
struct TileOrder {
    int ntiles, G, c, nt;
    __device__ bool next(int i, Unit& u) const { const int t = i * G + c; if (t >= ntiles) return false; u.pm = t >> 2; u.pn = t & 3; u.k0 = 0; u.nt = nt; u.br = 0; return true; }
};
struct BranchOrder {
    int ntiles, G, c;
    __device__ bool next(int i, Unit& u) const {
        const int t = (i >> 2) * G + c; if (t >= ntiles) return false; const int br = i & 3;
        u.pm = t >> 2; u.pn = t & 3; u.br = br; u.k0 = br == 0 ? 0 : (br == 1 ? 256 : (br == 2 ? 768 : 1024)); u.nt = br == 1 ? 8 : 4; return true;
    }
};

struct EpiProj {
    static __device__ __forceinline__ bool reset(const Unit&) { return true; }
    bf16_t* proj; bf16_t* gates;
    template <bool ISG> __device__ __forceinline__ void body(f32x4 (&acc)[2][2][4][2], bf16_t* base, int ld) const {
#pragma unroll
        for (int ai = 0; ai < 2; ++ai)
#pragma unroll
            for (int m = 0; m < 4; ++m) { bf16_t* rowp = base + (size_t)(ai * HALF + m * 16) * ld;
#pragma unroll
                for (int bj = 0; bj < 2; ++bj) { f32x4 v0 = acc[ai][bj][m][0], v1 = acc[ai][bj][m][1];
                    if (ISG) {
#pragma unroll
                        for (int i = 0; i < 4; ++i) { v0[i] = fmaxf(sigmoid_(v0[i]), 1e-6f); v1[i] = fmaxf(sigmoid_(v1[i]), 1e-6f); } }
                    u32x4 w; w.x = pk2(v0[0], v0[1]); w.y = pk2(v0[2], v0[3]); w.z = pk2(v1[0], v1[1]); w.w = pk2(v1[2], v1[3]);
                    *(u32x4*)(rowp + bj * HALF) = w; } }
    }
    __device__ __forceinline__ void operator()(f32x4 (&acc)[2][2][4][2], const Unit& u, int wr, int wc, int fr, int fq) const {
        const int row0 = u.pm * BM + wr * 64 + fr;
        if (u.pn >= 14) body<true>(acc, gates + (size_t)row0 * NGATE + (u.pn - 14) * BM + wc * 32 + 8 * fq, NGATE);
        else body<false>(acc, proj + (size_t)row0 * NPROJ + u.pn * BM + wc * 32 + 8 * fq, NPROJ);
    }
};
struct EpiBranch {
    static __device__ __forceinline__ bool reset(const Unit& u) { return u.br == 3; }
    const bf16_t* gates; bf16_t* mb;
    static __device__ __forceinline__ void scale8(f32x4& v0, f32x4& v1, const u32x4 g) {
        v0[0] *= lo16(g.x); v0[1] *= hi16(g.x); v0[2] *= lo16(g.y); v0[3] *= hi16(g.y); v1[0] *= lo16(g.z); v1[1] *= hi16(g.z); v1[2] *= lo16(g.w); v1[3] *= hi16(g.w); }
    static __device__ __forceinline__ void rscale8(f32x4& v0, f32x4& v1, const u32x4 g) {
        v0[0] *= __builtin_amdgcn_rcpf(lo16(g.x)); v0[1] *= __builtin_amdgcn_rcpf(hi16(g.x)); v0[2] *= __builtin_amdgcn_rcpf(lo16(g.y)); v0[3] *= __builtin_amdgcn_rcpf(hi16(g.y));
        v1[0] *= __builtin_amdgcn_rcpf(lo16(g.z)); v1[1] *= __builtin_amdgcn_rcpf(hi16(g.z)); v1[2] *= __builtin_amdgcn_rcpf(lo16(g.w)); v1[3] *= __builtin_amdgcn_rcpf(hi16(g.w)); }
    __device__ __forceinline__ void operator()(f32x4 (&acc)[2][2][4][2], const Unit& u, int wr, int wc, int fr, int fq) const {
        const int row0 = u.pm * BM + wr * 64 + fr, col0 = u.pn * BM + wc * 32 + 8 * fq;
        const bf16_t* gbase = gates + (size_t)row0 * NGATE + u.br * 1024 + col0;
        if (u.br < 3) {
#pragma unroll
            for (int ai = 0; ai < 2; ++ai)
#pragma unroll
                for (int mp = 0; mp < 2; ++mp) {
                    u32x4 g[2][2], gn[2][2];
#pragma unroll
                    for (int mm = 0; mm < 2; ++mm)
#pragma unroll
                        for (int bj = 0; bj < 2; ++bj) { const bf16_t* p = gbase + (size_t)(ai * HALF + (mp * 2 + mm) * 16) * NGATE + bj * HALF;
                            g[mm][bj] = *(const u32x4*)p; gn[mm][bj] = *(const u32x4*)(p + 1024); }
#pragma unroll
                    for (int mm = 0; mm < 2; ++mm)
#pragma unroll
                        for (int bj = 0; bj < 2; ++bj) { const int m = mp * 2 + mm;
                            scale8(acc[ai][bj][m][0], acc[ai][bj][m][1], g[mm][bj]); rscale8(acc[ai][bj][m][0], acc[ai][bj][m][1], gn[mm][bj]); }
                }
        } else {
#pragma unroll
            for (int ai = 0; ai < 2; ++ai)
#pragma unroll
                for (int mp = 0; mp < 2; ++mp) {
                    u32x4 g[2][2];
#pragma unroll
                    for (int mm = 0; mm < 2; ++mm)
#pragma unroll
                        for (int bj = 0; bj < 2; ++bj) g[mm][bj] = *(const u32x4*)(gbase + (size_t)(ai * HALF + (mp * 2 + mm) * 16) * NGATE + bj * HALF);
#pragma unroll
                    for (int mm = 0; mm < 2; ++mm)
#pragma unroll
                        for (int bj = 0; bj < 2; ++bj) { const int m = mp * 2 + mm;
                            f32x4 v0 = acc[ai][bj][m][0], v1 = acc[ai][bj][m][1]; scale8(v0, v1, g[mm][bj]);
                            u32x4 w; w.x = pk2(v0[0], v0[1]); w.y = pk2(v0[2], v0[3]); w.z = pk2(v1[0], v1[1]); w.w = pk2(v1[2], v1[3]);
                            *(u32x4*)(mb + (size_t)(row0 + ai * HALF + m * 16) * DM + col0 + bj * HALF) = w; }
                }
        }
    }
};
struct EpiF32 {
    static __device__ __forceinline__ bool reset(const Unit&) { return true; }
    bf16_t* o;
    __device__ __forceinline__ void operator()(f32x4 (&acc)[2][2][4][2], const Unit& u, int wr, int wc, int fr, int fq) const {
        const int row0 = u.pm * BM + wr * 64 + fr, col0 = u.pn * BM + wc * 32 + 8 * fq;
#pragma unroll
        for (int ai = 0; ai < 2; ++ai)
#pragma unroll
            for (int m = 0; m < 4; ++m) { bf16_t* rowp = o + (size_t)(row0 + ai * HALF + m * 16) * DM + col0;
#pragma unroll
                for (int bj = 0; bj < 2; ++bj) { const f32x4 v0 = acc[ai][bj][m][0], v1 = acc[ai][bj][m][1];
                    u32x4 w; w.x = pk2(v0[0], v0[1]); w.y = pk2(v0[2], v0[3]); w.z = pk2(v1[0], v1[1]); w.w = pk2(v1[2], v1[3]);
                    *(u32x4*)(rowp + bj * HALF) = w; } }
    }
};

template <class Epi, class Sched>
__device__ __forceinline__ void gemm_phase(LAS unsigned char* lds, const Gemm g, const Sched& S, const Epi& E, const int tid) {
    const int wid = __builtin_amdgcn_readfirstlane(tid >> 6), lane = tid & 63, wr = wid >> 2, wc = wid & 3, fr = lane & 15, fq = lane >> 4;
    unsigned voffA[2], voffB[2];
#pragma unroll
    for (int i = 0; i < 2; ++i) { int R, C; stage_rc(tid * 16 + i * 8192, R, C); const int Rb = (R & ~31) + perm32(R & 31);
        voffA[i] = (unsigned)(R * g.lda + C) * 2u; voffB[i] = (unsigned)(Rb * g.ldb + C) * 2u; }
    const size_t kstep = (size_t)(BK * 2);
    const size_t hstepA = (size_t)HALF * g.lda * 2, hstepB = (size_t)HALF * g.ldb * 2;
    const size_t tstepA = 2 * hstepA, tstepB = 2 * hstepB;
    const unsigned ldsw = (unsigned)wid * 1024u;
    const int aoff = lds_byte(wr * 64 + fr, fq * 8), boff = lds_byte(wc * 32 + fr, fq * 8);
#define PG8_SA(b, h) (((b) * 2 + (h)) * HTB)
#define PG8_SB(b, h) ((4 + (b) * 2 + (h)) * HTB)
#define PG8_STAGE(bufoff, gbase, voff) do { _Pragma("unroll") for (int _i = 0; _i < 2; ++_i) \
        __builtin_amdgcn_global_load_lds((const unsigned*)((const char*)(gbase) + (voff)[_i]), (LAS unsigned*)(lds + (bufoff) + ldsw + _i * 8192), 16, 0, 0); } while (0)
#define PG8_LDA(dst, b, h) do { _Pragma("unroll") for (int m = 0; m < 4; ++m) _Pragma("unroll") for (int k = 0; k < 2; ++k) dst[m][k] = *(const LAS bf16x8*)(lds + PG8_SA(b, h) + aoff + m * 2048 + k * 1024); } while (0)
#define PG8_LDB(dst, b, h) do { _Pragma("unroll") for (int n = 0; n < 2; ++n) _Pragma("unroll") for (int k = 0; k < 2; ++k) dst[n][k] = *(const LAS bf16x8*)(lds + PG8_SB(b, h) + boff + n * 2048 + k * 1024); } while (0)
#define PG8_MMA(ai, bj, At, Bt) do { __builtin_amdgcn_s_setprio(1); _Pragma("unroll") for (int m = 0; m < 4; ++m) _Pragma("unroll") for (int n = 0; n < 2; ++n) _Pragma("unroll") for (int k = 0; k < 2; ++k) \
        acc[ai][bj][m][n] = __builtin_amdgcn_mfma_f32_16x16x32_bf16(Bt[n][k], At[m][k], acc[ai][bj][m][n], 0, 0, 0); __builtin_amdgcn_s_setprio(0); } while (0)
#define PG8_WAIT_V(n) asm volatile("s_waitcnt vmcnt(" #n ")" ::: "memory")
#define PG8_WAIT_L(n) asm volatile("s_waitcnt lgkmcnt(" #n ")" ::: "memory")
#define PG8_BAR __builtin_amdgcn_s_barrier()
#define PG8_SCHED __builtin_amdgcn_sched_barrier(0)
    Unit cur, nxt; int ui = 0;
    if (!S.next(0, cur)) return;
    f32x4 acc[2][2][4][2];
#pragma unroll
    for (int a = 0; a < 2; ++a)
#pragma unroll
        for (int b = 0; b < 2; ++b)
#pragma unroll
            for (int m = 0; m < 4; ++m)
#pragma unroll
                for (int n = 0; n < 2; ++n) acc[a][b][m][n] = (f32x4){0.f, 0.f, 0.f, 0.f};
    bf16x8 At[4][2], B0[2][2], B1[2][2];
    const char* cA = (const char*)g.A + (size_t)cur.pm * tstepA + (size_t)cur.k0 * 2; const char* cB = (const char*)g.Bt + (size_t)cur.pn * tstepB + (size_t)cur.k0 * 2;
    PG8_STAGE(PG8_SB(0, 0), cB, voffB); PG8_STAGE(PG8_SB(0, 1), cB + hstepB, voffB); PG8_STAGE(PG8_SA(0, 0), cA, voffA); PG8_STAGE(PG8_SA(0, 1), cA + hstepA, voffA);
    if (wr == 1) PG8_BAR;
    PG8_WAIT_V(2); PG8_BAR;
    PG8_STAGE(PG8_SB(1, 0), cB + kstep, voffB); PG8_STAGE(PG8_SA(1, 0), cA + kstep, voffA); PG8_STAGE(PG8_SB(1, 1), cB + hstepB + kstep, voffB);
    PG8_WAIT_V(6); PG8_BAR;
    for (;;) {
        const bool has_next = S.next(ui + 1, nxt);
        const char* nA = has_next ? (const char*)g.A + (size_t)nxt.pm * tstepA + (size_t)nxt.k0 * 2 : cA;
        const char* nB = has_next ? (const char*)g.Bt + (size_t)nxt.pn * tstepB + (size_t)nxt.k0 * 2 : cB;
        const int nt = cur.nt;
        for (int t = 0; t < nt; t += 2) {
            const bool last = (t == nt - 2);
            const char* a1 = cA + (size_t)(t + 1) * kstep;
            const char* a2 = last ? nA : cA + (size_t)(t + 2) * kstep; const char* b2 = last ? nB : cB + (size_t)(t + 2) * kstep;
            const char* a3 = a2 + kstep; const char* b3 = b2 + kstep;
            PG8_LDB(B0, 0, 0); PG8_LDB(B1, 0, 1); PG8_SCHED; PG8_LDA(At, 0, 0); PG8_STAGE(PG8_SA(1, 1), a1 + hstepA, voffA);
            PG8_WAIT_V(8); PG8_WAIT_L(0); PG8_BAR; PG8_MMA(0, 0, At, B0); PG8_MMA(0, 1, At, B1); PG8_BAR; PG8_SCHED;
            PG8_LDA(At, 0, 1); PG8_STAGE(PG8_SB(0, 0), b2, voffB); PG8_STAGE(PG8_SB(0, 1), b2 + hstepB, voffB); PG8_STAGE(PG8_SA(0, 0), a2, voffA);
            PG8_WAIT_V(8); PG8_WAIT_L(0); PG8_BAR; PG8_MMA(1, 0, At, B0); PG8_MMA(1, 1, At, B1); PG8_BAR; PG8_SCHED;
            PG8_LDB(B0, 1, 0); PG8_LDB(B1, 1, 1); PG8_SCHED; PG8_LDA(At, 1, 0); PG8_STAGE(PG8_SA(0, 1), a2 + hstepA, voffA);
            PG8_WAIT_V(8); PG8_WAIT_L(0); PG8_BAR; PG8_MMA(0, 0, At, B0); PG8_MMA(0, 1, At, B1); PG8_BAR; PG8_SCHED;
            PG8_LDA(At, 1, 1); PG8_STAGE(PG8_SB(1, 0), b3, voffB); PG8_STAGE(PG8_SB(1, 1), b3 + hstepB, voffB); PG8_STAGE(PG8_SA(1, 0), a3, voffA);
            PG8_WAIT_V(8); PG8_WAIT_L(0); PG8_BAR; PG8_MMA(1, 0, At, B0); PG8_MMA(1, 1, At, B1); PG8_BAR; PG8_SCHED;
        }
        if (wr == 0) PG8_BAR;
        E(acc, cur, wr, wc, fr, fq);
        if (!has_next) break;
        if (Epi::reset(cur))
#pragma unroll
        for (int a = 0; a < 2; ++a)
#pragma unroll
            for (int b = 0; b < 2; ++b)
#pragma unroll
                for (int m = 0; m < 4; ++m)
#pragma unroll
                    for (int n = 0; n < 2; ++n) acc[a][b][m][n] = (f32x4){0.f, 0.f, 0.f, 0.f};
        cur = nxt; cA = nA; cB = nB; ++ui;
        if (wr == 1) PG8_BAR;
    }
    PG8_WAIT_V(0);
    PG8_BAR;
#undef PG8_SA
#undef PG8_SB
#undef PG8_STAGE
#undef PG8_LDA
#undef PG8_LDB
#undef PG8_MMA
#undef PG8_WAIT_V
#undef PG8_WAIT_L
#undef PG8_BAR
#undef PG8_SCHED
}
}


#define XB_TMO      128
#define XB_XCNT(j)  (256  + 64 * (j))
#define XB_XSUB(j)  (1280 + 64 * (j))
#define XB_XGEN(j)  (2304 + 64 * (j))
#define XB_TOP      3328
#define XB_TOPGEN   3392
#define XCD_BAR_WORDS 3456
#define XB_SPIN_CAP (1u << 18)
__device__ __forceinline__ unsigned xb_ld(unsigned* p)              { return __hip_atomic_load(p, __ATOMIC_RELAXED, __HIP_MEMORY_SCOPE_AGENT); }
__device__ __forceinline__ unsigned xb_add(unsigned* p, unsigned v) { return __hip_atomic_fetch_add(p, v, __ATOMIC_RELAXED, __HIP_MEMORY_SCOPE_AGENT); }
__device__ __forceinline__ unsigned xb_xcc_id() { return (unsigned)__builtin_amdgcn_s_getreg((3 << 11) | 20) & 0xFu; }
#define XB_SPIN(cond, bar) do { unsigned _sp = 0; while (cond) { __builtin_amdgcn_s_sleep(1); \
    if ((++_sp & 255u) == 0u) { if (xb_ld(&(bar)[XB_TMO])) break; if (_sp > XB_SPIN_CAP) { atomicAdd(&(bar)[XB_TMO], 1u); break; } } } } while (0)
__device__ __forceinline__ void xcd_barrier_complete(unsigned* bar, unsigned x, unsigned& nloc, unsigned& nx) {
    const unsigned G = gridDim.x * gridDim.y * gridDim.z;
    unsigned sum, cnt, mine, sp = 0u;
    for (;;) {
        sum = 0u; cnt = 0u; mine = 0u;
#pragma unroll
        for (unsigned j = 0; j < 16; ++j) { const unsigned c = xb_ld(&bar[XB_XCNT(j)]); sum += c; cnt += (c > 0u) ? 1u : 0u; mine = (j == x) ? c : mine; }
        if (sum == G) break;
        __builtin_amdgcn_s_sleep(1);
        if ((++sp & 255u) == 0u) { if (xb_ld(&bar[XB_TMO])) break; if (sp > XB_SPIN_CAP) { atomicAdd(&bar[XB_TMO], 1u); break; } }
    }
    nloc = mine > 0u ? mine : 1u; nx = cnt > 0u ? cnt : 1u;
}
__device__ __forceinline__ void xcd_barrier(unsigned* bar, volatile LAS unsigned* st) {
    asm volatile("s_waitcnt vmcnt(0)" ::: "memory");
    __syncthreads();
    if (threadIdx.x == 0) {
        const unsigned x = xb_xcc_id();
        __builtin_amdgcn_s_waitcnt(0);
        unsigned nloc = st[0], nx = st[1];
        if (nloc == 0u) { xcd_barrier_complete(bar, x, nloc, nx); st[0] = nloc; st[1] = nx; }
        const unsigned old = xb_add(&bar[XB_XSUB(x)], 1u);
        const unsigned gen = old / nloc;
        if (old + 1u == (gen + 1u) * nloc) {
            __builtin_amdgcn_fence(__ATOMIC_RELEASE, "agent");
            asm volatile("s_waitcnt vmcnt(0)" ::: "memory");
            const unsigned og = xb_add(&bar[XB_TOP], 1u);
            const unsigned tg = og / nx;
            if (og + 1u == (tg + 1u) * nx) xb_add(&bar[XB_TOPGEN], 1u);
            else XB_SPIN(xb_ld(&bar[XB_TOPGEN]) == tg, bar);
            __builtin_amdgcn_fence(__ATOMIC_ACQUIRE, "agent");
            xb_add(&bar[XB_XGEN(x)], 1u);
            asm volatile("s_waitcnt vmcnt(0)" ::: "memory");
        } else {
            XB_SPIN(xb_ld(&bar[XB_XGEN(x)]) == gen, bar);
            __builtin_amdgcn_fence(__ATOMIC_ACQUIRE, "agent");
            asm volatile("s_waitcnt vmcnt(0)" ::: "memory");
        }
    }
    __syncthreads();
}

struct Ctx {
    int bx;
    bf16_t *win, *wb, *wout, *h, *proj, *gates, *y, *mb;
    float *mf, *of, *kva, *kvd, *decd, *ropeAc, *ropeAs, *ropeBc, *ropeBs, *lbt;
    int tid, lane, w, G;
};

struct TJob { const float* src; bf16_t* dst; int N, Kp; };
__device__ __forceinline__ TJob tjob_decode(const Params& P, Ctx& C, int job) {
    const int l = job / 2496, j = job % 2496; TJob t; int kt, nt;
    if (j < 1920) { kt = j / 120; nt = j % 120; t.N = DIN; t.Kp = DM; t.src = P.w_in + (size_t)l * DM * DIN; t.dst = C.win + (size_t)l * DIN * DM; }
    else if (j < 2240) { const int jj = j - 1920; kt = jj / 16; nt = jj % 16; t.N = DM; t.Kp = WMIX; t.src = P.w_branch + (size_t)l * WMIX * DM; t.dst = C.wb + (size_t)l * DM * WMIX; }
    else { const int jj = j - 2240; kt = jj / 16; nt = jj % 16; t.N = DM; t.Kp = DM; t.src = P.w_out + (size_t)l * DM * DM; t.dst = C.wout + (size_t)l * DM * DM; }
    t.src += (size_t)(kt * 64) * t.N + nt * 64; t.dst += (size_t)(nt * 64) * t.Kp + kt * 64; return t;
}

__device__ __forceinline__ void phase_prologue(const Params& P, Ctx& C, unsigned char* lds) {
    const int tid = C.tid;
    float* scr = (float*)lds;
    {
        const int kk = tid >> 3, c8 = (tid & 7) * 8, n = tid >> 3, k8 = (tid & 7) * 8;
        int job = C.bx, par = 0; float4 a, b; TJob cur;
        if (job < 4 * 2496) { cur = tjob_decode(P, C, job); const float4* sp = (const float4*)(cur.src + (size_t)kk * cur.N + c8); a = sp[0]; b = sp[1]; }
        while (job < 4 * 2496) {
            float* r = scr + par * (64 * 65) + kk * 65 + c8;
            r[0] = a.x; r[1] = a.y; r[2] = a.z; r[3] = a.w; r[4] = b.x; r[5] = b.y; r[6] = b.z; r[7] = b.w;
            const int nxt = job + C.G; TJob nj;
            if (nxt < 4 * 2496) { nj = tjob_decode(P, C, nxt); const float4* sp = (const float4*)(nj.src + (size_t)kk * nj.N + c8); a = sp[0]; b = sp[1]; }
            __syncthreads();
            const float* q = scr + par * (64 * 65) + k8 * 65 + n;
            u32x4 wv; wv.x = pk2(q[0], q[65]); wv.y = pk2(q[130], q[195]); wv.z = pk2(q[260], q[325]); wv.w = pk2(q[390], q[455]);
            *(u32x4*)(cur.dst + (size_t)n * cur.Kp + k8) = wv;
            cur = nj; job = nxt; par ^= 1;
        }
        __syncthreads();
    }
    for (int row = C.bx * 8 + C.w; row < M_TOT; row += C.G * 8) {
        const float* xs = row < M_P ? P.x_prompt + (size_t)row * DM : P.x_sample + (size_t)(row - M_P) * DM;
        float4 x[4]; float ss = 0.f;
#pragma unroll
        for (int i = 0; i < 4; ++i) { x[i] = ((const float4*)xs)[C.lane + 64 * i]; ss += x[i].x * x[i].x + x[i].y * x[i].y + x[i].z * x[i].z + x[i].w * x[i].w; }
        ss = wave_sum(ss); const float r = rsqrtf(ss * (1.f / DM) + EPS);
#pragma unroll
        for (int i = 0; i < 4; ++i) { ((float4*)(P.out + (size_t)row * DM))[C.lane + 64 * i] = x[i];
            const float4 g = ((const float4*)P.g_pre)[C.lane + 64 * i];
            uint2 o; o.x = pk2(x[i].x * r * g.x, x[i].y * r * g.y); o.y = pk2(x[i].z * r * g.z, x[i].w * r * g.w);
            ((uint2*)(C.h + (size_t)row * DM))[C.lane + 64 * i] = o; }
    }
    const int gt = C.bx * NTHREADS + tid, gn = C.G * NTHREADS;
    const double TWO_PI = 6.283185307179586476925286766559, INV_2PI = 0.15915494309189533576888376337251;
    for (int i = gt; i < NPOS * 24; i += gn) {
        int pos, f; double inv;
        if (i < NPOS * 16) { pos = i >> 4; f = i & 15; inv = P.invA[f]; } else { const int k = i - NPOS * 16; pos = k >> 3; f = k & 7; inv = P.invB[f]; }
        double r = (double)pos * inv * INV_2PI; r -= floor(r);
        const float a = (float)(r * TWO_PI);
        const float cs = cosf(a), sn = sinf(a);
        if (i < NPOS * 16) { C.ropeAc[i] = cs; C.ropeAs[i] = sn; } else { C.ropeBc[i - NPOS * 16] = cs; C.ropeBs[i - NPOS * 16] = sn; }
    }
    for (int c = gt; c < 256; c += gn) {
        const float v0 = P.lower_bounds[c], v1 = P.lower_bounds[256 + c], v2 = P.lower_bounds[512 + c], v3 = P.lower_bounds[768 + c];
        const float m = fmaxf(fmaxf(v0, v1), fmaxf(v2, v3));
        const float e0 = expf(v0 - m), e1 = expf(v1 - m), e2 = expf(v2 - m), e3 = expf(v3 - m), inv = 1.f / (e0 + e1 + e2 + e3);
        C.lbt[c] = 0.f; C.lbt[256 + c] = e1 * inv; C.lbt[512 + c] = (e1 + e2) * inv; C.lbt[768 + c] = (e1 + e2 + e3) * inv;
    }
}

__device__ __forceinline__ void attn_prompt_unit(const Params& P, Ctx& C, int l, int b, int qb, int kvh, unsigned char* lds) {
    const int tid = C.tid, lane = C.lane, w = C.w, fr = lane & 15, fq = lane >> 4;
    bf16_t* Ks = (bf16_t*)lds;
    bf16_t* Vt = (bf16_t*)(lds + 36864);
    bf16_t* Ps = (bf16_t*)(lds + 36864 + 35840) + w * (16 * 168);
    const int t0 = qb * 128; const size_t R0 = (size_t)b * 8192 + t0;
    const bool last = (qb == 63);
#pragma unroll 2
    for (int it = 0; it < 4; ++it) { const int i = tid + it * NTHREADS;
      if (i < 256 * 7) {
        const int kk = i / 7, task = i - kk * 7, tk = t0 - 128 + kk;
        bf16_t* dst = Ks + kk * 72;
        if (tk < 0) { const u32x4 z = {0u, 0u, 0u, 0u}; if (task == 0) { *(u32x4*)dst = z; *(u32x4*)(dst + 8) = z; } else *(u32x4*)(dst + (task + 1) * 8) = z; }
        else {
            const bf16_t* src = C.proj + (size_t)(b * 8192 + tk) * NPROJ + C_KB + kvh * 64;
            if (task == 0) {
                const u32x4 a = *(const u32x4*)src, bb = *(const u32x4*)(src + 8);
                const float4 c0 = *(const float4*)(C.ropeBc + tk * 8), c1 = *(const float4*)(C.ropeBc + tk * 8 + 4), s0 = *(const float4*)(C.ropeBs + tk * 8), s1 = *(const float4*)(C.ropeBs + tk * 8 + 4);
                float x1[8], x2[8]; unpack8(a, x1); unpack8(bb, x2);
                const float cs[8] = {c0.x, c0.y, c0.z, c0.w, c1.x, c1.y, c1.z, c1.w}, sn[8] = {s0.x, s0.y, s0.z, s0.w, s1.x, s1.y, s1.z, s1.w};
                float r1[8], r2[8];
#pragma unroll
                for (int j = 0; j < 8; ++j) { r1[j] = x1[j] * cs[j] - x2[j] * sn[j]; r2[j] = x2[j] * cs[j] + x1[j] * sn[j]; }
                *(u32x4*)dst = pack8(r1); *(u32x4*)(dst + 8) = pack8(r2);
            } else { const int c = task + 1; *(u32x4*)(dst + c * 8) = *(const u32x4*)(src + c * 8); }
        }
      } }
#pragma unroll
    for (int it = 0; it < 4; ++it) { const int i = tid + it * NTHREADS;
        const int kk = i & 255, c = i >> 8, tk = t0 - 128 + kk;
        u32x4 a = {0u, 0u, 0u, 0u};
        if (tk >= 0) a = *(const u32x4*)(C.proj + (size_t)(b * 8192 + tk) * NPROJ + C_VB + kvh * 64 + c * 8);
        bf16_t* d = Vt + (c * 8) * 280 + kk;
        d[0] = (bf16_t)(a.x & 0xffff); d[280] = (bf16_t)(a.x >> 16); d[560] = (bf16_t)(a.y & 0xffff); d[840] = (bf16_t)(a.y >> 16);
        d[1120] = (bf16_t)(a.z & 0xffff); d[1400] = (bf16_t)(a.z >> 16); d[1680] = (bf16_t)(a.w & 0xffff); d[1960] = (bf16_t)(a.w >> 16);
    }
    for (int i = tid; i < 64 * 24; i += NTHREADS) Vt[(i / 24) * 280 + 256 + (i % 24)] = 0;
    for (int i = lane; i < 16 * 16; i += 64) Ps[(i >> 4) * 168 + 144 + (i & 15)] = 0;
    __syncthreads();
    if (last) {
        for (int i = tid; i < 128 * 64; i += NTHREADS) { const int wq = i >> 6, d = i & 63;
            const size_t o = ((((size_t)l * 2 + b) * 128 + wq) * 2 + kvh) * 64 + d;
            P.out[O_KP + o] = bf2f(Ks[(128 + wq) * 72 + d]); P.out[O_VP + o] = bf2f(Vt[d * 280 + 128 + wq]); }
    }
    const int tq = t0 + w * 16 + fr;
#pragma unroll
    for (int g = 0; g < 4; ++g) {
        const int h = kvh * 4 + g;
        const bf16_t* qsrc = C.proj + (R0 + w * 16 + fr) * NPROJ + C_QB + h * 64;
        u32x4 q0 = *(const u32x4*)(qsrc + fq * 8); const u32x4 q1 = *(const u32x4*)(qsrc + 32 + fq * 8);
        if (fq < 2) {
            const u32x4 qp = *(const u32x4*)(qsrc + (fq ^ 1) * 8);
            const float4 c0 = *(const float4*)(C.ropeBc + tq * 8), c1 = *(const float4*)(C.ropeBc + tq * 8 + 4), s0 = *(const float4*)(C.ropeBs + tq * 8), s1 = *(const float4*)(C.ropeBs + tq * 8 + 4);
            const float sg = fq == 0 ? -1.f : 1.f;
            const float own[8] = {lo16(q0.x), hi16(q0.x), lo16(q0.y), hi16(q0.y), lo16(q0.z), hi16(q0.z), lo16(q0.w), hi16(q0.w)};
            const float par[8] = {lo16(qp.x), hi16(qp.x), lo16(qp.y), hi16(qp.y), lo16(qp.z), hi16(qp.z), lo16(qp.w), hi16(qp.w)};
            const float cs[8] = {c0.x, c0.y, c0.z, c0.w, c1.x, c1.y, c1.z, c1.w}, sn[8] = {s0.x, s0.y, s0.z, s0.w, s1.x, s1.y, s1.z, s1.w};
            float r[8];
#pragma unroll
            for (int j = 0; j < 8; ++j) r[j] = own[j] * cs[j] + sg * par[j] * sn[j];
            q0.x = pk2(r[0], r[1]); q0.y = pk2(r[2], r[3]); q0.z = pk2(r[4], r[5]); q0.w = pk2(r[6], r[7]);
        }
        const bf16x8 qa0 = __builtin_bit_cast(bf16x8, q0), qa1 = __builtin_bit_cast(bf16x8, q1);
        f32x4 S[9];
#pragma unroll
        for (int jt = 0; jt < 9; ++jt) {
            const bf16_t* kp = Ks + ((w + jt) * 16 + fr) * 72 + fq * 8;
            f32x4 a = {0.f, 0.f, 0.f, 0.f};
            a = mfma16(qa0, *(const bf16x8*)kp, a); a = mfma16(qa1, *(const bf16x8*)(kp + 32), a);
            S[jt] = a;
        }
        const float sink = P.attn_sink[l * 8 + h];
        float mx[4], sm[4];
#pragma unroll
        for (int j = 0; j < 4; ++j) {
            const int r = w * 16 + fq * 4 + j;
            float m = -1e30f;
#pragma unroll
            for (int jt = 0; jt < 9; ++jt) { const int kk = (w + jt) * 16 + fr; const bool ok = (kk >= r) && (kk <= r + 128) && (t0 - 128 + kk >= 0);
                const float s = ok ? S[jt][j] * 0.125f : -1e30f; S[jt][j] = s; m = fmaxf(m, s); }
            m = fmaxf(quad16_max(m), sink); mx[j] = m;
            float su = 0.f;
#pragma unroll
            for (int jt = 0; jt < 9; ++jt) { const float p = __expf(S[jt][j] - m); su += p; Ps[(fq * 4 + j) * 168 + jt * 16 + fr] = f2bf(p); }
            su = quad16_sum(su) + __expf(sink - m); sm[j] = 1.f / su;
        }
        __syncthreads();
        float zz[4][4];
#pragma unroll
        for (int j = 0; j < 4; ++j)
#pragma unroll
            for (int nt = 0; nt < 4; ++nt) zz[j][nt] = bf2f(C.proj[(R0 + w * 16 + fq * 4 + j) * NPROJ + C_ZB + h * 64 + nt * 16 + fr]);
        f32x4 O[4];
#pragma unroll
        for (int nt = 0; nt < 4; ++nt) O[nt] = (f32x4){0.f, 0.f, 0.f, 0.f};
#pragma unroll
        for (int kx = 0; kx < 5; ++kx) {
            const bf16x8 a = *(const bf16x8*)(Ps + fr * 168 + kx * 32 + fq * 8);
#pragma unroll
            for (int nt = 0; nt < 4; ++nt) O[nt] = mfma16(a, *(const bf16x8*)(Vt + (nt * 16 + fr) * 280 + w * 16 + kx * 32 + fq * 8), O[nt]);
        }
#pragma unroll
        for (int j = 0; j < 4; ++j) {
            const size_t row = R0 + w * 16 + fq * 4 + j;
#pragma unroll
            for (int nt = 0; nt < 4; ++nt) { const int e = nt * 16 + fr;
                C.y[row * WMIX + Y_B + h * 64 + e] = f2bf(O[nt][j] * sm[j] * silu_(zz[j][nt])); }
        }
        __syncthreads();
    }
}

__device__ __forceinline__ void pool_prompt_unit(const Params& P, Ctx& C, int l, int tile, unsigned char* lds) {
    const int tid = C.tid, lane = C.lane, w = C.w, fr = lane & 15, fq = lane >> 4;
    bf16_t* U = (bf16_t*)lds;
    bf16_t* A = (bf16_t*)(lds + 40448);
    bf16_t* Wt = (bf16_t*)(lds + 40448 + 33792);
    const int b = tile >> 7, t0 = (tile & 127) * 64; const size_t R0 = (size_t)b * 8192 + t0;
    for (int i = tid; i < 79 * 32; i += NTHREADS) { const int r = i >> 5, c = i & 31, t = t0 - 15 + r;
        u32x4 a = {0u, 0u, 0u, 0u}; if (t >= 0) a = *(const u32x4*)(C.proj + (size_t)(b * 8192 + t) * NPROJ + C_UC + c * 8);
        *(u32x4*)(U + r * 256 + c * 8) = a; }
    for (int i = tid; i < 4 * 64 * 64; i += NTHREADS) { const int g = i >> 12, cin = (i >> 6) & 63, dout = i & 63;
        Wt[(g * 64 + dout) * 72 + cin] = f2bf(P.w_pool[(size_t)l * 16384 + i]); }
    __syncthreads();
    { const int c = tid & 255, rh = tid >> 8, g = c >> 6, wn = 2 << g;
      for (int r = rh * 32; r < rh * 32 + 32; ++r) {
          float s = 0.f; for (int j = 0; j < wn; ++j) s += bf2f(U[(r + 15 - j) * 256 + c]);
          const int pos = t0 + r; const float cnt = (float)(pos + 1 < wn ? pos + 1 : wn);
          const float u = bf2f(U[(r + 15) * 256 + c]);
          A[r * 264 + c] = f2bf(s / cnt - u);
          if (t0 == 8128 && r >= 49) P.out[O_POOLP + (((size_t)l * 2 + b) * 15 + (r - 49)) * 256 + c] = u;
      } }
    __syncthreads();
    for (int tl = w; tl < 64; tl += 8) { const int rt = tl >> 4, ct = tl & 15, g = ct >> 2;
        f32x4 acc = {0.f, 0.f, 0.f, 0.f};
        acc = mma_tile(A + rt * 16 * 264 + g * 64, 264, Wt + (g * 64 + (ct & 3) * 16) * 72, 72, 64, acc, lane);
        const int c = ct * 16 + fr; const float sc = P.pool_scale[l * 256 + c];
        float zz[4];
#pragma unroll
        for (int j = 0; j < 4; ++j) zz[j] = bf2f(C.proj[(R0 + rt * 16 + fq * 4 + j) * NPROJ + C_ZC + c]);
#pragma unroll
        for (int j = 0; j < 4; ++j) { const size_t row = R0 + rt * 16 + fq * 4 + j;
            C.y[row * WMIX + Y_C + c] = f2bf(acc[j] * sc * silu_(zz[j])); }
    }
    __syncthreads();
}

template <bool IS_D, bool KV>
__device__ __forceinline__ void lin_chunk(const Params& P, Ctx& C, int l, int b, int n, unsigned char* lds) {
    const int lane = C.lane, w = C.w, fr = lane & 15, fq = lane >> 4;
    constexpr int DK = IS_D ? 64 : 32, NCG = DK / 8, HPR = KV ? 4 : 2;
    constexpr int SLOT = KV ? 18432 : 53248, VP = KV ? 72 : 136;
    const size_t R0 = (size_t)b * 8192 + n * 64;
    const bf16_t* prow = C.proj + (R0 + lane) * NPROJ;
    for (int h0 = 0; h0 < 4; h0 += HPR) {
        float decv[(HPR * NCG) / 8][8];
#pragma unroll
        for (int ti = 0; ti < (HPR * NCG) / 8; ++ti) { const int task = w + ti * 8;
            const int hh = task / NCG, cg = task % NCG, h = h0 + hh, d0 = cg * 8;
            unsigned char* slot = lds + hh * SLOT;
            float q[8], k[8], Bt[8], Bm[8], Bl[8];
            if (IS_D) {
                float qv[8], fv[8]; unpack8(*(const u32x4*)(prow + C_QD + h * 64 + d0), qv); unpack8(*(const u32x4*)(prow + C_FD + h * 64 + d0), fv);
                const float4 l0 = *(const float4*)(C.lbt + l * 256 + h * 64 + d0), l1 = *(const float4*)(C.lbt + l * 256 + h * 64 + d0 + 4);
                const float lb[8] = {l0.x, l0.y, l0.z, l0.w, l1.x, l1.y, l1.z, l1.w};
#pragma unroll
                for (int j = 0; j < 8; ++j) { const float f = lb[j] + (1.f - lb[j]) * sigmoid_(fv[j]); q[j] = silu_(qv[j]); k[j] = 1.f - f;
                    float v = __logf(f);
#pragma unroll
                    for (int off = 1; off < 64; off <<= 1) { const float u = __shfl_up(v, off); if (lane >= off) v += u; }
                    Bt[j] = v; Bm[j] = __shfl(v, 31); Bl[j] = __shfl(v, 63); }
#pragma unroll
                for (int j = 0; j < 8; ++j) decv[ti][j] = Bl[j];
            } else {
                const float lg = log1pf(-exp2f(-5.f - (float)h));
                const int i0 = d0 & 15, pos = n * 64 + lane;
                float q1[8], q2[8], k1[8], k2[8];
                unpack8(*(const u32x4*)(prow + C_QA + h * 32 + i0), q1); unpack8(*(const u32x4*)(prow + C_QA + h * 32 + 16 + i0), q2);
                unpack8(*(const u32x4*)(prow + C_KA + h * 32 + i0), k1); unpack8(*(const u32x4*)(prow + C_KA + h * 32 + 16 + i0), k2);
                const float4 c0 = *(const float4*)(C.ropeAc + pos * 16 + i0), c1 = *(const float4*)(C.ropeAc + pos * 16 + i0 + 4), s0 = *(const float4*)(C.ropeAs + pos * 16 + i0), s1 = *(const float4*)(C.ropeAs + pos * 16 + i0 + 4);
                const float cs[8] = {c0.x, c0.y, c0.z, c0.w, c1.x, c1.y, c1.z, c1.w}, sn[8] = {s0.x, s0.y, s0.z, s0.w, s1.x, s1.y, s1.z, s1.w};
#pragma unroll
                for (int j = 0; j < 8; ++j) {
                    q[j] = d0 < 16 ? q1[j] * cs[j] - q2[j] * sn[j] : q2[j] * cs[j] + q1[j] * sn[j];
                    k[j] = (d0 < 16 ? k1[j] * cs[j] - k2[j] * sn[j] : k2[j] * cs[j] + k1[j] * sn[j]) * 0.17677669529663687f;
                    Bt[j] = (float)(lane + 1) * lg; Bm[j] = 32.f * lg; Bl[j] = 64.f * lg; }
            }
            if (!KV) {
                bf16_t* Qh = (bf16_t*)slot; bf16_t* Kh = (bf16_t*)(slot + 9216); bf16_t* PQ = (bf16_t*)(slot + 18432);
                float a[8], c[8], e[8];
#pragma unroll
                for (int j = 0; j < 8; ++j) { a[j] = q[j] * __expf(Bt[j] - Bm[j]); c[j] = k[j] * __expf(Bm[j] - Bt[j]); e[j] = q[j] * __expf(Bt[j]); }
                *(u32x4*)(Qh + lane * 72 + d0) = pack8(a); *(u32x4*)(Kh + lane * 72 + d0) = pack8(c); *(u32x4*)(PQ + lane * 136 + 64 + d0) = pack8(e);
            } else {
                bf16_t* KdT = (bf16_t*)slot;
#pragma unroll
                for (int j = 0; j < 8; ++j) KdT[(d0 + j) * 72 + lane] = f2bf(k[j] * __expf(Bl[j] - Bt[j]));
            }
        }
        if (IS_D && KV && lane == 63) {
#pragma unroll
            for (int ti = 0; ti < (HPR * NCG) / 8; ++ti) { const int task = w + ti * 8, h = h0 + task / NCG, d0 = (task % NCG) * 8;
#pragma unroll
                for (int j = 0; j < 8; ++j) C.decd[(size_t)(b * 128 + n) * 256 + h * 64 + d0 + j] = __expf(decv[ti][j]); } }
#pragma unroll
        for (int tv = 0; tv < HPR; ++tv) { const int task = w + tv * 8;
            const int hh = task >> 3, e0 = (task & 7) * 8, h = h0 + hh;
            bf16_t* VS = (bf16_t*)(lds + hh * SLOT + (KV ? 9216 : 35840));
            const u32x4 v = *(const u32x4*)(prow + (IS_D ? C_ID : C_VA) + h * 64 + e0);
            bf16_t* d = VS + e0 * VP + lane;
            d[0] = (bf16_t)(v.x & 0xffff); d[VP] = (bf16_t)(v.x >> 16); d[2 * VP] = (bf16_t)(v.y & 0xffff); d[3 * VP] = (bf16_t)(v.y >> 16);
            d[4 * VP] = (bf16_t)(v.z & 0xffff); d[5 * VP] = (bf16_t)(v.z >> 16); d[6 * VP] = (bf16_t)(v.w & 0xffff); d[7 * VP] = (bf16_t)(v.w >> 16);
            if (!KV && lane < DK) {
                const float* sp = (IS_D ? C.kvd : C.kva) + ((size_t)(b * 128 + n) * 4 + h) * (DK * 64) + lane * 64 + e0;
                const float4 s0 = *(const float4*)sp, s1 = *(const float4*)(sp + 4);
                bf16_t* ds = VS + e0 * VP + 64 + lane;
                ds[0] = f2bf(s0.x); ds[VP] = f2bf(s0.y); ds[2 * VP] = f2bf(s0.z); ds[3 * VP] = f2bf(s0.w); ds[4 * VP] = f2bf(s1.x); ds[5 * VP] = f2bf(s1.y); ds[6 * VP] = f2bf(s1.z); ds[7 * VP] = f2bf(s1.w);
            }
        }
        __syncthreads();
        if (KV) {
            constexpr int TPH = (DK / 16) * 4;
            for (int tl = w; tl < 4 * TPH; tl += 8) { const int hh = tl / TPH, r = tl % TPH, dt = r >> 2, et = r & 3, h = h0 + hh;
                const bf16_t* KdT = (const bf16_t*)(lds + hh * SLOT); const bf16_t* VT = (const bf16_t*)(lds + hh * SLOT + 9216);
                f32x4 acc = {0.f, 0.f, 0.f, 0.f};
                acc = mma_tile(KdT + dt * 16 * 72, 72, VT + et * 16 * 72, 72, 64, acc, lane);
                float* kvbase = (IS_D ? C.kvd : C.kva) + ((size_t)(b * 128 + n) * 4 + h) * (DK * 64);
#pragma unroll
                for (int j = 0; j < 4; ++j) kvbase[(dt * 16 + fq * 4 + j) * 64 + et * 16 + fr] = acc[j]; }
        } else {
            for (int tl = w; tl < 32; tl += 8) { const int hh = tl >> 4, rt = (tl >> 2) & 3, ct = tl & 3;
                const bf16_t* Qh = (const bf16_t*)(lds + hh * SLOT); const bf16_t* Kh = (const bf16_t*)(lds + hh * SLOT + 9216); bf16_t* PQ = (bf16_t*)(lds + hh * SLOT + 18432);
                f32x4 acc = {0.f, 0.f, 0.f, 0.f};
                if (ct <= rt) acc = mma_tile(Qh + rt * 16 * 72, 72, Kh + ct * 16 * 72, 72, DK, acc, lane);
#pragma unroll
                for (int j = 0; j < 4; ++j) { const int t = rt * 16 + fq * 4 + j, sidx = ct * 16 + fr; PQ[t * 136 + sidx] = f2bf(sidx <= t ? acc[j] : 0.f); } }
            __syncthreads();
            { const int hh = w >> 2, rt = w & 3, h = h0 + hh;
                const bf16_t* PQ = (const bf16_t*)(lds + hh * SLOT + 18432); const bf16_t* VS = (const bf16_t*)(lds + hh * SLOT + 35840);
                float zz[4][4], gg[4];
#pragma unroll
                for (int et = 0; et < 4; ++et) { gg[et] = IS_D ? P.g_hgrn[l * 256 + h * 64 + et * 16 + fr] : 1.f;
#pragma unroll
                    for (int j = 0; j < 4; ++j) zz[j][et] = bf2f(C.proj[(R0 + rt * 16 + fq * 4 + j) * NPROJ + (IS_D ? C_ZD : C_ZA) + h * 64 + et * 16 + fr]); }
                f32x4 O[4];
#pragma unroll
                for (int et = 0; et < 4; ++et) { O[et] = (f32x4){0.f, 0.f, 0.f, 0.f}; O[et] = mma_tile(PQ + rt * 16 * 136, 136, VS + et * 16 * 136, 136, 64 + DK, O[et], lane); }
#pragma unroll
                for (int j = 0; j < 4; ++j) {
                    float ss = O[0][j] * O[0][j] + O[1][j] * O[1][j] + O[2][j] * O[2][j] + O[3][j] * O[3][j];
                    ss = quad16_sum(ss); const float r = rsqrtf(ss * (1.f / 64.f) + EPS);
                    const size_t row = R0 + rt * 16 + fq * 4 + j;
#pragma unroll
                    for (int et = 0; et < 4; ++et) { const int e = et * 16 + fr;
                        C.y[row * WMIX + (IS_D ? Y_D : Y_A) + h * 64 + e] = f2bf(O[et][j] * r * gg[et] * silu_(zz[j][et])); }
                }
            }
        }
        __syncthreads();
    }
}

#define PR(t, c) bf2f(prb[(t) * NPROJ + (c)])
__device__ __forceinline__ void sample_b_unit(const Params& P, Ctx& C, int l, int sb, unsigned char* lds) {
    const int tid = C.tid, lane = C.lane, w = C.w;
    bf16_t* prb = (bf16_t*)lds;
    float* qbq = (float*)(lds + 28672);
    float* kn = qbq + 2048;
    float* ps = kn + 512;
    float* kv = ps + 32 * 136;
    const size_t R0 = (size_t)M_P + sb * 4;
    const float4* kc4 = (const float4*)(P.cache_k + ((size_t)l * 128 + sb) * 16384);
    const float4* vc4 = (const float4*)(P.cache_v + ((size_t)l * 128 + sb) * 16384);
    for (int i = tid; i < 4 * 448; i += NTHREADS) { const int t = i / 448, c = i % 448;
        *(u32x4*)(prb + t * NPROJ + c * 8) = *(const u32x4*)(C.proj + (R0 + t) * NPROJ + c * 8); }
    { float4* ko = (float4*)(P.out + O_KS + ((size_t)l * 128 + sb) * 16384);
      f32x4 cv[8];
#pragma unroll
      for (int j = 0; j < 8; ++j) cv[j] = ((const f32x4*)kc4)[tid + NTHREADS * j];
#pragma unroll
      for (int j = 0; j < 8; ++j) { const int i = tid + NTHREADS * j, e = i * 4, wq = e >> 7, r = e & 127;
          *(f32x4*)(kv + (wq * 2 + (r >> 6)) * 68 + (r & 63)) = cv[j];
          if (wq >= 4) ((f32x4*)ko)[i - 128] = cv[j]; } }
    __syncthreads();
    for (int i = tid; i < 2048; i += NTHREADS) { const int t = i >> 9, c = i & 511, h = c >> 6, d = c & 63; const int pos = 8192 + t;
        float v;
        if (d < 16) { const int ii = d & 7; const float cs = C.ropeBc[pos * 8 + ii], sn = C.ropeBs[pos * 8 + ii];
            const float x1 = PR(t, C_QB + h * 64 + ii), x2 = PR(t, C_QB + h * 64 + 8 + ii); v = d < 8 ? x1 * cs - x2 * sn : x2 * cs + x1 * sn; }
        else v = PR(t, C_QB + c);
        qbq[i] = v * 0.125f; }
    { const int t = tid >> 7, c = tid & 127, kh = c >> 6, d = c & 63, pos = 8192 + t;
        float v;
        if (d < 16) { const int ii = d & 7; const float cs = C.ropeBc[pos * 8 + ii], sn = C.ropeBs[pos * 8 + ii];
            const float x1 = PR(t, C_KB + kh * 64 + ii), x2 = PR(t, C_KB + kh * 64 + 8 + ii); v = d < 8 ? x1 * cs - x2 * sn : x2 * cs + x1 * sn; }
        else v = PR(t, C_KB + c);
        kn[tid] = v;
        P.out[O_KS + (((size_t)l * 128 + sb) * 128 + 124 + t) * 128 + c] = v;
        P.out[O_VS + (((size_t)l * 128 + sb) * 128 + 124 + t) * 128 + c] = PR(t, C_VB + c); }
    __syncthreads();
    for (int i = tid; i < 4224; i += NTHREADS) { const int kh = i / 2112, rem = i - kh * 2112, r16 = rem / 132, kk = rem - r16 * 132, g = r16 >> 2, t = r16 & 3, h = kh * 4 + g;
        const bool ok = kk < 128 ? (kk >= t) : (kk - 128 <= t);
        const float4* kp = (const float4*)(kk < 128 ? kv + (kk * 2 + kh) * 68 : kn + (kk - 128) * 128 + kh * 64);
        const float4* qp = (const float4*)(qbq + t * 512 + h * 64);
        float s = 0.f;
#pragma unroll 4
        for (int d = 0; d < 16; ++d) { const float4 a = qp[d], bq = kp[d]; s += a.x * bq.x + a.y * bq.y + a.z * bq.z + a.w * bq.w; }
        ps[(h * 4 + t) * 136 + kk] = ok ? s : -1e30f; }
    __syncthreads();
    { float4* vo = (float4*)(P.out + O_VS + ((size_t)l * 128 + sb) * 16384);
      f32x4 cv[8];
#pragma unroll
      for (int j = 0; j < 8; ++j) cv[j] = ((const f32x4*)vc4)[tid + NTHREADS * j];
#pragma unroll
      for (int j = 0; j < 8; ++j) { const int i = tid + NTHREADS * j, e = i * 4, wq = e >> 7, r = e & 127;
          *(f32x4*)(kv + (wq * 2 + (r >> 6)) * 68 + (r & 63)) = cv[j];
          if (wq >= 4) ((f32x4*)vo)[i - 128] = cv[j]; } }
    { const int h = w; const float sink = P.attn_sink[l * 8 + h];
      for (int t = 0; t < 4; ++t) { float* pr_ = ps + (h * 4 + t) * 136;
          const float s0 = pr_[lane], s1 = pr_[lane + 64], s2 = lane < 4 ? pr_[lane + 128] : -1e30f;
          float m = fmaxf(fmaxf(s0, s1), s2); m = fmaxf(m, __shfl_xor(m, 32)); m = fmaxf(m, __shfl_xor(m, 16)); m = fmaxf(m, __shfl_xor(m, 8)); m = fmaxf(m, __shfl_xor(m, 4)); m = fmaxf(m, __shfl_xor(m, 2)); m = fmaxf(m, __shfl_xor(m, 1));
          m = fmaxf(m, sink);
          const float p0 = __expf(s0 - m), p1 = __expf(s1 - m), p2 = lane < 4 ? __expf(s2 - m) : 0.f;
          const float inv = 1.f / (wave_sum(p0 + p1 + p2) + __expf(sink - m));
          pr_[lane] = p0 * inv; pr_[lane + 64] = p1 * inv; if (lane < 4) pr_[lane + 128] = p2 * inv; } }
    __syncthreads();
    { const int h = w, kh = h >> 2, e = lane;
      float o0 = 0.f, o1 = 0.f, o2 = 0.f, o3 = 0.f; const float* p0 = ps + (h * 4) * 136;
#pragma unroll 8
      for (int kk = 0; kk < 128; ++kk) { const float v = kv[(kk * 2 + kh) * 68 + e]; o0 += p0[kk] * v; o1 += p0[136 + kk] * v; o2 += p0[272 + kk] * v; o3 += p0[408 + kk] * v; }
#pragma unroll
      for (int kk = 128; kk < 132; ++kk) { const float v = PR(kk - 128, C_VB + kh * 64 + e); o0 += p0[kk] * v; o1 += p0[136 + kk] * v; o2 += p0[272 + kk] * v; o3 += p0[408 + kk] * v; }
      const int c = h * 64 + e;
      C.y[(R0 + 0) * WMIX + Y_B + c] = f2bf(o0 * silu_(PR(0, C_ZB + c))); C.y[(R0 + 1) * WMIX + Y_B + c] = f2bf(o1 * silu_(PR(1, C_ZB + c)));
      C.y[(R0 + 2) * WMIX + Y_B + c] = f2bf(o2 * silu_(PR(2, C_ZB + c))); C.y[(R0 + 3) * WMIX + Y_B + c] = f2bf(o3 * silu_(PR(3, C_ZB + c))); }
    __syncthreads();
}

__device__ __forceinline__ void sample_adc_unit(const Params& P, Ctx& C, int l, int sb, unsigned char* lds) {
    const int tid = C.tid, lane = C.lane, w = C.w;
    bf16_t* prb = (bf16_t*)lds;
    float* qa = (float*)(lds + 28672);
    float* ka = qa + 512;
    float* qd = ka + 512;
    float* fd = qd + 1024;
    float* pl = fd + 1024;
    float* part = pl + 1024;
    const size_t R0 = (size_t)M_P + sb * 4;
    const int h = w >> 1, half = w & 1, e = lane;
    const float* SD0 = P.state_hgrn + (((size_t)l * 128 + sb) * 4 + h) * 4096 + (half * 32) * 64 + e;
    const float* SA0 = P.state_ret + (((size_t)l * 128 + sb) * 4 + h) * 2048 + (half * 16) * 64 + e;
    float sd[32], sa[16];
#pragma unroll
    for (int i = 0; i < 32; ++i) sd[i] = SD0[i * 64];
#pragma unroll
    for (int i = 0; i < 16; ++i) sa[i] = SA0[i * 64];
    for (int i = tid; i < 4 * 448; i += NTHREADS) { const int t = i / 448, c = i % 448;
        *(u32x4*)(prb + t * NPROJ + c * 8) = *(const u32x4*)(C.proj + (R0 + t) * NPROJ + c * 8); }
    __syncthreads();
    { const int t = tid >> 7, c = tid & 127, hh = c >> 5, d = c & 31, ii = d & 15, pos = 8192 + t;
        const float cs = C.ropeAc[pos * 16 + ii], sn = C.ropeAs[pos * 16 + ii];
        const float q1 = PR(t, C_QA + hh * 32 + ii), q2 = PR(t, C_QA + hh * 32 + 16 + ii), k1 = PR(t, C_KA + hh * 32 + ii), k2 = PR(t, C_KA + hh * 32 + 16 + ii);
        qa[tid] = d < 16 ? q1 * cs - q2 * sn : q2 * cs + q1 * sn;
        ka[tid] = (d < 16 ? k1 * cs - k2 * sn : k2 * cs + k1 * sn) * 0.17677669529663687f; }
    for (int i = tid; i < 1024; i += NTHREADS) { const int t = i >> 8, c = i & 255;
        qd[i] = silu_(PR(t, C_QD + c)); const float lb = C.lbt[l * 256 + c]; fd[i] = lb + (1.f - lb) * sigmoid_(PR(t, C_FD + c));
        const int g = c >> 6, wn = 2 << g; float s = 0.f;
        for (int j = 0; j < wn; ++j) { const int ee = 15 + t - j; s += ee >= 15 ? PR(ee - 15, C_UC + c) : P.state_pool[(((size_t)l * 128 + sb) * 15 + ee) * 256 + c]; }
        pl[i] = s / (float)wn - PR(t, C_UC + c); }
    { float pv[8];
#pragma unroll
      for (int it = 0; it < 8; ++it) { const int i = tid + it * NTHREADS, r = i >> 8, c = i & 255;
          pv[it] = (i < 15 * 256) ? (r < 11 ? P.state_pool[(((size_t)l * 128 + sb) * 15 + r + 4) * 256 + c] : PR(r - 11, C_UC + c)) : 0.f; }
#pragma unroll
      for (int it = 0; it < 8; ++it) { const int i = tid + it * NTHREADS, r = i >> 8, c = i & 255;
          if (i < 15 * 256) P.out[O_POOLS + (((size_t)l * 128 + sb) * 15 + r) * 256 + c] = pv[it]; } }
    const int pc = tid & 255, tp = tid >> 8, pg = pc >> 6;
    const float* wp = P.w_pool + ((size_t)l * 4 + pg) * 4096 + (pc & 63);
    __syncthreads();
    {
        float* S1 = P.out + O_HGRNS + (((size_t)l * 128 + sb) * 4 + h) * 4096 + (half * 32) * 64 + e;
        const float v0 = PR(0, C_ID + h * 64 + e), v1 = PR(1, C_ID + h * 64 + e), v2 = PR(2, C_ID + h * 64 + e), v3 = PR(3, C_ID + h * 64 + e);
        float o0 = 0.f, o1 = 0.f, o2 = 0.f, o3 = 0.f;
#pragma unroll
        for (int i = 0; i < 32; ++i) { float s = sd[i]; const int c = h * 64 + half * 32 + i;
            float f = fd[c]; s = f * s + (1.f - f) * v0; o0 += qd[c] * s; f = fd[256 + c]; s = f * s + (1.f - f) * v1; o1 += qd[256 + c] * s;
            f = fd[512 + c]; s = f * s + (1.f - f) * v2; o2 += qd[512 + c] * s; f = fd[768 + c]; s = f * s + (1.f - f) * v3; o3 += qd[768 + c] * s; S1[i * 64] = s; __builtin_amdgcn_sched_barrier(0); }
        float* pp = part + (w * 2 + 1) * 256 + e; pp[0] = o0; pp[64] = o1; pp[128] = o2; pp[192] = o3;
    }
    {
        const float gam = 1.f - exp2f(-5.f - (float)h);
        float* S1 = P.out + O_RETS + (((size_t)l * 128 + sb) * 4 + h) * 2048 + (half * 16) * 64 + e;
        const float v0 = PR(0, C_VA + h * 64 + e), v1 = PR(1, C_VA + h * 64 + e), v2 = PR(2, C_VA + h * 64 + e), v3 = PR(3, C_VA + h * 64 + e);
        float o0 = 0.f, o1 = 0.f, o2 = 0.f, o3 = 0.f;
#pragma unroll
        for (int i = 0; i < 16; ++i) { float s = sa[i]; const int c = h * 32 + half * 16 + i;
            s = gam * s + ka[c] * v0; o0 += qa[c] * s; s = gam * s + ka[128 + c] * v1; o1 += qa[128 + c] * s;
            s = gam * s + ka[256 + c] * v2; o2 += qa[256 + c] * s; s = gam * s + ka[384 + c] * v3; o3 += qa[384 + c] * s; S1[i * 64] = s; __builtin_amdgcn_sched_barrier(0); }
        float* pp = part + (w * 2) * 256 + e; pp[0] = o0; pp[64] = o1; pp[128] = o2; pp[192] = o3;
    }
    { float a0 = 0.f, a1 = 0.f;
      for (int c0 = 0; c0 < 64; c0 += 16) { float wv[16];
#pragma unroll
          for (int i = 0; i < 16; ++i) wv[i] = wp[(c0 + i) * 64];
#pragma unroll
          for (int i = 0; i < 16; ++i) { a0 += pl[(2 * tp) * 256 + pg * 64 + c0 + i] * wv[i]; a1 += pl[(2 * tp + 1) * 256 + pg * 64 + c0 + i] * wv[i]; } }
      const float sc = P.pool_scale[l * 256 + pc];
      C.y[(R0 + 2 * tp) * WMIX + Y_C + pc] = f2bf(a0 * sc * silu_(PR(2 * tp, C_ZC + pc)));
      C.y[(R0 + 2 * tp + 1) * WMIX + Y_C + pc] = f2bf(a1 * sc * silu_(PR(2 * tp + 1, C_ZC + pc))); }
    __syncthreads();
    { const bool isd = w >= 4; const int hh = w & 3, c = hh * 64 + e;
      const float* p0 = part + ((2 * hh) * 2 + (isd ? 1 : 0)) * 256 + e; const float* p1 = p0 + 512;
      const float gs = isd ? P.g_hgrn[l * 256 + c] : 1.f; const int zc = isd ? C_ZD : C_ZA, yc = isd ? Y_D : Y_A;
#pragma unroll
      for (int t = 0; t < 4; ++t) { const float o = p0[t * 64] + p1[t * 64];
          const float r = rsqrtf(wave_sum(o * o) * (1.f / 64.f) + EPS);
          C.y[(R0 + t) * WMIX + yc + c] = f2bf(o * r * gs * silu_(PR(t, zc + c))); } }
    __syncthreads();
}
#undef PR

__device__ __forceinline__ void sample_branch_tile(Ctx& C, int l, int tile) {
    const int lane = C.lane, w = C.w, fr = lane & 15, fq = lane >> 4;
    const int r0 = M_P + (tile >> 4) * 32 + (w >> 2) * 16, c0 = (tile & 15) * 64 + (w & 3) * 16;
    const bf16_t* A = C.y + (size_t)(r0 + fr) * WMIX + fq * 8;
    const bf16_t* B = C.wb + (size_t)l * DM * WMIX + (size_t)(c0 + fr) * WMIX + fq * 8;
    f32x4 acc = {0.f, 0.f, 0.f, 0.f};
    float gv[4][4];
#pragma unroll
    for (int br = 0; br < 4; ++br)
#pragma unroll
        for (int j = 0; j < 4; ++j) gv[br][j] = bf2f(C.gates[(size_t)(r0 + fq * 4 + j) * NGATE + br * 1024 + c0 + fr]);
#pragma unroll
    for (int br = 0; br < 4; ++br) {
        const int k0 = br == 0 ? 0 : (br == 1 ? 256 : (br == 2 ? 768 : 1024)), k1 = br == 0 ? 256 : (br == 1 ? 768 : (br == 2 ? 1024 : 1280));
#pragma unroll 8
        for (int k = k0; k < k1; k += 32) acc = mfma16(*(const bf16x8*)(A + k), *(const bf16x8*)(B + k), acc);
#pragma unroll
        for (int j = 0; j < 4; ++j) { float sc = gv[br][j]; if (br < 3) sc *= __builtin_amdgcn_rcpf(gv[br + 1][j]); acc[j] *= sc; }
    }
#pragma unroll
    for (int j = 0; j < 4; ++j) C.mb[(size_t)(r0 + fq * 4 + j) * DM + c0 + fr] = f2bf(acc[j]);
}
__device__ __forceinline__ void sample_out_tile(Ctx& C, int l, int tile) {
    const int lane = C.lane, w = C.w, fr = lane & 15, fq = lane >> 4;
    const int r0 = M_P + (tile >> 4) * 32 + (w >> 2) * 16, c0 = (tile & 15) * 64 + (w & 3) * 16;
    const bf16_t* A = C.mb + (size_t)(r0 + fr) * DM + fq * 8;
    const bf16_t* B = C.wout + (size_t)l * DM * DM + (size_t)(c0 + fr) * DM + fq * 8;
    f32x4 acc = {0.f, 0.f, 0.f, 0.f};
#pragma unroll 8
    for (int k = 0; k < DM; k += 32) acc = mfma16(*(const bf16x8*)(A + k), *(const bf16x8*)(B + k), acc);
#pragma unroll
    for (int j = 0; j < 4; ++j) ((bf16_t*)C.of)[(size_t)(r0 + fq * 4 + j) * DM + c0 + fr] = f2bf(acc[j]);
}

__device__ __forceinline__ void phase_scan(const Params& P, Ctx& C, int l) {
    for (int g = C.bx * NTHREADS + C.tid; g < 49152; g += C.G * NTHREADS) {
        const bool isA = g < 16384;
        const int gg = isA ? g : g - 16384;
        const int b = isA ? (gg >> 13) : (gg >> 14), r = isA ? (gg & 8191) : (gg & 16383), h = isA ? (r >> 11) : (r >> 12), de = isA ? (r & 2047) : (r & 4095);
        float* base = isA ? C.kva + ((size_t)(b * 128) * 4 + h) * 2048 + de : C.kvd + ((size_t)(b * 128) * 4 + h) * 4096 + de;
        const size_t stride = isA ? 8192 : 16384;
        const float* dp = C.decd + (size_t)(b * 128) * 256 + h * 64 + (de >> 6);
        const float decA = __expf(64.f * log1pf(-exp2f(-5.f - (float)h)));
        const float* lp = base; float* sp = base; const float* dlp = dp;
        float S = 0.f, va[16], da[16];
#pragma unroll
        for (int i = 0; i < 16; ++i) { va[i] = *lp; lp += stride; da[i] = isA ? decA : *dlp; dlp += 256; }
        for (int blk = 0; blk < 8; ++blk) {
            float vb[16], db[16];
            if (blk < 7) {
#pragma unroll
                for (int i = 0; i < 16; ++i) { vb[i] = *lp; lp += stride; db[i] = isA ? decA : *dlp; dlp += 256; } }
#pragma unroll
            for (int i = 0; i < 16; ++i) { *sp = S; sp += stride; S = da[i] * S + va[i]; }
#pragma unroll
            for (int i = 0; i < 16; ++i) { va[i] = vb[i]; da[i] = db[i]; }
        }
        float* fin = isA ? P.out + O_RETP + (((size_t)l * 2 + b) * 4 + h) * 2048 + de : P.out + O_HGRNP + (((size_t)l * 2 + b) * 4 + h) * 4096 + de;
        *fin = S;
    }
}

__device__ __forceinline__ void phase_finalize(const Params& P, Ctx& C, int l) {
    const int lane = C.lane; const int stride = C.G * 8;
    for (int row0 = C.bx * 8 + C.w; row0 < M_TOT; row0 += 2 * stride) {
        const int row1 = row0 + stride; const bool has1 = row1 < M_TOT; const int r1 = has1 ? row1 : row0;
        const uint2* oA = (const uint2*)((const bf16_t*)C.of + (size_t)row0 * DM); float4* xA = (float4*)(P.out + (size_t)row0 * DM);
        const uint2* oB = (const uint2*)((const bf16_t*)C.of + (size_t)r1 * DM); float4* xB = (float4*)(P.out + (size_t)r1 * DM);
        float4 o0[4], x0[4], o1[4], x1[4]; float ss0 = 0.f, ss1 = 0.f;
#pragma unroll
        for (int i = 0; i < 4; ++i) { const uint2 pa = oA[lane + 64 * i], pb = oB[lane + 64 * i]; x0[i] = xA[lane + 64 * i]; x1[i] = xB[lane + 64 * i];
            o0[i] = make_float4(lo16(pa.x), hi16(pa.x), lo16(pa.y), hi16(pa.y)); o1[i] = make_float4(lo16(pb.x), hi16(pb.x), lo16(pb.y), hi16(pb.y)); }
#pragma unroll
        for (int i = 0; i < 4; ++i) { ss0 += o0[i].x * o0[i].x + o0[i].y * o0[i].y + o0[i].z * o0[i].z + o0[i].w * o0[i].w; ss1 += o1[i].x * o1[i].x + o1[i].y * o1[i].y + o1[i].z * o1[i].z + o1[i].w * o1[i].w; }
        ss0 = wave_sum(ss0); ss1 = wave_sum(ss1);
        const float ra = rsqrtf(ss0 * (1.f / DM) + EPS), rb = rsqrtf(ss1 * (1.f / DM) + EPS);
        float s0 = 0.f, s1 = 0.f;
#pragma unroll
        for (int i = 0; i < 4; ++i) { const float4 g = ((const float4*)(P.g_post + l * DM))[lane + 64 * i];
            x0[i].x += o0[i].x * ra * g.x; x0[i].y += o0[i].y * ra * g.y; x0[i].z += o0[i].z * ra * g.z; x0[i].w += o0[i].w * ra * g.w;
            x1[i].x += o1[i].x * rb * g.x; x1[i].y += o1[i].y * rb * g.y; x1[i].z += o1[i].z * rb * g.z; x1[i].w += o1[i].w * rb * g.w;
            xA[lane + 64 * i] = x0[i]; if (has1) xB[lane + 64 * i] = x1[i];
            s0 += x0[i].x * x0[i].x + x0[i].y * x0[i].y + x0[i].z * x0[i].z + x0[i].w * x0[i].w; s1 += x1[i].x * x1[i].x + x1[i].y * x1[i].y + x1[i].z * x1[i].z + x1[i].w * x1[i].w; }
        if (l < 3) { s0 = wave_sum(s0); s1 = wave_sum(s1); const float qa = rsqrtf(s0 * (1.f / DM) + EPS), qb = rsqrtf(s1 * (1.f / DM) + EPS);
#pragma unroll
            for (int i = 0; i < 4; ++i) { const float4 g = ((const float4*)(P.g_pre + (l + 1) * DM))[lane + 64 * i];
                uint2 ov; ov.x = pk2(x0[i].x * qa * g.x, x0[i].y * qa * g.y); ov.y = pk2(x0[i].z * qa * g.z, x0[i].w * qa * g.w);
                ((uint2*)(C.h + (size_t)row0 * DM))[lane + 64 * i] = ov;
                if (has1) { uint2 ow; ow.x = pk2(x1[i].x * qb * g.x, x1[i].y * qb * g.y); ow.y = pk2(x1[i].z * qb * g.z, x1[i].w * qb * g.w);
                    ((uint2*)(C.h + (size_t)row1 * DM))[lane + 64 * i] = ow; } } }
    }
}

#ifndef PH_MASK
#define PH_MASK 2047
#endif
__global__ void __launch_bounds__(NTHREADS, 2) fwd_kernel(Params P) {
    extern __shared__ __attribute__((aligned(16))) unsigned char lds[];
    LAS unsigned char* ldsl = (LAS unsigned char*)lds;
    volatile LAS unsigned* bst = (volatile LAS unsigned*)(ldsl + LDS_BYTES - 16);
    if (threadIdx.x == 0) { bst[0] = 0u; bst[1] = 0u; if (P.coop) (void)xb_add((unsigned*)P.ws + XB_XCNT(xb_xcc_id()), 1u); }
    __syncthreads();

    for (int ph = P.ph_lo; ph < P.ph_hi; ++ph) {
        int nrep = 1;
#ifdef DUP_SP
        if (ph > 0 && ((ph - 1) % 7) == DUP_SP) nrep = 2;
        if (ph == 0 && DUP_SP == 7) nrep = 5;
#endif
        for (int rep = 0; rep < nrep; ++rep) {
        if (rep) xcd_barrier((unsigned*)P.ws, bst);
        int tid_ = threadIdx.x, bx = blockIdx.x, G_ = gridDim.x; __attribute__((address_space(1))) unsigned char* wsg = (__attribute__((address_space(1))) unsigned char*)P.ws;
        asm volatile("" : "+v"(tid_)); asm volatile("" : "+s"(bx)); asm volatile("" : "+s"(G_)); asm volatile("" : "+s"(wsg));
        unsigned char* ws = (unsigned char*)wsg;
        Ctx C;
        C.win = (bf16_t*)(ws + WS_WIN); C.wb = (bf16_t*)(ws + WS_WB); C.wout = (bf16_t*)(ws + WS_WOUT); C.h = (bf16_t*)(ws + WS_H); C.mb = (bf16_t*)(ws + WS_H);
        C.proj = (bf16_t*)(ws + WS_PROJ); C.mf = (float*)(ws + WS_PROJ); C.gates = (bf16_t*)(ws + WS_GATES); C.of = (float*)(ws + WS_GATES); C.y = (bf16_t*)(ws + WS_Y);
        C.kva = (float*)(ws + WS_KVA); C.kvd = (float*)(ws + WS_KVD); C.decd = (float*)(ws + WS_DECD);
        C.ropeAc = (float*)(ws + WS_ROPEA); C.ropeAs = C.ropeAc + NPOS * 16; C.ropeBc = (float*)(ws + WS_ROPEB); C.ropeBs = C.ropeBc + NPOS * 8; C.lbt = (float*)(ws + WS_LB);
        C.bx = bx; C.tid = tid_; C.lane = tid_ & 63; C.w = __builtin_amdgcn_readfirstlane(tid_ >> 6); C.G = G_;
        const int vcu = (C.G % 8 == 0) ? (bx % 8) * (C.G / 8) + bx / 8 : bx;
        if (ph == 0) { if (PH_MASK & 1) phase_prologue(P, C, lds); }
        else {
            const int l = (ph - 1) / 7, sp = (ph - 1) % 7;
            if (sp == 0) {
              if (PH_MASK & 2) {
                pg8::Gemm g{C.h, C.win + (size_t)l * DIN * DM, DM, DM}; pg8::StaticOrder S; S.init(M_TOT, DIN, DM, C.G, bx);
                pg8::EpiProj E{C.proj, C.gates};
                pg8::gemm_phase<pg8::EpiProj, pg8::StaticOrder>(ldsl, g, S, E, C.tid); }
            } else if (sp == 1) {
                for (int u = bx; u < 1280; u += C.G) {
                    asm volatile("" : "+v"(C.tid)); C.lane = C.tid & 63; C.w = __builtin_amdgcn_readfirstlane(C.tid >> 6);
                    if (u < 256) { if (PH_MASK & 4) attn_prompt_unit(P, C, l, u >> 7, (u & 127) >> 1, u & 1, lds); }
                    else if (u < 512) { if (PH_MASK & 32) lin_chunk<false, true>(P, C, l, (u - 256) >> 7, (u - 256) & 127, lds); }
                    else if (u < 768) { if (PH_MASK & 32) lin_chunk<true, true>(P, C, l, (u - 512) >> 7, (u - 512) & 127, lds); }
                    else if (u < 1024) { const int v = u - 768; if (PH_MASK & 8) { if (v < 128) { if (!(PH_MASK & 4096)) sample_b_unit(P, C, l, v, lds); } else { if (!(PH_MASK & 8192)) sample_adc_unit(P, C, l, v - 128, lds); } } }
                    else { if (PH_MASK & 16) pool_prompt_unit(P, C, l, u - 1024, lds); }
                }
            } else if (sp == 2) { if (PH_MASK & 64) phase_scan(P, C, l); }
            else if (sp == 3) {
                for (int u = bx; u < 512; u += C.G) {
                    asm volatile("" : "+v"(C.tid)); C.lane = C.tid & 63; C.w = __builtin_amdgcn_readfirstlane(C.tid >> 6);
                    if (u < 256) { if (PH_MASK & 128) lin_chunk<false, false>(P, C, l, u >> 7, u & 127, lds); }
                    else { if (PH_MASK & 128) lin_chunk<true, false>(P, C, l, (u - 256) >> 7, (u - 256) & 127, lds); }
                }
            } else if (sp == 4) {
              if (PH_MASK & 256) {
                for (int t = bx; t < 256; t += C.G) sample_branch_tile(C, l, t);
                pg8::Gemm g{C.y, C.wb + (size_t)l * DM * WMIX, WMIX, WMIX}; pg8::BranchOrder S{256, C.G, vcu};
                pg8::EpiBranch E{C.gates, C.mb};
                pg8::gemm_phase<pg8::EpiBranch, pg8::BranchOrder>(ldsl, g, S, E, C.tid); }
            } else if (sp == 5) {
              if (PH_MASK & 512) {
                for (int t = bx; t < 256; t += C.G) sample_out_tile(C, l, t);
                pg8::Gemm g{C.mb, C.wout + (size_t)l * DM * DM, DM, DM}; pg8::TileOrder S{256, C.G, vcu, DM / 64};
                pg8::EpiF32 E{(bf16_t*)C.of};
                pg8::gemm_phase<pg8::EpiF32, pg8::TileOrder>(ldsl, g, S, E, C.tid); }
            } else { if (PH_MASK & 1024) phase_finalize(P, C, l); }
        }
        }
        if (ph + 1 < P.ph_hi && P.coop) { if (ph == 0) cg::this_grid().sync(); else xcd_barrier((unsigned*)P.ws, bst); }
    }
}

#ifndef N_LAUNCH_MODE
#define N_LAUNCH_MODE 1
#endif
extern "C" void kernel_launch(void* const* d_in, const int* in_sizes, int n_in, void* d_out, int out_size, void* d_ws, size_t ws_size, hipStream_t stream) {
    static int grid = 0;
    if (grid == 0) {
        if (n_in != 17 || (size_t)out_size != O_END || ws_size < WS_END) { fprintf(stderr, "kernel_launch: unexpected sizes n_in %d out %d ws %zu\n", n_in, out_size, ws_size); grid = -1; return; }
        int dev = 0, cus = 0, per_cu = 0;
        hipGetDevice(&dev); hipDeviceGetAttribute(&cus, hipDeviceAttributeMultiprocessorCount, dev);
        if (hipFuncSetAttribute((const void*)fwd_kernel, hipFuncAttributeMaxDynamicSharedMemorySize, LDS_BYTES) != hipSuccess) { fprintf(stderr, "hipFuncSetAttribute failed\n"); grid = -1; return; }
        if (hipOccupancyMaxActiveBlocksPerMultiprocessor(&per_cu, (const void*)fwd_kernel, NTHREADS, LDS_BYTES) != hipSuccess || per_cu < 1) { fprintf(stderr, "occupancy query: %d\n", per_cu); per_cu = 1; }
        (void)hipGetLastError();
        grid = cus * 1;
        if (per_cu < 1) grid = -1;
    }
    if (grid < 0) return;
    Params p{};
    const float* const* in = (const float* const*)d_in;
    p.x_prompt = in[0]; p.x_sample = in[1]; p.state_ret = in[2]; p.cache_k = in[3]; p.cache_v = in[4]; p.state_pool = in[5]; p.state_hgrn = in[6];
    p.w_in = in[7]; p.w_branch = in[8]; p.w_out = in[9]; p.g_pre = in[10]; p.g_post = in[11]; p.attn_sink = in[12]; p.w_pool = in[13];
    p.pool_scale = in[14]; p.g_hgrn = in[15]; p.lower_bounds = in[16];
    p.out = (float*)d_out; p.ws = (unsigned char*)d_ws;
    for (int i = 0; i < 16; ++i) p.invA[i] = pow(10000.0, -(double)i / 16.0);
    for (int i = 0; i < 8; ++i) p.invB[i] = pow(500000.0, -(double)i / 8.0);
    const int NPH = 29;
#if N_LAUNCH_MODE == 1
    (void)hipMemsetAsync(d_ws, 0, 16384, stream);
    p.ph_lo = 0; p.ph_hi = NPH; p.coop = 1; p.pad = 0;
    void* args[] = {&p};
    hipError_t e = hipLaunchCooperativeKernel((const void*)fwd_kernel, dim3(grid), dim3(NTHREADS), args, LDS_BYTES, stream);
    if (e != hipSuccess) fprintf(stderr, "cooperative launch failed: %s (grid %d)\n", hipGetErrorString(e), grid);
#else
    for (int ph = 0; ph < NPH; ++ph) {
        p.ph_lo = ph; p.ph_hi = ph + 1; p.coop = 0; p.pad = 0;
        hipLaunchKernelGGL(fwd_kernel, dim3(grid), dim3(NTHREADS), LDS_BYTES, stream, p);
    }
#endif
}
```
